# Optimizing an MI355X kernel written in HIP

```python
import math
import jax, jax.numpy as jnp
from jax import lax
import numpy as np

D_MODEL = 1024
BATCH = 8
SEQ = 4096
DEPTH = 4

GRID_W = 64
CTX_LEN = 256
HEAD_DIM = 64
N_HEADS_NA = 8
NA_WIDTH = N_HEADS_NA * HEAD_DIM
HY_WIDTH = D_MODEL - NA_WIDTH
HY_ORDER = 2
HY_EMB = 33
HY_HIDDEN = 64
HY_FAST_DECAY = 0.3
HY_SLOW_DECAY = 1.5
HY_TARGET = 1e-2
SHORT_CONV = 3
WIN_R = 8
WIN_C = 16
N_HEADS_DIFF = D_MODEL // (2 * HEAD_DIM)
DIFF_QK = N_HEADS_DIFF * 2 * HEAD_DIM
GATE_WIDTH = D_MODEL
IN_WIDTH = 4 * D_MODEL
HY_LO = 3 * NA_WIDTH
HY_HI = HY_LO + (HY_ORDER + 1) * HY_WIDTH
GATE_LO = IN_WIDTH - GATE_WIDTH
Q_BLOCK = 128
N_EVEN = (DEPTH + 1) // 2
N_ODD = DEPTH // 2
EPS = 1e-6
ROPE_BASE = 10000.0

kernel_name = "hybrid_natten_hyena_diffattn_prefix_dit"

F32 = jnp.float32


def _rmsnorm(x, g):
    x32 = x.astype(F32)
    y = x32 * lax.rsqrt(jnp.mean(x32 * x32, axis=-1, keepdims=True) + EPS)
    return (y * g.astype(F32)).astype(x.dtype)


def _modulation(vec, w_mod, b_mod, n_parts):
    m = jax.nn.silu(vec) @ w_mod[:, :n_parts * D_MODEL] + b_mod[:n_parts * D_MODEL]
    return jnp.split(m, n_parts, axis=-1)


def _axial_rope(n_tokens):
    t = jnp.arange(n_tokens, dtype=jnp.int32)
    row = (t // GRID_W).astype(F32)
    col = (t % GRID_W).astype(F32)
    n_freq = HEAD_DIM // 4
    inv = ROPE_BASE ** (-jnp.arange(n_freq, dtype=F32) / n_freq)
    ang = jnp.concatenate([row[:, None] * inv, col[:, None] * inv], axis=-1)
    return jnp.cos(ang), jnp.sin(ang)


def _apply_rope(x, cos, sin):
    shape = (1, cos.shape[0]) + (1,) * (x.ndim - 3) + (cos.shape[1],)
    cos = cos.reshape(shape)
    sin = sin.reshape(shape)
    x32 = x.astype(F32)
    x1, x2 = x32[..., :HEAD_DIM // 2], x32[..., HEAD_DIM // 2:]
    return jnp.concatenate([x1 * cos - x2 * sin, x1 * sin + x2 * cos], axis=-1).astype(x.dtype)


def _softmax_attend(q, k, v):
    s = jnp.einsum('bqhd,bkhd->bhqk', q, k).astype(F32) * (q.shape[-1] ** -0.5)
    p = jax.nn.softmax(s, axis=-1).astype(v.dtype)
    return jnp.einsum('bhqk,bkhe->bqhe', p, v)


def _neighbourhood_attention(q, k, v, kc, vc, rpb):
    B, S, H, Dh = q.shape
    rows = S // GRID_W
    kr = min(WIN_R, rows)
    kw = min(WIN_C, GRID_W)
    qg = q.reshape(B, rows, GRID_W, H, Dh)
    kg = k.reshape(B, rows, GRID_W, H, Dh)
    vg = v.reshape(B, rows, GRID_W, H, Dh)
    row_start = jnp.clip(jnp.arange(rows) - kr // 2, 0, rows - kr)
    col = jnp.arange(GRID_W)
    col_start = jnp.clip(col - kw // 2, 0, GRID_W - kw)
    col_ok = (col[None, :] >= col_start[:, None]) & (col[None, :] < col_start[:, None] + kw)
    dcol_idx = jnp.clip(col[None, :] - col[:, None] + WIN_C - 1, 0, 2 * WIN_C - 2)
    rpb_cols = rpb.astype(F32)[:, :, dcol_idx]
    scale = Dh ** -0.5
    n_loc = kr * GRID_W

    def row_block(r):
        rs = row_start[r]
        q_r = lax.dynamic_index_in_dim(qg, r, axis=1, keepdims=False)
        k_b = lax.dynamic_slice_in_dim(kg, rs, kr, axis=1)
        v_b = lax.dynamic_slice_in_dim(vg, rs, kr, axis=1)
        bias = lax.dynamic_slice_in_dim(rpb_cols, rs - r + WIN_R - 1, kr, axis=1)
        bias = jnp.transpose(bias, (0, 2, 1, 3))
        s_loc = jnp.einsum('bqhd,brwhd->bhqrw', q_r, k_b).astype(F32) * scale + bias[None]
        s_loc = jnp.where(col_ok[None, None, :, None, :], s_loc, -jnp.inf)
        s_ctx = jnp.einsum('bqhd,bchd->bhqc', q_r, kc).astype(F32) * scale
        s = jnp.concatenate([s_loc.reshape(B, H, GRID_W, n_loc), s_ctx], axis=-1)
        p = jax.nn.softmax(s, axis=-1).astype(v.dtype)
        o = jnp.einsum('bhqk,bkhd->bqhd', p[..., :n_loc], v_b.reshape(B, n_loc, H, Dh))
        return o + jnp.einsum('bhqc,bchd->bqhd', p[..., n_loc:], vc)

    out = lax.map(row_block, jnp.arange(rows))
    return jnp.moveaxis(out, 0, 1).reshape(B, S, H, Dh)


def _short_conv(u, w, b):
    L = u.shape[1]
    pad = SHORT_CONV // 2
    up = jnp.pad(u, ((0, 0), (pad, SHORT_CONV - 1 - pad), (0, 0)))
    y = b
    for j in range(SHORT_CONV):
        y = y + up[:, j:j + L] * w[j]
    return y


def _hyena_filters(L, w1, b1, freq, w2, b2, w3, b3):
    t = jnp.linspace(0.0, 1.0, L, dtype=F32)[:, None]
    w = (2.0 * math.pi / L) * jnp.arange(L, dtype=F32)[:, None]
    bands = (HY_EMB - 1) // 2
    fb = jnp.linspace(1e-4, bands - 1, bands, dtype=F32)[None, :]
    z = jnp.concatenate([t, jnp.cos(fb * w), -jnp.sin(fb * w)], axis=-1)
    fr = freq.astype(F32)
    h = jnp.sin(fr * (z @ w1.astype(F32) + b1.astype(F32)))
    h = jnp.sin(fr * (h @ w2.astype(F32) + b2.astype(F32)))
    h = h @ w3.astype(F32) + b3.astype(F32)
    min_decay = math.log(HY_TARGET) / HY_SLOW_DECAY
    max_decay = math.log(HY_TARGET) / HY_FAST_DECAY
    deltas = jnp.abs(jnp.linspace(min_decay, max_decay, HY_WIDTH, dtype=F32))
    decay = jnp.exp(-t * deltas[None, :])
    h = h.reshape(L, HY_ORDER, 2, HY_WIDTH) * decay[:, None, None, :]
    return h * lax.rsqrt(jnp.sum(h * h, axis=(0, 2), keepdims=True) + EPS)


def _bidir_long_conv(z, h_fwd, h_bwd, skip):
    L = z.shape[1]
    n = 2 * L
    Zf = jnp.fft.rfft(z, n=n, axis=1)
    Hf = jnp.fft.rfft(h_fwd, n=n, axis=0) + jnp.conj(jnp.fft.rfft(h_bwd, n=n, axis=0))
    y = jnp.fft.irfft(Zf * Hf[None], n=n, axis=1)[:, :L]
    return y + skip * z


def _hyena(u, conv_w, conv_b, filt, skip):
    u = _short_conv(u, conv_w, conv_b).astype(F32)
    v, x1, x2 = jnp.split(u, 3, axis=-1)
    h = _hyena_filters(u.shape[1], *filt)
    skip = skip.astype(F32)
    z = x1 * _bidir_long_conv(v, h[:, 0, 0], h[:, 0, 1], skip[0])
    z = x2 * _bidir_long_conv(z, h[:, 1, 0], h[:, 1, 1], skip[1])
    return z


def _diff_attend(q, k, v, lam):
    s = jnp.einsum('bqhmd,bkhmd->bhmqk', q, k).astype(F32) * (q.shape[-1] ** -0.5)
    p = jax.nn.softmax(s, axis=-1)
    a = p[:, :, 0] - lam * p[:, :, 1]
    return jnp.einsum('bhqk,bkhe->bqhe', a.astype(v.dtype), v)


def _diff_attention_latent(q, k, v, kc, vc, lam):
    B, S = q.shape[:2]
    k_all = jnp.concatenate([k, kc], axis=1)
    v_all = jnp.concatenate([v, vc], axis=1)
    nb = S // Q_BLOCK
    qb = jnp.moveaxis(q.reshape((B, nb, Q_BLOCK) + q.shape[2:]), 1, 0)
    o = lax.map(lambda qq: _diff_attend(qq, k_all, v_all, lam), qb)
    return jnp.moveaxis(o, 0, 1).reshape((B, S) + o.shape[3:])


def setup_inputs(seed: int = 0) -> dict:
    key = jax.random.key(seed)
    ks = jax.random.split(key, 32)
    nrm = jax.random.normal
    D = D_MODEL
    return {
        "x": nrm(ks[0], (BATCH, SEQ, D), F32),
        "c": nrm(ks[1], (BATCH, D), F32),
        "ctx": nrm(ks[2], (BATCH, CTX_LEN, D), F32),
        "c_ctx": nrm(ks[3], (D,), F32),
        "norm_g": 1.0 + 0.02 * nrm(ks[4], (DEPTH, D), F32),
        "w_mod": 0.5 * D ** -0.5 * nrm(ks[5], (DEPTH, D, 3 * D), F32),
        "b_mod": 0.02 * nrm(ks[6], (DEPTH, 3 * D), F32),
        "w_in": D ** -0.5 * nrm(ks[7], (DEPTH, D, IN_WIDTH), F32),
        "w_out": D ** -0.5 * nrm(ks[8], (DEPTH, D, D), F32),
        "q_norm_g": 1.0 + 0.02 * nrm(ks[9], (DEPTH, HEAD_DIM), F32),
        "k_norm_g": 1.0 + 0.02 * nrm(ks[10], (DEPTH, HEAD_DIM), F32),
        "na_rpb": 0.1 * nrm(ks[11], (N_EVEN, N_HEADS_NA, 2 * WIN_R - 1, 2 * WIN_C - 1), F32),
        "hy_conv_w": SHORT_CONV ** -0.5 * nrm(ks[12], (N_EVEN, SHORT_CONV, 3 * HY_WIDTH), F32),
        "hy_conv_b": 0.02 * nrm(ks[13], (N_EVEN, 3 * HY_WIDTH), F32),
        "hy_filt_w1": HY_EMB ** -0.5 * nrm(ks[14], (N_EVEN, HY_EMB, HY_HIDDEN), F32),
        "hy_filt_b1": 0.02 * nrm(ks[15], (N_EVEN, HY_HIDDEN), F32),
        "hy_filt_freq": 1.0 + 0.1 * nrm(ks[16], (N_EVEN, HY_HIDDEN), F32),
        "hy_filt_w2": HY_HIDDEN ** -0.5 * nrm(ks[17], (N_EVEN, HY_HIDDEN, HY_HIDDEN), F32),
        "hy_filt_b2": 0.02 * nrm(ks[18], (N_EVEN, HY_HIDDEN), F32),
        "hy_filt_w3": HY_HIDDEN ** -0.5 * nrm(ks[19], (N_EVEN, HY_HIDDEN, HY_ORDER * 2 * HY_WIDTH), F32),
        "hy_filt_b3": 0.02 * nrm(ks[20], (N_EVEN, HY_ORDER * 2 * HY_WIDTH), F32),
        "hy_skip": 0.5 * nrm(ks[21], (N_EVEN, HY_ORDER, HY_WIDTH), F32),
        "diff_lam_q1": 0.1 * nrm(ks[22], (N_ODD, HEAD_DIM), F32),
        "diff_lam_k1": 0.1 * nrm(ks[23], (N_ODD, HEAD_DIM), F32),
        "diff_lam_q2": 0.1 * nrm(ks[24], (N_ODD, HEAD_DIM), F32),
        "diff_lam_k2": 0.1 * nrm(ks[25], (N_ODD, HEAD_DIM), F32),
        "diff_subln_g": 1.0 + 0.02 * nrm(ks[26], (N_ODD, 2 * HEAD_DIM), F32),
    }


def reference(x, c, ctx, c_ctx, norm_g, w_mod, b_mod, w_in, w_out, q_norm_g, k_norm_g,
              na_rpb, hy_conv_w, hy_conv_b, hy_filt_w1, hy_filt_b1, hy_filt_freq, hy_filt_w2,
              hy_filt_b2, hy_filt_w3, hy_filt_b3, hy_skip,
              diff_lam_q1, diff_lam_k1, diff_lam_q2, diff_lam_k2, diff_subln_g):
    B, S, _ = x.shape
    n_ctx = ctx.shape[1]
    cos, sin = _axial_rope(S)
    xc = ctx
    for l in range(DEPTH):
        ctx_out = l < DEPTH - 1
        shift, scale, gate = _modulation(c, w_mod[l], b_mod[l], 3)
        h = _rmsnorm(x, norm_g[l]) * (1.0 + scale[:, None]) + shift[:, None]
        p = h @ w_in[l]
        mods_c = _modulation(c_ctx, w_mod[l], b_mod[l], 3 if ctx_out else 2)
        hc = _rmsnorm(xc, norm_g[l]) * (1.0 + mods_c[1]) + mods_c[0]
        if l % 2 == 0:
            e = l // 2
            qa = _rmsnorm(p[..., :NA_WIDTH].reshape(B, S, N_HEADS_NA, HEAD_DIM), q_norm_g[l])
            ka = _rmsnorm(p[..., NA_WIDTH:2 * NA_WIDTH].reshape(B, S, N_HEADS_NA, HEAD_DIM), k_norm_g[l])
            va = p[..., 2 * NA_WIDTH:3 * NA_WIDTH].reshape(B, S, N_HEADS_NA, HEAD_DIM)
            kv_lo, kv_hi = NA_WIDTH, 3 * NA_WIDTH
            pc = hc @ (w_in[l] if ctx_out else w_in[l][:, kv_lo:kv_hi])
            off = 0 if ctx_out else kv_lo
            kc = _rmsnorm(pc[..., kv_lo - off:kv_lo - off + NA_WIDTH].reshape(B, n_ctx, N_HEADS_NA, HEAD_DIM), k_norm_g[l])
            vc = pc[..., kv_lo - off + NA_WIDTH:kv_hi - off].reshape(B, n_ctx, N_HEADS_NA, HEAD_DIM)
            filt = (hy_filt_w1[e], hy_filt_b1[e], hy_filt_freq[e], hy_filt_w2[e], hy_filt_b2[e],
                    hy_filt_w3[e], hy_filt_b3[e])
            o_na = _neighbourhood_attention(qa, ka, va, kc, vc, na_rpb[e]).reshape(B, S, NA_WIDTH)
            o_hy = _hyena(p[..., HY_LO:HY_HI], hy_conv_w[e], hy_conv_b[e], filt, hy_skip[e]).astype(x.dtype)
            y = jnp.concatenate([o_na, o_hy], axis=-1) * jax.nn.silu(p[..., GATE_LO:])
            if ctx_out:
                qc = _rmsnorm(pc[..., :NA_WIDTH].reshape(B, n_ctx, N_HEADS_NA, HEAD_DIM), q_norm_g[l])
                oc_na = _softmax_attend(qc, kc, vc).reshape(B, n_ctx, NA_WIDTH)
                oc_hy = _hyena(pc[..., HY_LO:HY_HI], hy_conv_w[e], hy_conv_b[e], filt, hy_skip[e]).astype(xc.dtype)
                yc = jnp.concatenate([oc_na, oc_hy], axis=-1) * jax.nn.silu(pc[..., GATE_LO:])
        else:
            o_i = l // 2
            lam_init = 0.8 - 0.6 * math.exp(-0.3 * l)
            lam = (jnp.exp(jnp.sum(diff_lam_q1[o_i].astype(F32) * diff_lam_k1[o_i].astype(F32)))
                   - jnp.exp(jnp.sum(diff_lam_q2[o_i].astype(F32) * diff_lam_k2[o_i].astype(F32)))
                   + lam_init)
            q = _rmsnorm(p[..., :DIFF_QK].reshape(B, S, N_HEADS_DIFF, 2, HEAD_DIM), q_norm_g[l])
            k = _rmsnorm(p[..., DIFF_QK:2 * DIFF_QK].reshape(B, S, N_HEADS_DIFF, 2, HEAD_DIM), k_norm_g[l])
            q = _apply_rope(q, cos, sin)
            k = _apply_rope(k, cos, sin)
            v = p[..., 2 * DIFF_QK:3 * DIFF_QK].reshape(B, S, N_HEADS_DIFF, 2 * HEAD_DIM)
            kv_lo, kv_hi = DIFF_QK, 3 * DIFF_QK
            pc = hc @ (w_in[l] if ctx_out else w_in[l][:, kv_lo:kv_hi])
            off = 0 if ctx_out else kv_lo
            kc = _rmsnorm(pc[..., kv_lo - off:kv_lo - off + DIFF_QK].reshape(B, n_ctx, N_HEADS_DIFF, 2, HEAD_DIM), k_norm_g[l])
            vc = pc[..., kv_lo - off + DIFF_QK:kv_hi - off].reshape(B, n_ctx, N_HEADS_DIFF, 2 * HEAD_DIM)
            o = _diff_attention_latent(q, k, v, kc, vc, lam)
            o = (_rmsnorm(o, diff_subln_g[o_i]) * (1.0 - lam_init)).reshape(B, S, D_MODEL)
            y = o * jax.nn.silu(p[..., GATE_LO:])
            if ctx_out:
                qc = _rmsnorm(pc[..., :DIFF_QK].reshape(B, n_ctx, N_HEADS_DIFF, 2, HEAD_DIM), q_norm_g[l])
                oc = _diff_attend(qc, kc, vc, lam)
                oc = (_rmsnorm(oc, diff_subln_g[o_i]) * (1.0 - lam_init)).reshape(B, n_ctx, D_MODEL)
                yc = oc * jax.nn.silu(pc[..., GATE_LO:])
        x = x + gate[:, None] * (y @ w_out[l])
        if ctx_out:
            xc = xc + mods_c[2] * (yc @ w_out[l])
    return x
```

```cpp
#ifndef DUP
#define DUP 0
#endif
#include <hip/hip_runtime.h>
#include <hip/hip_cooperative_groups.h>
#include <cstdio>
namespace cg = cooperative_groups;

typedef unsigned short bf16_t;
typedef short bf16x8 __attribute__((ext_vector_type(8)));
typedef float f32x16 __attribute__((ext_vector_type(16)));
typedef float f32x4 __attribute__((ext_vector_type(4)));
typedef unsigned u32x4 __attribute__((ext_vector_type(4)));
typedef unsigned u32x2 __attribute__((ext_vector_type(2)));
typedef __bf16 bf16v2 __attribute__((ext_vector_type(2)));
#define DI __device__ __forceinline__
#define MFMA32(a, b, c) __builtin_amdgcn_mfma_f32_32x32x16_bf16((a), (b), (c), 0, 0, 0)
#define UNR _Pragma("unroll")

constexpr int R = 34816, TB = 4352, SEQ = 4096, NCTX = 256;
constexpr float LOG2E = 1.4426950408889634f;
constexpr size_t SEG = (size_t)R * 512;
constexpr size_t OFF_WIN = 0;
constexpr size_t OFF_WOUT = OFF_WIN + 4ull * 4096 * 1024 * 2;
constexpr size_t OFF_MOD = OFF_WOUT + 4ull * 1024 * 1024 * 2;
constexpr size_t OFF_HN = OFF_MOD + 4ull * 9 * 3072 * 4;
constexpr size_t OFF_PB = OFF_HN + (size_t)R * 1024 * 2;
constexpr size_t OFF_Y = OFF_PB + (size_t)R * 4096 * 2;
constexpr size_t OFF_XC = OFF_Y + (size_t)R * 1024 * 2;
constexpr size_t OFF_GREV = OFF_XC + 8ull * 256 * 1024 * 4;
constexpr size_t OFF_GC = OFF_GREV + 2ull * 2 * 512 * 8192 * 2;
constexpr size_t OFF_MISC = OFF_GC + 2ull * 2 * 512 * 512 * 4;
constexpr size_t OFF_BAR = OFF_MISC + 4096;
constexpr size_t WS_NEED = OFF_BAR + 16384;
constexpr size_t OFF_HRAW = OFF_PB;
constexpr size_t OFF_HRAWC = OFF_HRAW + 2ull * 2 * 2 * 512 * 4096 * 4;
constexpr size_t OFF_SSP = OFF_HRAWC + 2ull * 2 * 2 * 512 * 256 * 4;

struct Params {
  const float *x, *c, *ctx, *c_ctx, *norm_g, *w_mod, *b_mod, *w_in, *w_out, *q_norm_g, *k_norm_g, *na_rpb, *hy_conv_w, *hy_conv_b,
      *f_w1, *f_b1, *f_freq, *f_w2, *f_b2, *f_w3, *f_b3, *hy_skip, *lq1, *lk1, *lq2, *lk2, *subln_g;
  float* out;
  unsigned char* ws;
};
struct PW : Params { int wid0; };

DI unsigned pk2(float a, float b) { bf16v2 v = {(__bf16)a, (__bf16)b}; return __builtin_bit_cast(unsigned, v); }
DI float bflo(unsigned u) { return __uint_as_float(u << 16); }
DI float bfhi(unsigned u) { return __uint_as_float(u & 0xffff0000u); }
DI float bf1(bf16_t u) { return __uint_as_float((unsigned)u << 16); }
DI int crow(int reg, int h) { return (reg & 3) + 8 * (reg >> 2) + 4 * h; }
DI float silu(float x) { return x * __builtin_amdgcn_rcpf(1.f + __builtin_amdgcn_exp2f(-x * LOG2E)); }
DI int lane_l() { int l = __builtin_amdgcn_mbcnt_hi(~0u, __builtin_amdgcn_mbcnt_lo(~0u, 0u)); asm volatile("" : "+v"(l)); return l; }
DI float shx(float v, int o) { return __int_as_float(__builtin_amdgcn_ds_bpermute((lane_l() ^ o) << 2, __float_as_int(v))); }
DI float wave_sum(float v) { UNR for (int o = 32; o > 0; o >>= 1) v += shx(v, o); return v; }
DI float wave_max(float v) { UNR for (int o = 32; o > 0; o >>= 1) v = fmaxf(v, shx(v, o)); return v; }
DI f32x16 splat16(float v) { f32x16 r; UNR for (int i = 0; i < 16; ++i) r[i] = v; return r; }
DI bf16x8 pack8(const f32x16& s, int o) {
  u32x4 w; w[0] = pk2(s[o], s[o + 1]); w[1] = pk2(s[o + 2], s[o + 3]); w[2] = pk2(s[o + 4], s[o + 5]); w[3] = pk2(s[o + 6], s[o + 7]);
  return __builtin_bit_cast(bf16x8, w);
}

#define LTID(p) (((p).wid0 << 6) | lane_l())
DI int lbid() { int b = blockIdx.x; asm volatile("" : "+s"(b)); return b; }
DI void transpose_jobs(const PW& p, float* tile) {
  const int tid = LTID(p);
  constexpr int J_TIN = 4 * 16 * 64, J_ALL = J_TIN + 4 * 16 * 16;
  const int kk = tid >> 4, n4 = (tid & 15) * 4, n = tid >> 3, kc = tid & 7;
#define TJ_SRC(j, pass) ((j) < J_TIN ? p.w_in + (size_t)((j) >> 10) * 1024 * 4096 + (size_t)((((j) >> 6) & 15) * 64 + (pass) * 32 + kk) * 4096 + ((j) & 63) * 64 + n4 \
                                     : p.w_out + (size_t)(((j) - J_TIN) >> 8) * 1024 * 1024 + (size_t)(((((j) - J_TIN) >> 4) & 15) * 64 + (pass) * 32 + kk) * 1024 + (((j) - J_TIN) & 15) * 64 + n4)
  int j = lbid();
  f32x4 v0 = {0.f, 0.f, 0.f, 0.f}, v1 = v0;
  if (j < J_ALL) { v0 = *(const f32x4*)TJ_SRC(j, 0); v1 = *(const f32x4*)TJ_SRC(j, 1); }
  for (; j < J_ALL; j += gridDim.x) {
    UNR for (int e = 0; e < 4; ++e) { tile[kk * 65 + n4 + e] = v0[e]; tile[(32 + kk) * 65 + n4 + e] = v1[e]; }
    const int jn = j + gridDim.x;
    if (jn < J_ALL) { v0 = *(const f32x4*)TJ_SRC(jn, 0); v1 = *(const f32x4*)TJ_SRC(jn, 1); }
    __syncthreads();
    u32x4 w;
    UNR for (int q = 0; q < 4; ++q) w[q] = pk2(tile[(kc * 8 + 2 * q) * 65 + n], tile[(kc * 8 + 2 * q + 1) * 65 + n]);
    const bool isin = j < J_TIN; const int jj = isin ? j : j - J_TIN;
    const int l = isin ? jj >> 10 : jj >> 8, tk = isin ? (jj >> 6) & 15 : (jj >> 4) & 15, tn = isin ? jj & 63 : jj & 15;
    bf16_t* Wt = isin ? (bf16_t*)(p.ws + OFF_WIN) + (size_t)l * 4096 * 1024 : (bf16_t*)(p.ws + OFF_WOUT) + (size_t)l * 1024 * 1024;
    { const int cn = tn * 64 + n, c = cn & 255; const int pos = (cn & ~255) + 128 * ((c >> 5) & 1) + 32 * (c >> 6) + (c & 31);
      *(u32x4*)(Wt + (size_t)pos * 1024 + tk * 64 + kc * 8) = w; }
    __syncthreads();
  }
#undef TJ_SRC
}

DI void job_mod(const PW& p, int l, int cgp, float* sv, float* red) {
  const int tid = LTID(p);
  float* MOD = (float*)(p.ws + OFF_MOD);
  for (int i = tid; i < 9 * 1024; i += 512) { const int v = i >> 10, k = i & 1023; const float c = v < 8 ? p.c[v * 1024 + k] : p.c_ctx[k]; sv[i] = silu(c); }
  __syncthreads();
  const int kg = tid >> 6, cn = tid & 63, n = cgp * 64 + cn;
  float acc[9];
  UNR for (int v = 0; v < 9; ++v) acc[v] = 0.f;
  const float* W = p.w_mod + (size_t)l * 1024 * 3072 + n;
  for (int k = kg * 128; k < kg * 128 + 128; k += 16) {
    float w[16];
    UNR for (int u = 0; u < 16; ++u) w[u] = W[(size_t)(k + u) * 3072];
    UNR for (int v = 0; v < 9; ++v) UNR for (int u4 = 0; u4 < 4; ++u4) { const f32x4 s4 = *(const f32x4*)(sv + v * 1024 + k + u4 * 4); UNR for (int j = 0; j < 4; ++j) acc[v] += s4[j] * w[u4 * 4 + j]; }
  }
  UNR for (int v = 0; v < 9; ++v) red[(kg * 9 + v) * 64 + cn] = acc[v];
  __syncthreads();
  for (int i = tid; i < 9 * 64; i += 512) {
    const int v = i >> 6, c2 = i & 63; float s = 0.f;
    UNR for (int g = 0; g < 8; ++g) s += red[(g * 9 + v) * 64 + c2];
    MOD[(l * 9 + v) * 3072 + cgp * 64 + c2] = s + p.b_mod[l * 3072 + cgp * 64 + c2];
  }
  __syncthreads();
}

DI void job_filter(const PW& p, int e, int chunk, int cb, float* zs, float* h1, float* h2) {
  const int tid = LTID(p);
  const bool isc = chunk >= 256; const int L = isc ? 256 : 4096; const int t0 = (isc ? chunk - 256 : chunk) * 16;
  for (int i = tid; i < 16 * 33; i += 512) {
    const int tt = i / 33, f = i % 33, t = t0 + tt; float val;
    if (f == 0) val = (float)t / (float)(L - 1);
    else { const int k = (f - 1) & 15; const float fb = 1e-4f + (float)k * ((15.f - 1e-4f) / 15.f); float rev = fb * (float)t / (float)L; rev -= floorf(rev);
           val = f <= 16 ? __builtin_amdgcn_cosf(rev) : -__builtin_amdgcn_sinf(rev); }
    zs[i] = val;
  }
  __syncthreads();
  for (int i = tid; i < 1024; i += 512) {
    const int tt = i >> 6, j = i & 63; float a = p.f_b1[e * 64 + j];
    for (int f = 0; f < 33; ++f) a += zs[tt * 33 + f] * p.f_w1[(e * 33 + f) * 64 + j];
    h1[i] = __sinf(p.f_freq[e * 64 + j] * a);
  }
  __syncthreads();
  for (int i = tid; i < 1024; i += 512) {
    const int tt = i >> 6, j = i & 63; float a = p.f_b2[e * 64 + j];
    for (int k = 0; k < 64; ++k) a += h1[tt * 64 + k] * p.f_w2[(e * 64 + k) * 64 + j];
    h2[j * 16 + tt] = __sinf(p.f_freq[e * 64 + j] * a);
  }
  __syncthreads();
  const int n = cb * 512 + tid;
  float acc[16];
  { const float b3 = p.f_b3[e * 2048 + n]; UNR for (int tt = 0; tt < 16; ++tt) acc[tt] = b3; }
  _Pragma("unroll 4") for (int k = 0; k < 64; ++k) {
    const float w = p.f_w3[((size_t)e * 64 + k) * 2048 + n];
    UNR for (int q4 = 0; q4 < 4; ++q4) { const f32x4 hv = *(const f32x4*)(h2 + k * 16 + q4 * 4); UNR for (int j = 0; j < 4; ++j) acc[q4 * 4 + j] += hv[j] * w; }
  }
  const float mind = logf(1e-2f) / 1.5f, maxd = logf(1e-2f) / 0.3f;
  const float delta = fabsf(mind + (float)tid * ((maxd - mind) / 511.f));
  float ss = 0.f;
  UNR for (int tt = 0; tt < 16; ++tt) { const float tl = (float)(t0 + tt) / (float)(L - 1); acc[tt] *= __expf(-tl * delta); ss += acc[tt] * acc[tt]; }
  float* dst = isc ? (float*)(p.ws + OFF_HRAWC) + ((size_t)(e * 4 + cb) * 512 + tid) * 256 + t0 : (float*)(p.ws + OFF_HRAW) + ((size_t)(e * 4 + cb) * 512 + tid) * 4096 + t0;
  UNR for (int q = 0; q < 4; ++q) { f32x4 v = {acc[4 * q], acc[4 * q + 1], acc[4 * q + 2], acc[4 * q + 3]}; *(f32x4*)(dst + 4 * q) = v; }
  ((float*)(p.ws + OFF_SSP))[((size_t)e * 272 + chunk) * 2048 + n] = ss;
  __syncthreads();
}

DI void job_misc(const PW& p) {
  const int tid_ = LTID(p); const int wid = __builtin_amdgcn_readfirstlane(tid_ >> 6), lane = tid_ & 63;
  float* MISC = (float*)(p.ws + OFF_MISC);
  if (wid != 0) return;
  for (int l = 0; l < 4; ++l) {
    const float mq = wave_max(fabsf(p.q_norm_g[l * 64 + lane])), mk = wave_max(fabsf(p.k_norm_g[l * 64 + lane]));
    float bound = 8.f * mq * mk;
    if ((l & 1) == 0) { float mr = 0.f; const float* rp = p.na_rpb + (size_t)(l >> 1) * 8 * 15 * 31; for (int i = lane; i < 8 * 15 * 31; i += 64) mr = fmaxf(mr, fabsf(rp[i])); bound += wave_max(mr); }
    if (lane == 0) MISC[l] = -bound * LOG2E;
  }
  for (int o = 0; o < 2; ++o) {
    const float s1 = wave_sum(p.lq1[o * 64 + lane] * p.lk1[o * 64 + lane]), s2 = wave_sum(p.lq2[o * 64 + lane] * p.lk2[o * 64 + lane]);
    const float lam_init = 0.8f - 0.6f * expf(-0.3f * (float)(2 * o + 1));
    if (lane == 0) { MISC[4 + o] = expf(s1) - expf(s2) + lam_init; MISC[6 + o] = lam_init; }
  }
}

DI void phase0(const PW& p, unsigned char* smem) {
  float* fs = (float*)smem;
  transpose_jobs(p, fs);
  constexpr int J_MOD = 4 * 48, J_FIL = 2 * 272 * 4;
  constexpr int NJ = J_MOD + J_FIL + 1;
  for (int job = lbid(); job < NJ; job += gridDim.x) {
    int j = job;
    if (j < J_MOD) { job_mod(p, j / 48, j % 48, fs, fs + 9 * 1024); continue; }
    j -= J_MOD;
    if (j < J_FIL) { const int e = j / (272 * 4), chunk = (j / 4) % 272, cb = j % 4; job_filter(p, e, chunk, cb, fs, fs + 16 * 33, fs + 16 * 33 + 1024); continue; }
    job_misc(p);
  }
}

DI void finalize_filters(const PW& p) {
  const int tid_ = LTID(p); const int wid = __builtin_amdgcn_readfirstlane(tid_ >> 6), lane = tid_ & 63;
  const float* SSP = (const float*)(p.ws + OFF_SSP);
  for (int job = lbid() * 8 + wid; job < 2048; job += gridDim.x * 8) {
    const int e = job >> 10, o = (job >> 9) & 1, c = job & 511;
    float ss = 0.f;
    for (int i = lane; i < 512; i += 64) ss += SSP[((size_t)e * 272 + (i >> 1)) * 2048 + o * 1024 + (i & 1) * 512 + c];
    ss = wave_sum(ss);
    float ssc = 0.f;
    if (lane < 32) ssc = SSP[((size_t)e * 272 + 256 + (lane >> 1)) * 2048 + o * 1024 + (lane & 1) * 512 + c];
    ssc = wave_sum(ssc);
    const float rs = 1.0f / sqrtf(ss + 1e-6f), rsc = 1.0f / sqrtf(ssc + 1e-6f);
    const float skip = p.hy_skip[(e * 2 + o) * 512 + c];
    const float* hf = (const float*)(p.ws + OFF_HRAW) + ((size_t)((e * 2 + o) * 2 + 0) * 512 + c) * 4096;
    const float* hb = (const float*)(p.ws + OFF_HRAW) + ((size_t)((e * 2 + o) * 2 + 1) * 512 + c) * 4096;
    unsigned* dst = (unsigned*)((bf16_t*)(p.ws + OFF_GREV) + ((size_t)(e * 2 + o) * 512 + c) * 8192);
    const float diag = rs * (hf[0] + hb[0]) + skip;
    _Pragma("unroll 8") for (int pp = lane * 2; pp < 8192; pp += 128) {
      float v[2];
      UNR for (int u = 0; u < 2; ++u) { const int d = 4095 - (pp + u); v[u] = d > 0 ? rs * hf[d] : (d == 0 ? diag : (d > -4096 ? rs * hb[-d] : 0.f)); }
      dst[pp >> 1] = pk2(v[0], v[1]);
    }
    const float* hfc = (const float*)(p.ws + OFF_HRAWC) + ((size_t)((e * 2 + o) * 2 + 0) * 512 + c) * 256;
    const float* hbc = (const float*)(p.ws + OFF_HRAWC) + ((size_t)((e * 2 + o) * 2 + 1) * 512 + c) * 256;
    float* gc = (float*)(p.ws + OFF_GC) + ((size_t)(e * 2 + o) * 512 + c) * 512;
    for (int q = lane; q < 512; q += 64) {
      const int d = q - 256;
      gc[q] = q == 0 ? 0.f : (d > 0 ? rsc * hfc[d] : (d == 0 ? rsc * (hfc[0] + hbc[0]) + skip : rsc * hbc[-d]));
    }
  }
}

DI void norm_phase(const PW& p, int l) {
  const int tid_ = LTID(p); const int wid = __builtin_amdgcn_readfirstlane(tid_ >> 6), lane = tid_ & 63;
  const float* MOD = (const float*)(p.ws + OFF_MOD);
  bf16_t* HN = (bf16_t*)(p.ws + OFF_HN);
  const float* xc_in = l == 0 ? p.ctx : (const float*)(p.ws + OFF_XC);
  const float* x_in = l == 0 ? p.x : p.out;
  const int nw = gridDim.x * 8;
  for (int row = lbid() * 8 + wid; row < R; row += 2 * nw) {
    const float* src[2]; const float* mv[2]; int rr[2];
    UNR for (int q = 0; q < 2; ++q) {
      rr[q] = row + q * nw; const int rq = rr[q] < R ? rr[q] : row;
      const int b = rq / TB, t = rq % TB;
      src[q] = t < SEQ ? x_in + ((size_t)b * SEQ + t) * 1024 : xc_in + ((size_t)b * NCTX + (t - SEQ)) * 1024;
      mv[q] = MOD + (size_t)(l * 9 + (t < SEQ ? b : 8)) * 3072;
    }
    f32x4 v[2][4]; float ss[2] = {0.f, 0.f};
    UNR for (int q = 0; q < 2; ++q) UNR for (int i = 0; i < 4; ++i) v[q][i] = *(const f32x4*)(src[q] + i * 256 + lane * 4);
    UNR for (int q = 0; q < 2; ++q) UNR for (int i = 0; i < 4; ++i) ss[q] += v[q][i][0] * v[q][i][0] + v[q][i][1] * v[q][i][1] + v[q][i][2] * v[q][i][2] + v[q][i][3] * v[q][i][3];
    UNR for (int o = 32; o > 0; o >>= 1) { ss[0] += shx(ss[0], o); ss[1] += shx(ss[1], o); }
    UNR for (int q = 0; q < 2; ++q) {
      if (rr[q] >= R) continue;
      const float rstd = 1.0f / sqrtf(ss[q] * (1.f / 1024.f) + 1e-6f);
      UNR for (int i = 0; i < 4; ++i) {
        const int c0 = i * 256 + lane * 4;
        const f32x4 g = *(const f32x4*)(p.norm_g + l * 1024 + c0), sh = *(const f32x4*)(mv[q] + c0), sc = *(const f32x4*)(mv[q] + 1024 + c0);
        float o[4];
        UNR for (int j = 0; j < 4; ++j) o[j] = v[q][i][j] * rstd * g[j] * (1.f + sc[j]) + sh[j];
        u32x2 w = {pk2(o[0], o[1]), pk2(o[2], o[3])};
        *(u32x2*)(HN + (size_t)rr[q] * 1024 + c0) = w;
      }
    }
  }
}

namespace pg8 {
#define PG8_LAS __attribute__((address_space(3)))
typedef unsigned short bf16_t;
typedef short bf16x8 __attribute__((ext_vector_type(8)));
typedef float f32x4 __attribute__((ext_vector_type(4)));
typedef unsigned u32x4 __attribute__((ext_vector_type(4)));
constexpr int BM = 256, BK = 64, HALF = 128, HTB = HALF * BK * 2  , STAGE_BYTES = 8 * HTB, NXCD = 8, WGM = 8;

__host__ __device__ __forceinline__ int lds_byte(int r, int c) { const int st = (r >> 4) * 2 + (c >> 5), rr = r & 15, cc = c & 31, ob = rr * 64 + cc * 2; return st * 1024 + (ob ^ (((ob >> 9) & 1) << 5)); }
__host__ __device__ __forceinline__ void stage_rc(int b, int& R, int& C) { const int st = b / 1024, sb = b % 1024, swz = sb ^ (((sb >> 9) & 1) << 5); R = (st >> 1) * 16 + swz / 64; C = (st & 1) * 32 + (swz % 64) / 2; }
__host__ __device__ __forceinline__ int perm32(int rho) { const int n = rho >> 4, i = rho & 15; return 8 * (i >> 2) + 4 * n + (i & 3); }

struct Unit { int pm, pn; };
struct Gemm { const bf16_t* A; const bf16_t* Bt; int M, N, K; };

struct StaticOrder {
    int nM, nN, nwg, G, c;
    __host__ __device__ void init(int M, int N, int G_, int c_) { nM = M / BM; nN = N / BM; nwg = nM * nN; G = G_; c = c_; }
    __host__ __device__ bool next(int i, Unit& u) const {
        const long L = (long)i * G + c; if (L >= nwg) return false;
        int wgid = (int)L; { const int q = nwg / NXCD, r = nwg % NXCD, xcd = wgid % NXCD, off = wgid / NXCD; wgid = (xcd < r ? xcd * (q + 1) : r * (q + 1) + (xcd - r) * q) + off; }
        const int nig = WGM * nN, gid = wgid / nig, fm = gid * WGM, gsz = (nM - fm) < WGM ? (nM - fm) : WGM;
        u.pm = fm + ((wgid % nig) % gsz); u.pn = (wgid % nig) / gsz; return true;
    }
    __device__ __forceinline__ void a_ready(const Unit&) const {}
    __device__ __forceinline__ void done(const Unit&) const {}
};
template <class Epi, class Sched, bool ALIGN_EPI = false, bool SP2 = false>
__device__ __forceinline__ void gemm_phase(PG8_LAS unsigned char* lds, const Gemm g, const Sched& S, const Epi& E, const int tid0) {
    const int tid = tid0, wid = __builtin_amdgcn_readfirstlane(tid >> 6), lane = tid & 63, wr = wid >> 2, wc = wid & 3, fr = lane & 15, fq = lane >> 4;
    const int K = g.K, nt = K / BK;
    unsigned voffA[2], voffB[2];
#pragma unroll
    for (int i = 0; i < 2; ++i) { int R, C; stage_rc(tid * 16 + i * 8192, R, C); const int Rb = Epi::PERM ? ((R & ~31) + perm32(R & 31)) : R;
        voffA[i] = (unsigned)(R * K + C) * 2u; voffB[i] = (unsigned)(Rb * K + C) * 2u; }
    const size_t kstep = (size_t)(BK * 2);
    const size_t hstep = (size_t)HALF * K * 2;
    const size_t tstep = 2 * hstep;
    const unsigned ldsw = (unsigned)wid * 1024u;
    const int aoff = lds_byte(wr * 64 + fr, fq * 8), boff = lds_byte(wc * 32 + fr, fq * 8);
#define PG8_SA(b, h) (((b) * 2 + (h)) * HTB)
#define PG8_SB(b, h) ((4 + (b) * 2 + (h)) * HTB)
#define PG8_STAGE(bufoff, gbase, voff) do { _Pragma("unroll") for (int _i = 0; _i < 2; ++_i) \
        __builtin_amdgcn_global_load_lds((const unsigned*)((const char*)(gbase) + (voff)[_i]), (PG8_LAS unsigned*)(lds + (bufoff) + ldsw + _i * 8192), 16, 0, 0); } while (0)
#define PG8_LDA(dst, b, h) do { _Pragma("unroll") for (int m = 0; m < 4; ++m) _Pragma("unroll") for (int k = 0; k < 2; ++k) dst[m][k] = *(const PG8_LAS bf16x8*)(lds + PG8_SA(b, h) + aoff + m * 2048 + k * 1024); } while (0)
#define PG8_LDB(dst, b, h) do { _Pragma("unroll") for (int n = 0; n < 2; ++n) _Pragma("unroll") for (int k = 0; k < 2; ++k) dst[n][k] = *(const PG8_LAS bf16x8*)(lds + PG8_SB(b, h) + boff + n * 2048 + k * 1024); } while (0)
#define PG8_MMA(ai, bj, At, Bt) do { __builtin_amdgcn_s_setprio(1); _Pragma("unroll") for (int m = 0; m < 4; ++m) _Pragma("unroll") for (int n = 0; n < 2; ++n) _Pragma("unroll") for (int k = 0; k < 2; ++k) \
        acc[ai][bj][m][n] = __builtin_amdgcn_mfma_f32_16x16x32_bf16(Bt[n][k], At[m][k], acc[ai][bj][m][n], 0, 0, 0); __builtin_amdgcn_s_setprio(0); } while (0)
#define PG8_WAIT_V(n) asm volatile("s_waitcnt vmcnt(" #n ")" ::: "memory")
#define PG8_WAIT_L(n) asm volatile("s_waitcnt lgkmcnt(" #n ")" ::: "memory")
#define PG8_BAR __builtin_amdgcn_s_barrier()
#define PG8_SCHED __builtin_amdgcn_sched_barrier(0)
    Unit cur, nxt; int ui = 0;
    if (!S.next(0, cur)) return;
    f32x4 acc[2][2][4][2];
#pragma unroll
    for (int a = 0; a < 2; ++a)
#pragma unroll
        for (int b = 0; b < 2; ++b)
#pragma unroll
            for (int m = 0; m < 4; ++m)
#pragma unroll
                for (int n = 0; n < 2; ++n) acc[a][b][m][n] = (f32x4){0.f, 0.f, 0.f, 0.f};
    bf16x8 At[4][2], B0[2][2], B1[2][2];
    const char* cA = E.normal(cur) ? (const char*)g.Bt + (size_t)cur.pn * tstep : (const char*)g.A + (size_t)cur.pm * tstep; const char* cB = E.normal(cur) ? (const char*)g.A + (size_t)cur.pm * tstep : (const char*)g.Bt + (size_t)cur.pn * tstep;
    S.a_ready(cur);
    if constexpr (SP2) {
        PG8_STAGE(PG8_SB(0, 0), cB, voffB); PG8_STAGE(PG8_SB(0, 1), cB + hstep, voffB); PG8_STAGE(PG8_SA(0, 0), cA, voffA); PG8_STAGE(PG8_SA(0, 1), cA + hstep, voffA);
        if (wr == 1) PG8_BAR;
        PG8_WAIT_V(2); PG8_BAR;
        PG8_STAGE(PG8_SB(1, 0), cB + kstep, voffB); PG8_STAGE(PG8_SA(1, 0), cA + kstep, voffA); PG8_STAGE(PG8_SB(1, 1), cB + hstep + kstep, voffB);
        PG8_WAIT_V(6); PG8_BAR;
    } else {
        PG8_STAGE(PG8_SB(0, 0), cB, voffB); PG8_STAGE(PG8_SA(0, 0), cA, voffA); PG8_STAGE(PG8_SB(0, 1), cB + hstep, voffB); PG8_STAGE(PG8_SA(0, 1), cA + hstep, voffA);
        if (wr == 1) PG8_BAR;
        PG8_WAIT_V(4); PG8_BAR;
        PG8_STAGE(PG8_SB(1, 0), cB + kstep, voffB); PG8_STAGE(PG8_SA(1, 0), cA + kstep, voffA); PG8_STAGE(PG8_SB(1, 1), cB + hstep + kstep, voffB);
        PG8_WAIT_V(6); PG8_BAR;
    }
    for (;;) {
        const bool has_next = S.next(ui + 1, nxt);
        const bool nsw = has_next && E.normal(nxt); const char* nA = has_next ? (nsw ? (const char*)g.Bt + (size_t)nxt.pn * tstep : (const char*)g.A + (size_t)nxt.pm * tstep) : cA; const char* nB = has_next ? (nsw ? (const char*)g.A + (size_t)nxt.pm * tstep : (const char*)g.Bt + (size_t)nxt.pn * tstep) : cB;
        for (int t = 0; t < nt; t += 2) {
            const bool last = (t == nt - 2);
            const char* a1 = cA + (size_t)(t + 1) * kstep;
            const char* a2 = last ? nA : cA + (size_t)(t + 2) * kstep; const char* b2 = last ? nB : cB + (size_t)(t + 2) * kstep;
            const char* a3 = a2 + kstep; const char* b3 = b2 + kstep;
            if (last && has_next) S.a_ready(nxt);
            if constexpr (SP2) {
            PG8_LDB(B0, 0, 0); PG8_LDB(B1, 0, 1); PG8_SCHED; PG8_LDA(At, 0, 0); PG8_STAGE(PG8_SA(1, 1), a1 + hstep, voffA);
            PG8_WAIT_V(8); PG8_WAIT_L(0); PG8_BAR; PG8_MMA(0, 0, At, B0); PG8_MMA(0, 1, At, B1); PG8_BAR; PG8_SCHED;
            PG8_LDA(At, 0, 1); PG8_STAGE(PG8_SB(0, 0), b2, voffB); PG8_STAGE(PG8_SB(0, 1), b2 + hstep, voffB); PG8_STAGE(PG8_SA(0, 0), a2, voffA);
            PG8_WAIT_V(8); PG8_WAIT_L(0); PG8_BAR; PG8_MMA(1, 0, At, B0); PG8_MMA(1, 1, At, B1); PG8_BAR; PG8_SCHED;
            PG8_LDB(B0, 1, 0); PG8_LDB(B1, 1, 1); PG8_SCHED; PG8_LDA(At, 1, 0); PG8_STAGE(PG8_SA(0, 1), a2 + hstep, voffA);
            PG8_WAIT_V(8); PG8_WAIT_L(0); PG8_BAR; PG8_MMA(0, 0, At, B0); PG8_MMA(0, 1, At, B1); PG8_BAR; PG8_SCHED;
            PG8_LDA(At, 1, 1); PG8_STAGE(PG8_SB(1, 0), b3, voffB); PG8_STAGE(PG8_SB(1, 1), b3 + hstep, voffB); PG8_STAGE(PG8_SA(1, 0), a3, voffA);
            PG8_WAIT_V(8); PG8_WAIT_L(0); PG8_BAR; PG8_MMA(1, 0, At, B0); PG8_MMA(1, 1, At, B1); PG8_BAR; PG8_SCHED;
            } else {
            PG8_LDB(B0, 0, 0); PG8_SCHED; PG8_LDA(At, 0, 0); PG8_STAGE(PG8_SA(1, 1), a1 + hstep, voffA);
            PG8_WAIT_L(8); PG8_BAR; PG8_WAIT_L(0); PG8_MMA(0, 0, At, B0); PG8_BAR; PG8_SCHED;
            PG8_LDB(B1, 0, 1); PG8_STAGE(PG8_SB(0, 0), b2, voffB);
            PG8_BAR; PG8_WAIT_L(0); PG8_MMA(0, 1, At, B1); PG8_BAR;
            PG8_LDA(At, 0, 1); PG8_STAGE(PG8_SA(0, 0), a2, voffA);
            PG8_BAR; PG8_WAIT_L(0); PG8_MMA(1, 0, At, B0); PG8_BAR; PG8_SCHED;
            PG8_STAGE(PG8_SB(0, 1), b2 + hstep, voffB);
            PG8_WAIT_V(6); PG8_BAR; PG8_MMA(1, 1, At, B1); PG8_BAR;
            PG8_LDB(B0, 1, 0); PG8_SCHED; PG8_LDA(At, 1, 0); PG8_STAGE(PG8_SA(0, 1), a2 + hstep, voffA);
            PG8_WAIT_L(8); PG8_BAR; PG8_WAIT_L(0); PG8_MMA(0, 0, At, B0); PG8_BAR; PG8_SCHED;
            PG8_LDB(B1, 1, 1); PG8_STAGE(PG8_SB(1, 0), b3, voffB);
            PG8_BAR; PG8_WAIT_L(0); PG8_MMA(0, 1, At, B1); PG8_BAR;
            PG8_LDA(At, 1, 1); PG8_STAGE(PG8_SA(1, 0), a3, voffA);
            PG8_BAR; PG8_WAIT_L(0); PG8_MMA(1, 0, At, B0); PG8_BAR; PG8_SCHED;
            PG8_STAGE(PG8_SB(1, 1), b3 + hstep, voffB);
            PG8_WAIT_V(6); PG8_BAR; PG8_MMA(1, 1, At, B1); PG8_BAR;
            }
        }
        if constexpr (ALIGN_EPI) { if (wr == 0) PG8_BAR; }
        if constexpr (!Epi::AFTER_DRAIN) { E(acc, cur, wr, wc, fr, fq); S.done(cur); }
        if (!has_next) break;
#pragma unroll
        for (int a = 0; a < 2; ++a)
#pragma unroll
            for (int b = 0; b < 2; ++b)
#pragma unroll
                for (int m = 0; m < 4; ++m)
#pragma unroll
                    for (int n = 0; n < 2; ++n) acc[a][b][m][n] = (f32x4){0.f, 0.f, 0.f, 0.f};
        cur = nxt; cA = nA; cB = nB; ++ui;
        if constexpr (ALIGN_EPI) { if (wr == 1) PG8_BAR; }
    }
    PG8_WAIT_V(0);
    if constexpr (!ALIGN_EPI) { if (wr == 0) PG8_BAR; }
    PG8_BAR;
    if constexpr (Epi::AFTER_DRAIN) { E.fused(acc, cur, wr, wc, fr, fq, lds, wid, lane); S.done(cur); }
#undef PG8_SA
#undef PG8_SB
#undef PG8_STAGE
#undef PG8_LDA
#undef PG8_LDB
#undef PG8_MMA
#undef PG8_WAIT_V
#undef PG8_WAIT_L
#undef PG8_BAR
#undef PG8_SCHED
}
}

typedef const f32x4 (&AccRef)[2][2][4][2];
DI void epi2_qk(AccRef acc, bf16_t* dst, int pitch, const float* g, float scale, bool rope, int tq0, int fr, int fq) {
  f32x4 g0[2], g1[2];
  UNR for (int n = 0; n < 2; ++n) { g0[n] = *(const f32x4*)(g + 16 * n + 4 * fq); g1[n] = *(const f32x4*)(g + 32 + 16 * n + 4 * fq); }
  float inv[4];
  UNR for (int e = 0; e < 4; ++e) inv[e] = __builtin_amdgcn_exp2f(-(float)(4 * fq + e) * (13.287712379549449f / 16.f)) * 0.15915494309189535f;
  float ssq[2][4];
  UNR for (int ai = 0; ai < 2; ++ai) UNR for (int m = 0; m < 4; ++m) {
    float ss = 0.f;
    UNR for (int bj = 0; bj < 2; ++bj) UNR for (int n = 0; n < 2; ++n) UNR for (int e = 0; e < 4; ++e) ss += acc[ai][bj][m][n][e] * acc[ai][bj][m][n][e];
    ssq[ai][m] = ss;
  }
  UNR for (int ai = 0; ai < 2; ++ai) UNR for (int m = 0; m < 4; ++m) ssq[ai][m] += shx(ssq[ai][m], 16);
  UNR for (int ai = 0; ai < 2; ++ai) UNR for (int m = 0; m < 4; ++m) ssq[ai][m] += shx(ssq[ai][m], 32);
  UNR for (int ai = 0; ai < 2; ++ai) UNR for (int m = 0; m < 4; ++m) {
    const int t = tq0 + 128 * ai + 16 * m + fr;
    const float rstd = scale * __builtin_amdgcn_rsqf(ssq[ai][m] * (1.f / 64.f) + 1e-6f);
    const unsigned off = (unsigned)(t * pitch + 4 * fq);
    UNR for (int n = 0; n < 2; ++n) {
      f32x4 v0 = acc[ai][0][m][n] * rstd * g0[n];
      f32x4 v1 = acc[ai][1][m][n] * rstd * g1[n];
      if (rope) {
        const int pos = n == 0 ? (t >> 6) : (t & 63);
        UNR for (int e = 0; e < 4; ++e) {
          const float rev = (float)pos * inv[e];
          const float cs = __builtin_amdgcn_cosf(rev), sn = __builtin_amdgcn_sinf(rev);
          const float x1 = v0[e], x2 = v1[e];
          v0[e] = x1 * cs - x2 * sn; v1[e] = x1 * sn + x2 * cs;
        }
      }
      u32x2 w0 = {pk2(v0[0], v0[1]), pk2(v0[2], v0[3])}, w1 = {pk2(v1[0], v1[1]), pk2(v1[2], v1[3])};
      *(u32x2*)(dst + off + 16 * n) = w0;
      *(u32x2*)(dst + off + 32 + 16 * n) = w1;
    }
    asm volatile("" ::: "memory");
  }
}
DI void epi2_gate_tok(AccRef acc, bf16_t* dst, int pitch, int fr, int fq) {
  UNR for (int ai = 0; ai < 2; ++ai) UNR for (int m = 0; m < 4; ++m) {
    const unsigned off = (unsigned)((128 * ai + 16 * m + fr) * pitch + 4 * fq);
    UNR for (int bj = 0; bj < 2; ++bj) UNR for (int n = 0; n < 2; ++n) {
      const f32x4 a = acc[ai][bj][m][n];
      u32x2 w = {pk2(silu(a[0]), silu(a[1])), pk2(silu(a[2]), silu(a[3]))};
      *(u32x2*)(dst + off + (32 * bj + 16 * n)) = w;
    }
    asm volatile("" ::: "memory");
  }
}
DI void epi2_S(AccRef acc, bf16_t* dst, unsigned chmul, bool dosilu, bool qperm, int wr, int wc, int fr, int fq_) {
  const int fq = qperm ? (((fq_ & 1) << 1) | (fq_ >> 1)) : fq_;
  UNR for (int ai = 0; ai < 2; ++ai) UNR for (int m = 0; m < 4; ++m) {
    const int ch = 64 * (2 * wr + (m >> 1)) + 32 * ai + 16 * (m & 1) + fr;
    const unsigned off = (unsigned)ch * chmul + (unsigned)(32 * wc + 4 * fq);
    UNR for (int bj = 0; bj < 2; ++bj) UNR for (int n = 0; n < 2; ++n) {
      f32x4 a = acc[ai][bj][m][n];
      if (dosilu) { a[0] = silu(a[0]); a[1] = silu(a[1]); a[2] = silu(a[2]); a[3] = silu(a[3]); }
      u32x2 w = {pk2(a[0], a[1]), pk2(a[2], a[3])};
      *(u32x2*)(dst + off + (128 * bj + 16 * n)) = w;
    }
    asm volatile("" ::: "memory");
  }
}
struct EpiIn {
  static constexpr bool PERM = false, AFTER_DRAIN = false;
  bf16_t* PB; const float* gq; const float* gk; int odd;
  DI bool normal(const pg8::Unit& u) const { const int n0 = u.pn * 256; return odd ? (n0 >= 2048 && n0 < 3072) : ((n0 >= 1024 && n0 < 3072) || n0 >= 3584); }
  DI void operator()(AccRef acc, const pg8::Unit& u, int wr, int wc, int fr_, int fq_) const {
    int fr = fr_, fq = fq_; asm volatile("" : "+v"(fr), "+v"(fq));
    const int n0 = u.pn * 256, cb = n0 + 64 * wc, b = u.pm / 17, tmi = u.pm % 17; const bool isctx = tmi == 16;
    const int tq0 = tmi * 256 + 64 * wr; const size_t row0 = (size_t)u.pm * 256 + 64 * wr;
    if (normal(u)) {
      const int t0 = tmi * 256; bf16_t* dst; unsigned chmul = (unsigned)(8 * TB); bool sl = false, qp = odd != 0;
      if (!odd) {
        if (n0 < 1536) { dst = PB + 2 * SEG + ((size_t)b * 512 + (n0 - 1024)) * TB + t0; chmul = (unsigned)TB; qp = true; }
        else if (n0 < 3072) dst = PB + 3 * SEG + ((size_t)(n0 - 1536) * 8 + b) * TB + t0;
        else { dst = PB + 7 * SEG + ((size_t)(n0 - 3584) * 8 + b) * TB + t0; sl = true; }
      } else { dst = PB + 4 * SEG + ((size_t)b * 1024 + (n0 - 2048)) * TB + t0; chmul = (unsigned)TB; }
      epi2_S(acc, dst, chmul, sl, qp, wr, wc, fr, fq);
      return;
    }
    if (n0 >= 3072) {
      const int pitch = odd ? 1024 : 512;
      epi2_gate_tok(acc, PB + 6 * SEG + row0 * pitch + (cb - 3072), pitch, fr, fq);
      return;
    }
    {
      bf16_t* dst; int pitch; const float* g; float scale; bool rope = false;
      if (!odd) {
        pitch = 64;
        if (cb < 512) { dst = PB + ((size_t)(b * 8 + (cb >> 6)) * TB) * 64; g = gq; scale = LOG2E * 0.125f; }
        else { dst = PB + SEG + ((size_t)(b * 8 + ((cb - 512) >> 6)) * TB) * 64; g = gk; scale = 1.f; }
      } else {
        pitch = 128; rope = !isctx;
        if (cb < 1024) { dst = PB + ((size_t)(b * 8 + (cb >> 7)) * TB) * 128 + ((cb >> 6) & 1) * 64; g = gq; scale = LOG2E * 0.125f; }
        else { const int c2 = cb - 1024; dst = PB + 2 * SEG + ((size_t)(b * 8 + (c2 >> 7)) * TB) * 128 + ((c2 >> 6) & 1) * 64; g = gk; scale = 1.f; }
      }
      epi2_qk(acc, dst, pitch, g, scale, rope, tq0, fr, fq);
    }
  }
};
struct EpiOut {
  static constexpr bool PERM = false, AFTER_DRAIN = false;
  const float* x_in; const float* xc_in; float* out; float* xc; const float* mod; int l;
  DI bool normal(const pg8::Unit&) const { return false; }
  DI void operator()(AccRef acc, const pg8::Unit& u, int wr, int wc, int fr, int fq) const {
    const int cb = u.pn * 256 + 64 * wc, b = u.pm / 17, tmi = u.pm % 17; const bool isctx = tmi == 16;
    if (isctx && l == 3) return;
    const float* gate = mod + (size_t)(l * 9 + (isctx ? 8 : b)) * 3072 + 2048;
    const float* src; float* dst;
    if (isctx) { src = xc_in + ((size_t)b * NCTX + 64 * wr) * 1024; dst = xc + ((size_t)b * NCTX + 64 * wr) * 1024; }
    else { const size_t o = ((size_t)b * SEQ + tmi * 256 + 64 * wr) * 1024; src = x_in + o; dst = out + o; }
    UNR for (int bj = 0; bj < 2; ++bj) {
      f32x4 xo[2][2][4], gg[2];
      UNR for (int n = 0; n < 2; ++n) {
        const int c = cb + 32 * bj + 16 * n + 4 * fq; gg[n] = *(const f32x4*)(gate + c);
        UNR for (int ai = 0; ai < 2; ++ai) UNR for (int m = 0; m < 4; ++m) xo[n][ai][m] = *(const f32x4*)(src + (size_t)(128 * ai + 16 * m + fr) * 1024 + c);
      }
      UNR for (int n = 0; n < 2; ++n) {
        const int c = cb + 32 * bj + 16 * n + 4 * fq;
        UNR for (int ai = 0; ai < 2; ++ai) UNR for (int m = 0; m < 4; ++m) *(f32x4*)(dst + (size_t)(128 * ai + 16 * m + fr) * 1024 + c) = xo[n][ai][m] + gg[n] * acc[ai][bj][m][n];
      }
      asm volatile("" ::: "memory");
    }
  }
};
struct LatentOrder : pg8::StaticOrder {
  __device__ bool next(int i, pg8::Unit& u) const { if (!pg8::StaticOrder::next(i, u)) return false; u.pm += u.pm >> 4; return true; }
};
template <int MODE>
DI void gemm_phase(const PW& p, int l, unsigned char* smem) {
  pg8::Gemm g; g.M = R; g.K = 1024;
  pg8::StaticOrder S;
  PG8_LAS unsigned char* lds = (PG8_LAS unsigned char*)smem;
  if (MODE == 2) {
    g.A = (const bf16_t*)(p.ws + OFF_Y); g.Bt = (const bf16_t*)(p.ws + OFF_WOUT) + (size_t)l * 1024 * 1024; g.N = 1024;
    S.init(R, 1024, gridDim.x, lbid());
    EpiOut E; E.x_in = l == 0 ? p.x : p.out; E.xc_in = l == 0 ? p.ctx : (const float*)(p.ws + OFF_XC); E.out = p.out; E.xc = (float*)(p.ws + OFF_XC); E.mod = (const float*)(p.ws + OFF_MOD); E.l = l;
    if (l == 3) { LatentOrder S3; S3.init(128 * 256, 1024, gridDim.x, lbid()); pg8::gemm_phase<EpiOut, LatentOrder, true, true>(lds, g, S3, E, LTID(p)); }
    else pg8::gemm_phase<EpiOut, pg8::StaticOrder, true, true>(lds, g, S, E, LTID(p));
  } else {
    g.A = (const bf16_t*)(p.ws + OFF_HN); g.Bt = (const bf16_t*)(p.ws + OFF_WIN) + (size_t)l * 4096 * 1024; g.N = 4096;
    S.init(R, 4096, gridDim.x, lbid());
    EpiIn E; E.PB = (bf16_t*)(p.ws + OFF_PB); E.gq = p.q_norm_g + l * 64; E.gk = p.k_norm_g + l * 64; E.odd = MODE;
    pg8::gemm_phase<EpiIn, pg8::StaticOrder, true, true>(lds, g, S, E, LTID(p));
  }
  __syncthreads();
}

DI void na_unit(const PW& p, int e, int b, int hd, int tq0, bool ctxq, float negM, int r, int h) {
  const bf16_t* PB = (const bf16_t*)(p.ws + OFF_PB);
  const bf16_t* Q = PB + ((size_t)(b * 8 + hd) * TB) * 64;
  const bf16_t* K = PB + SEG + ((size_t)(b * 8 + hd) * TB) * 64;
  const bf16_t* VT = PB + 2 * SEG + ((size_t)(b * 8 + hd) * 64) * TB;
  const int tq = tq0 + r;
  f32x16 O[2]; O[0] = splat16(0.f); O[1] = splat16(0.f);
  float lsum = 0.f;
  const int qrow = tq0 >> 6, qcol = tq & 63;
  const int rs = min(max(qrow - 4, 0), 56), cs = min(max(qcol - 8, 0), 48);
  const float* rpb = p.na_rpb + (size_t)(e * 8 + hd) * 15 * 31;
  constexpr int NB = 2; const int ngrp = ctxq ? 8 / NB : 24 / NB;
  _Pragma("unroll 1") for (int g = 0; g < ngrp; ++g) {
    const bool local = !ctxq && g < 16 / NB;
    bf16x8 kf[NB][4], vf[NB][4], qf[4];
    UNR for (int ks = 0; ks < 4; ++ks) qf[ks] = *(const bf16x8*)(Q + (size_t)tq * 64 + ks * 16 + h * 8);
    UNR for (int u = 0; u < NB; ++u) {
      const int it = g * NB + u;
      const int kb = local ? (rs + (it >> 1)) * 64 + (it & 1) * 32 : SEQ + (ctxq ? it : it - 16) * 32;
      UNR for (int ks = 0; ks < 4; ++ks) kf[u][ks] = *(const bf16x8*)(K + (size_t)(kb + r) * 64 + ks * 16 + h * 8);
      UNR for (int dvt = 0; dvt < 2; ++dvt) UNR for (int s2 = 0; s2 < 2; ++s2) vf[u][dvt * 2 + s2] = *(const bf16x8*)(VT + (size_t)(dvt * 32 + r) * TB + kb + s2 * 16 + 8 * h);
    }
    asm volatile("" ::: "memory");
    UNR for (int u = 0; u < NB; ++u) {
      const int it = g * NB + u;
      const int krow = rs + (it >> 1), ct = it & 1;
      f32x16 s = splat16(negM);
      UNR for (int ks = 0; ks < 4; ++ks) s = MFMA32(kf[u][ks], qf[ks], s);
      if (local) {
        const float* rp = rpb + (krow - qrow + 7) * 31;
        UNR for (int i = 0; i < 16; ++i) {
          const int kcol = ct * 32 + crow(i, h); const bool valid = kcol >= cs && kcol < cs + 16;
          const int dc = min(max(kcol - qcol + 15, 0), 30);
          const float pv = __builtin_amdgcn_exp2f(s[i] + rp[dc] * LOG2E);
          s[i] = valid ? pv : 0.f;
        }
      } else {
        UNR for (int i = 0; i < 16; ++i) s[i] = __builtin_amdgcn_exp2f(s[i]);
      }
      UNR for (int i = 0; i < 16; ++i) lsum += s[i];
      bf16x8 pf[2]; pf[0] = pack8(s, 0); pf[1] = pack8(s, 8);
      UNR for (int dvt = 0; dvt < 2; ++dvt) UNR for (int s2 = 0; s2 < 2; ++s2) O[dvt] = MFMA32(vf[u][dvt * 2 + s2], pf[s2], O[dvt]);
      asm volatile("" ::: "memory");
    }
  }
  lsum += shx(lsum, 32);
  const float inv = 1.f / lsum;
  const size_t row = (size_t)b * TB + tq;
  const bf16_t* G = PB + 6 * SEG + row * 512 + hd * 64;
  bf16_t* Y = (bf16_t*)(p.ws + OFF_Y) + row * 1024 + hd * 64;
  UNR for (int dvt = 0; dvt < 2; ++dvt) UNR for (int gq = 0; gq < 4; ++gq) {
    const int dv = dvt * 32 + 8 * gq + 4 * h;
    const u32x2 gg = *(const u32x2*)(G + dv);
    u32x2 w = {pk2(O[dvt][4 * gq] * inv * bflo(gg[0]), O[dvt][4 * gq + 1] * inv * bfhi(gg[0])), pk2(O[dvt][4 * gq + 2] * inv * bflo(gg[1]), O[dvt][4 * gq + 3] * inv * bfhi(gg[1]))};
    *(u32x2*)(Y + dv) = w;
  }
}

DI void na_block(const PW& p, int e, int b, int hd, int r0, bool ctxq, float negM, unsigned char* smem) {
  const int tid = LTID(p), wid = __builtin_amdgcn_readfirstlane(tid >> 6), lane = tid & 63, r = lane & 31, h = lane >> 5;
  const bf16_t* PB = (const bf16_t*)(p.ws + OFF_PB);
  const bf16_t* Q = PB + ((size_t)(b * 8 + hd) * TB) * 64;
  const bf16_t* K = PB + SEG + ((size_t)(b * 8 + hd) * TB) * 64;
  const bf16_t* VT = PB + 2 * SEG + ((size_t)(b * 8 + hd) * 64) * TB;
  PG8_LAS unsigned char* lds = (PG8_LAS unsigned char*)smem;
  const int qrow = ctxq ? 0 : r0 + (wid >> 1);
  const int tq0 = ctxq ? SEQ + wid * 32 : qrow * 64 + (wid & 1) * 32;
  const int tq = tq0 + r, qcol = tq & 63;
  const int rsw = min(max(qrow - 4, 0), 56), cs = min(max(qcol - 8, 0), 48);
  const int kr_lo = min(max(r0 - 4, 0), 56), kr_hi = min(max(r0 - 1, 0), 56) + 7;
  const int nloc = ctxq ? 0 : (kr_hi - kr_lo + 2) >> 1, nch = nloc + 2;
  bf16x8 qf[4];
  UNR for (int ks = 0; ks < 4; ++ks) qf[ks] = *(const bf16x8*)(Q + (size_t)tq * 64 + ks * 16 + h * 8);
  f32x16 O[2]; O[0] = splat16(0.f); O[1] = splat16(0.f);
  float lsum = 0.f;
  const float* rpb = p.na_rpb + (size_t)(e * 8 + hd) * 15 * 31;
  unsigned offK[2], offV[2];
  UNR for (int j = 0; j < 2; ++j) {
    const int s = (wid * 2 + j) * 64 + lane;
    { const int row = s >> 3, c = (s & 7) ^ ((row >> 1) & 7); offK[j] = (unsigned)(row * 64 + c * 8) * 2u; }
    { const int row = s >> 4, c = (s & 15) ^ (row & 15); offV[j] = (unsigned)(row * TB + c * 8) * 2u; }
  }
#define NA_KB(ci) ((ci) < nloc ? (kr_lo + 2 * (ci)) * 64 : SEQ + ((ci) - nloc) * 128)
#define NA_STAGE(st, ci) do { const int kb_ = NA_KB(ci); const char* kp_ = (const char*)(K + (size_t)kb_ * 64); const char* vp_ = (const char*)(VT + kb_); \
    UNR for (int j = 0; j < 2; ++j) { __builtin_amdgcn_global_load_lds((const unsigned*)(kp_ + offK[j]), (PG8_LAS unsigned*)(lds + (st) * 32768 + (wid * 2 + j) * 1024), 16, 0, 0); \
                                      __builtin_amdgcn_global_load_lds((const unsigned*)(vp_ + offV[j]), (PG8_LAS unsigned*)(lds + (st) * 32768 + 16384 + (wid * 2 + j) * 1024), 16, 0, 0); } } while (0)
  float* btab = (float*)(smem + 65536);
  __syncthreads();
  if (!ctxq && tid < 465) btab[tid] = rpb[tid] * LOG2E;
  NA_STAGE(0, 0);
  asm volatile("s_waitcnt vmcnt(0)" ::: "memory");
  __syncthreads();
  for (int ci = 0; ci < nch; ++ci) {
    if (ci + 1 < nch) NA_STAGE((ci + 1) & 1, ci + 1);
    const unsigned char* Kl = smem + (ci & 1) * 32768; const unsigned char* Vl = Kl + 16384;
    const bool local = ci < nloc;
    _Pragma("unroll 2") for (int sub = 0; sub < 4; ++sub) {
      const int krow = kr_lo + 2 * ci + (sub >> 1), ct = sub & 1;
      if (local && (krow < rsw || krow >= rsw + 8)) continue;
      f32x16 s = splat16(negM);
      const int kr_ = sub * 32 + r;
      UNR for (int ks = 0; ks < 4; ++ks) { const bf16x8 kf = *(const bf16x8*)(Kl + kr_ * 128 + (((ks * 2 + h) ^ ((kr_ >> 1) & 7)) << 4)); s = MFMA32(kf, qf[ks], s); }
      if (local) {
        const float* rp = btab + (krow - qrow + 7) * 31;
        UNR for (int i = 0; i < 16; ++i) {
          const int kcol = ct * 32 + crow(i, h); const bool valid = kcol >= cs && kcol < cs + 16;
          const int dc = min(max(kcol - qcol + 15, 0), 30);
          const float pv = __builtin_amdgcn_exp2f(s[i] + rp[dc]);
          s[i] = valid ? pv : 0.f;
        }
      } else {
        UNR for (int i = 0; i < 16; ++i) s[i] = __builtin_amdgcn_exp2f(s[i]);
      }
      UNR for (int i = 0; i < 16; ++i) lsum += s[i];
      bf16x8 pf[2]; pf[0] = pack8(s, 0); pf[1] = pack8(s, 8);
      UNR for (int dvt = 0; dvt < 2; ++dvt) UNR for (int s2 = 0; s2 < 2; ++s2) {
        const int vrow = dvt * 32 + r;
        const bf16x8 vf = *(const bf16x8*)(Vl + vrow * 256 + (((sub * 4 + s2 * 2 + h) ^ (vrow & 15)) << 4));
        O[dvt] = MFMA32(vf, pf[s2], O[dvt]);
      }
    }
    asm volatile("s_waitcnt vmcnt(0)" ::: "memory");
    __syncthreads();
  }
#undef NA_STAGE
#undef NA_KB
  lsum += shx(lsum, 32);
  const float inv = 1.f / lsum;
  const size_t row = (size_t)b * TB + tq;
  const bf16_t* G = PB + 6 * SEG + row * 512 + hd * 64;
  bf16_t* Y = (bf16_t*)(p.ws + OFF_Y) + row * 1024 + hd * 64;
  UNR for (int dvt = 0; dvt < 2; ++dvt) UNR for (int gq = 0; gq < 4; ++gq) {
    const int dv = dvt * 32 + 8 * gq + 4 * h;
    const u32x2 gg = *(const u32x2*)(G + dv);
    u32x2 w = {pk2(O[dvt][4 * gq] * inv * bflo(gg[0]), O[dvt][4 * gq + 1] * inv * bfhi(gg[0])), pk2(O[dvt][4 * gq + 2] * inv * bflo(gg[1]), O[dvt][4 * gq + 3] * inv * bfhi(gg[1]))};
    *(u32x2*)(Y + dv) = w;
  }
}

#ifndef HY_FENCE
#define HY_FENCE do { } while (0)
#endif
DI float sconv3(float um, float u0, float up, float w0, float w1, float w2, float cb) { return cb + w0 * um + w1 * u0 + w2 * up; }

DI void conv4(const bf16_t* rowp, int seq0, int len, int t0, float w0, float w1, float w2, float cb, float (&o)[4]) {
  const u32x2 m = *(const u32x2*)(rowp + seq0 + t0);
  const float um = t0 > 0 ? bf1(rowp[seq0 + t0 - 1]) : 0.f, up = t0 + 4 < len ? bf1(rowp[seq0 + t0 + 4]) : 0.f;
  const float u0 = bflo(m[0]), u1 = bfhi(m[0]), u2 = bflo(m[1]), u3 = bfhi(m[1]);
  o[0] = sconv3(um, u0, u1, w0, w1, w2, cb); o[1] = sconv3(u0, u1, u2, w0, w1, w2, cb); o[2] = sconv3(u1, u2, u3, w0, w1, w2, cb); o[3] = sconv3(u2, u3, up, w0, w1, w2, cb);
}

DI void hy_load_filter(const PW& p, int e, int o, int c, unsigned char* C0, unsigned char* C1) {
  const int tid = LTID(p);
  const bf16_t* grev = (const bf16_t*)(p.ws + OFF_GREV) + ((size_t)(e * 2 + o) * 512 + c) * 8192;
  UNR for (int i = 0; i < 2; ++i) { const int q = tid + i * 512; *(u32x4*)(C0 + q * 16) = *(const u32x4*)(grev + q * 8); }
  __syncthreads();
  const unsigned* c0d = (const unsigned*)C0; unsigned* c1d = (unsigned*)C1;
  UNR for (int i = 0; i < 8; ++i) { const int w = tid + i * 512; const unsigned a = c0d[w], bnx = w + 1 < 4096 ? c0d[w + 1] : 0u; c1d[w] = (a >> 16) | (bnx << 16); }
  __syncthreads();
}

DI u32x4 hy_loadA(const unsigned char* C0, const unsigned char* C1, int d, int off, int r, int h) {
  const int P0 = 4095 - 64 * d - off - r + 8 * h;
  const int odd = P0 & 1;
  const unsigned* ap = (const unsigned*)((odd ? C1 : C0) + (P0 - odd) * 2);
  u32x4 w = {ap[0], ap[1], ap[2], ap[3]};
  return w;
}
DI void hy_conv(f32x16 (&acc)[2][2], const unsigned char* Z, const unsigned char* ZR, const unsigned char* C0, const unsigned char* C1, int wid, int r, int h) {
  UNR for (int i = 0; i < 2; ++i) UNR for (int j = 0; j < 2; ++j) acc[i][j] = splat16(0.f);
  const int abase = wid * 8;
  const int bb = r & 7, ar = r >> 3;
  u32x4 F[6];
  int d = abase - 63;
  UNR for (int k = 0; k < 6; ++k) F[k] = hy_loadA(C0, C1, d, 32 - 16 * k, r, h);
  for (;;) {
    UNR for (int nt = 0; nt < 2; ++nt) {
      const int ap_ = abase + 4 * nt - d + ar; const bool valid = (unsigned)ap_ < 64u;
      const unsigned char* zp = valid ? Z + (ap_ * 8 + bb) * 144 + h * 16 : ZR + h * 16;
      UNR for (int ks = 0; ks < 4; ++ks) {
        const bf16x8 zf = *(const bf16x8*)(zp + ks * 32);
        acc[0][nt] = MFMA32(__builtin_bit_cast(bf16x8, F[2 + ks]), zf, acc[0][nt]);
        acc[1][nt] = MFMA32(__builtin_bit_cast(bf16x8, F[ks]), zf, acc[1][nt]);
      }
    }
    if (d == abase + 7) break;
    ++d;
    F[4] = F[0]; F[5] = F[1];
    UNR for (int k = 0; k < 4; ++k) F[k] = hy_loadA(C0, C1, d, 32 - 16 * k, r, h);
  }
}

DI void hyena_unit(const PW& p, int e, int c, unsigned char* smem) {
  const int tid = LTID(p), wid = __builtin_amdgcn_readfirstlane(tid >> 6), lane = tid & 63, r = lane & 31, h = lane >> 5;
  unsigned char* Z = smem; unsigned char* C0 = smem + 73728; unsigned char* C1 = C0 + 16384 + 64; unsigned char* ZR = smem + 106624;
  if (tid < 32) ((unsigned*)ZR)[tid] = 0u;
  const bf16_t* PB = (const bf16_t*)(p.ws + OFF_PB);
  const bf16_t* UT = PB + 3 * SEG;
  const bf16_t* GHT = PB + 7 * SEG;
  bf16_t* Y = (bf16_t*)(p.ws + OFF_Y);
  float cw[3][3], cbias[3];
  UNR for (int s = 0; s < 3; ++s) { UNR for (int j = 0; j < 3; ++j) cw[s][j] = p.hy_conv_w[(e * 3 + j) * 1536 + s * 512 + c]; cbias[s] = p.hy_conv_b[e * 1536 + s * 512 + c]; }
  __syncthreads();
  hy_load_filter(p, e, 0, c, C0, C1);
  _Pragma("unroll 4") for (int i = 0; i < 8; ++i) {
    const int cid = tid + i * 512, b = cid >> 9, t0 = (cid & 511) * 8;
    const bf16_t* rowp = UT + ((size_t)c * 8 + b) * TB;
    float o0[4], o1[4];
    conv4(rowp, 0, SEQ, t0, cw[0][0], cw[0][1], cw[0][2], cbias[0], o0);
    conv4(rowp, 0, SEQ, t0 + 4, cw[0][0], cw[0][1], cw[0][2], cbias[0], o1);
    u32x4 w = {pk2(o0[0], o0[1]), pk2(o0[2], o0[3]), pk2(o1[0], o1[1]), pk2(o1[2], o1[3])};
    *(u32x4*)(Z + ((t0 >> 6) * 8 + b) * 144 + (t0 & 63) * 2) = w;
  }
  __syncthreads();
  f32x16 acc[2][2];
#if DUP & 512
  hy_conv(acc, Z, ZR, C0, C1, wid, r, h);
  UNR for (int i_ = 0; i_ < 2; ++i_) UNR for (int j_ = 0; j_ < 2; ++j_) asm volatile("" :: "v"(acc[i_][j_]));
#endif
  hy_conv(acc, Z, ZR, C0, C1, wid, r, h);
  __syncthreads();
  {
    const int bb = r & 7;
    UNR for (int nt = 0; nt < 2; ++nt) {
      const int a = wid * 8 + 4 * nt + (r >> 3);
      const bf16_t* rowp = UT + ((size_t)(512 + c) * 8 + bb) * TB;
      UNR for (int mt = 0; mt < 2; ++mt) UNR for (int gq = 0; gq < 4; ++gq) {
        const int i0 = 32 * mt + 8 * gq + 4 * h; float x1[4];
        conv4(rowp, 0, SEQ, 64 * a + i0, cw[1][0], cw[1][1], cw[1][2], cbias[1], x1);
        u32x2 w = {pk2(x1[0] * acc[mt][nt][4 * gq], x1[1] * acc[mt][nt][4 * gq + 1]), pk2(x1[2] * acc[mt][nt][4 * gq + 2], x1[3] * acc[mt][nt][4 * gq + 3])};
        *(u32x2*)(Z + (a * 8 + bb) * 144 + i0 * 2) = w;
        HY_FENCE;
      }
    }
  }
  hy_load_filter(p, e, 1, c, C0, C1);
#if DUP & 512
  hy_conv(acc, Z, ZR, C0, C1, wid, r, h);
  UNR for (int i_ = 0; i_ < 2; ++i_) UNR for (int j_ = 0; j_ < 2; ++j_) asm volatile("" :: "v"(acc[i_][j_]));
#endif
  hy_conv(acc, Z, ZR, C0, C1, wid, r, h);
  __syncthreads();
  {
    const int bb = r & 7;
    UNR for (int nt = 0; nt < 2; ++nt) {
      const int a = wid * 8 + 4 * nt + (r >> 3);
      const bf16_t* rowp = UT + ((size_t)(1024 + c) * 8 + bb) * TB;
      const bf16_t* gp = GHT + ((size_t)c * 8 + bb) * TB;
      UNR for (int mt = 0; mt < 2; ++mt) UNR for (int gq = 0; gq < 4; ++gq) {
        const int i0 = 32 * mt + 8 * gq + 4 * h; float x2[4];
        conv4(rowp, 0, SEQ, 64 * a + i0, cw[2][0], cw[2][1], cw[2][2], cbias[2], x2);
        const u32x2 gg = *(const u32x2*)(gp + 64 * a + i0);
        u32x2 w = {pk2(x2[0] * acc[mt][nt][4 * gq] * bflo(gg[0]), x2[1] * acc[mt][nt][4 * gq + 1] * bfhi(gg[0])),
                   pk2(x2[2] * acc[mt][nt][4 * gq + 2] * bflo(gg[1]), x2[3] * acc[mt][nt][4 * gq + 3] * bfhi(gg[1]))};
        *(u32x2*)(Z + (a * 8 + bb) * 144 + i0 * 2) = w;
        HY_FENCE;
      }
    }
  }
  __syncthreads();
  {
    bf16_t* OT = (bf16_t*)(p.ws + OFF_HN);
    _Pragma("unroll 2") for (int i = 0; i < 8; ++i) {
      const int cid = tid + i * 512, b = cid >> 9, t0 = (cid & 511) * 8;
      *(u32x4*)(OT + ((size_t)c * 8 + b) * TB + t0) = *(const u32x4*)(Z + ((t0 >> 6) * 8 + b) * 144 + (t0 & 63) * 2);
    }
  }
  __syncthreads();
  {
    float* zc = (float*)smem;
    float* gl = zc + 2048;
    const int bb = tid >> 6, tq = tid & 63, t0 = 4 * tq;
    const bf16_t* r0 = UT + ((size_t)c * 8 + bb) * TB;
    const bf16_t* r1 = UT + ((size_t)(512 + c) * 8 + bb) * TB;
    const bf16_t* r2 = UT + ((size_t)(1024 + c) * 8 + bb) * TB;
    const bf16_t* gp = GHT + ((size_t)c * 8 + bb) * TB + SEQ;
    bf16_t* OTc = (bf16_t*)(p.ws + OFF_HN) + ((size_t)c * 8 + bb) * TB + SEQ;
    { float v4[4]; conv4(r0, SEQ, NCTX, t0, cw[0][0], cw[0][1], cw[0][2], cbias[0], v4);
      f32x4 vv = {v4[0], v4[1], v4[2], v4[3]}; *(f32x4*)(zc + bb * 256 + t0) = vv; }
    for (int o = 0; o < 2; ++o) {
      const float* gc = (const float*)(p.ws + OFF_GC) + ((size_t)(e * 2 + o) * 512 + c) * 512;
      gl[tid] = gc[tid];
      __syncthreads();
      f32x4 a4 = {0.f, 0.f, 0.f, 0.f};
      for (int s0 = 0; s0 < 256; s0 += 4) {
        const f32x4 zv = *(const f32x4*)(zc + bb * 256 + s0);
        const int base4 = 256 + t0 - s0;
        const f32x4 glo = *(const f32x4*)(gl + base4 - 4), ghi = *(const f32x4*)(gl + base4);
        const float G[8] = {glo[0], glo[1], glo[2], glo[3], ghi[0], ghi[1], ghi[2], ghi[3]};
        UNR for (int j = 0; j < 4; ++j) UNR for (int k = 0; k < 4; ++k) a4[j] += G[4 + j - k] * zv[k];
      }
      __syncthreads();
      float xv[4];
      conv4(o == 0 ? r1 : r2, SEQ, NCTX, t0, cw[1 + o][0], cw[1 + o][1], cw[1 + o][2], cbias[1 + o], xv);
      if (o == 0) { f32x4 zn = {xv[0] * a4[0], xv[1] * a4[1], xv[2] * a4[2], xv[3] * a4[3]}; *(f32x4*)(zc + bb * 256 + t0) = zn; }
      else {
        const u32x2 gg = *(const u32x2*)(gp + t0);
        u32x2 w = {pk2(xv[0] * a4[0] * bflo(gg[0]), xv[1] * a4[1] * bfhi(gg[0])), pk2(xv[2] * a4[2] * bflo(gg[1]), xv[3] * a4[3] * bfhi(gg[1]))};
        *(u32x2*)(OTc + t0) = w;
      }
      __syncthreads();
    }
  }
}

DI void hy_transpose_phase(const PW& p, int l, unsigned char* smem) {
  const int tid = LTID(p);
  const bf16_t* OT = (const bf16_t*)(p.ws + OFF_HN);
  bf16_t* Y = (bf16_t*)(p.ws + OFF_Y);
  unsigned* T = (unsigned*)smem;
  const int tb_per_b = l == 3 ? 64 : 68;
  const int ntile = 8 * tb_per_b * 8;
  const int cl = tid >> 3, part = tid & 7;
#define HT_SRC(tile) (OT + ((size_t)(((tile) & 7) * 64 + cl) * 8 + ((tile) >> 3) / tb_per_b) * TB + (((tile) >> 3) % tb_per_b) * 64 + part * 8)
  int tile = lbid();
  u32x4 v = {0u, 0u, 0u, 0u};
  if (tile < ntile) v = *(const u32x4*)HT_SRC(tile);
  for (; tile < ntile; tile += gridDim.x) {
    const int cbk = tile & 7, tb = tile >> 3, b = tb / tb_per_b, t0 = (tb % tb_per_b) * 64;
    UNR for (int j = 0; j < 4; ++j) T[cl * 33 + part * 4 + j] = v[j];
    const int nxt = tile + gridDim.x;
    if (nxt < ntile) v = *(const u32x4*)HT_SRC(nxt);
    __syncthreads();
    { const int tl = tid >> 3;
      const bf16_t* Tb = (const bf16_t*)T;
      unsigned short e[8];
      UNR for (int j = 0; j < 8; ++j) e[j] = Tb[(part * 8 + j) * 66 + tl];
      u32x4 w = {(unsigned)e[0] | ((unsigned)e[1] << 16), (unsigned)e[2] | ((unsigned)e[3] << 16), (unsigned)e[4] | ((unsigned)e[5] << 16), (unsigned)e[6] | ((unsigned)e[7] << 16)};
      *(u32x4*)(Y + ((size_t)b * TB + t0 + tl) * 1024 + 512 + cbk * 64 + part * 8) = w; }
    __syncthreads();
  }
#undef HT_SRC
}

DI void mixer_even(const PW& p, int l, unsigned char* smem, int what = 3) {
  const int e = l >> 1;
  if (what & 1) for (int c = lbid(); c < 512; c += gridDim.x) hyena_unit(p, e, c, smem);
  if (!(what & 2)) return;
  const float negM = ((const float*)(p.ws + OFF_MISC))[l];
  for (int u = lbid(); u < 1024 + 64; u += gridDim.x) {
    if (u < 1024) { const int rg = u & 15, hd = (u >> 4) & 7, b = u >> 7; na_block(p, e, b, hd, rg * 4, false, negM, smem); }
    else { const int v = u - 1024, hd = v & 7, b = v >> 3; na_block(p, e, b, hd, 0, true, negM, smem); }
  }
}

DI void diff_unit(const PW& p, int l, int b, int hd, int q0, int kbeg, int kend, float negM, float lam, float lam_init, unsigned char* smem) {
  const int tid = LTID(p), wid = __builtin_amdgcn_readfirstlane(tid >> 6), lane = tid & 63, r = lane & 31, h = lane >> 5, m = wid & 1, qg = wid >> 1;
  const bf16_t* PB = (const bf16_t*)(p.ws + OFF_PB);
  const bf16_t* Q = PB + ((size_t)(b * 8 + hd) * TB) * 128;
  const bf16_t* K = PB + 2 * SEG + ((size_t)(b * 8 + hd) * TB) * 128;
  const bf16_t* VT = PB + 4 * SEG + ((size_t)(b * 8 + hd) * 128) * TB;
  const int tq = q0 + qg * 32 + r;
  bf16x8 qf[4];
  UNR for (int ks = 0; ks < 4; ++ks) qf[ks] = *(const bf16x8*)(Q + (size_t)tq * 128 + m * 64 + ks * 16 + h * 8);
  f32x16 O[4];
  UNR for (int d = 0; d < 4; ++d) O[d] = splat16(0.f);
  float lsum = 0.f;
  const int kkey0 = tid >> 4, kpart = tid & 15;
  const int vdv0 = tid >> 3, vpart = tid & 7;
  u32x4 rk[2], rv[2];
  const int nt = (kend - kbeg) >> 6;
  UNR for (int i = 0; i < 2; ++i) { rk[i] = *(const u32x4*)(K + (size_t)(kbeg + kkey0 + 32 * i) * 128 + kpart * 8); rv[i] = *(const u32x4*)(VT + (size_t)(vdv0 + 64 * i) * TB + kbeg + vpart * 8); }
  UNR for (int i = 0; i < 2; ++i) { *(u32x4*)(smem + (kkey0 + 32 * i) * 272 + kpart * 16) = rk[i]; *(u32x4*)(smem + 17408 + (vdv0 + 64 * i) * 144 + vpart * 16) = rv[i]; }
  __syncthreads();
  for (int it = 0; it < nt; ++it) {
    const unsigned char* Kl = smem + (it & 1) * 35840; const unsigned char* Vl = Kl + 17408;
    if (it + 1 < nt) {
      const int k0 = kbeg + (it + 1) * 64;
      UNR for (int i = 0; i < 2; ++i) { rk[i] = *(const u32x4*)(K + (size_t)(k0 + kkey0 + 32 * i) * 128 + kpart * 8); rv[i] = *(const u32x4*)(VT + (size_t)(vdv0 + 64 * i) * TB + k0 + vpart * 8); }
    }
    {
      f32x16 s0 = splat16(negM), s1 = splat16(negM);
      UNR for (int ks = 0; ks < 4; ++ks) { const bf16x8 kf = *(const bf16x8*)(Kl + r * 272 + m * 128 + ks * 32 + h * 16); s0 = MFMA32(kf, qf[ks], s0); }
      UNR for (int ks = 0; ks < 4; ++ks) { const bf16x8 kf = *(const bf16x8*)(Kl + (32 + r) * 272 + m * 128 + ks * 32 + h * 16); s1 = MFMA32(kf, qf[ks], s1); }
      UNR for (int i = 0; i < 16; ++i) { s0[i] = __builtin_amdgcn_exp2f(s0[i]); lsum += s0[i]; }
      bf16x8 pf0[2]; pf0[0] = pack8(s0, 0); pf0[1] = pack8(s0, 8);
      __builtin_amdgcn_sched_barrier(0);
      UNR for (int dvt = 0; dvt < 4; ++dvt) UNR for (int s2 = 0; s2 < 2; ++s2) {
        const bf16x8 vf = *(const bf16x8*)(Vl + (dvt * 32 + r) * 144 + (s2 * 16 + 8 * h) * 2);
        O[dvt] = MFMA32(vf, pf0[s2], O[dvt]);
      }
      UNR for (int i = 0; i < 16; ++i) { s1[i] = __builtin_amdgcn_exp2f(s1[i]); lsum += s1[i]; }
      bf16x8 pf1[2]; pf1[0] = pack8(s1, 0); pf1[1] = pack8(s1, 8);
      UNR for (int g = 0; g < 8; ++g) { __builtin_amdgcn_sched_group_barrier(0x008, 1, 0); __builtin_amdgcn_sched_group_barrier(0x002, 5, 0); }
      __builtin_amdgcn_sched_barrier(0);
      UNR for (int dvt = 0; dvt < 4; ++dvt) UNR for (int s2 = 0; s2 < 2; ++s2) {
        const bf16x8 vf = *(const bf16x8*)(Vl + (dvt * 32 + r) * 144 + (32 + s2 * 16 + 8 * h) * 2);
        O[dvt] = MFMA32(vf, pf1[s2], O[dvt]);
      }
    }
    if (it + 1 < nt) {
      unsigned char* nx = smem + ((it + 1) & 1) * 35840;
      UNR for (int i = 0; i < 2; ++i) { *(u32x4*)(nx + (kkey0 + 32 * i) * 272 + kpart * 16) = rk[i]; *(u32x4*)(nx + 17408 + (vdv0 + 64 * i) * 144 + vpart * 16) = rv[i]; }
    }
    __syncthreads();
  }
  lsum += shx(lsum, 32);
  float* X = (float*)smem + qg * 4096;
  if (m == 1) {
    const float sc = lam / lsum;
    UNR for (int d = 0; d < 4; ++d) UNR for (int i = 0; i < 16; ++i) X[(d * 16 + i) * 64 + lane] = O[d][i] * sc;
  }
  __syncthreads();
  if (m == 0) {
    const float i0 = 1.f / lsum;
    float ss = 0.f;
    UNR for (int d = 0; d < 4; ++d) UNR for (int i = 0; i < 16; ++i) { const float o = O[d][i] * i0 - X[(d * 16 + i) * 64 + lane]; O[d][i] = o; ss += o * o; }
    ss += shx(ss, 32);
    const float rstd = (1.0f / sqrtf(ss * (1.f / 128.f) + 1e-6f)) * (1.f - lam_init);
    const size_t row = (size_t)b * TB + tq;
    const bf16_t* G = PB + 6 * SEG + row * 1024 + hd * 128;
    bf16_t* Y = (bf16_t*)(p.ws + OFF_Y) + row * 1024 + hd * 128;
    const float* sg = p.subln_g + (l >> 1) * 128;
    UNR for (int d = 0; d < 4; ++d) UNR for (int gq = 0; gq < 4; ++gq) {
      const int dv = d * 32 + 8 * gq + 4 * h;
      const u32x2 gg = *(const u32x2*)(G + dv); const f32x4 s4 = *(const f32x4*)(sg + dv);
      u32x2 w = {pk2(O[d][4 * gq] * rstd * s4[0] * bflo(gg[0]), O[d][4 * gq + 1] * rstd * s4[1] * bfhi(gg[0])),
                 pk2(O[d][4 * gq + 2] * rstd * s4[2] * bflo(gg[1]), O[d][4 * gq + 3] * rstd * s4[3] * bfhi(gg[1]))};
      *(u32x2*)(Y + dv) = w;
    }
  }
  __syncthreads();
}

DI void mixer_odd(const PW& p, int l, unsigned char* smem) {
  const float* MISC = (const float*)(p.ws + OFF_MISC);
  const float negM = MISC[l], lam = MISC[4 + (l >> 1)], lam_init = MISC[6 + (l >> 1)];
  const int nun = l < 3 ? 2048 + 128 : 2048;
  for (int u = lbid(); u < nun; u += gridDim.x) {
    if (u < 2048) { const int qb = u & 31, hd = (u >> 5) & 7, b = u >> 8; diff_unit(p, l, b, hd, qb * 128, 0, TB, negM, lam, lam_init, smem); }
    else { const int v = u - 2048, qb = v & 1, hd = (v >> 1) & 7, b = v >> 4; diff_unit(p, l, b, hd, SEQ + qb * 128, SEQ, TB, negM, lam, lam_init, smem); }
  }
}

#define XB_TMO      128
#define XB_XCNT(j)  (256  + 64 * (j))
#define XB_XSUB(j)  (1280 + 64 * (j))
#define XB_XGEN(j)  (2304 + 64 * (j))
#define XB_TOP      3328
#define XB_TOPGEN   3392
#define XCD_BAR_WORDS 3456
#define XB_SPIN_CAP (1u << 18)
#ifndef LAS
#define LAS __attribute__((address_space(3)))
#endif

__device__ __forceinline__ unsigned xb_ld(unsigned* p)              { return __hip_atomic_load(p, __ATOMIC_RELAXED, __HIP_MEMORY_SCOPE_AGENT); }
__device__ __forceinline__ unsigned xb_add(unsigned* p, unsigned v) { return __hip_atomic_fetch_add(p, v, __ATOMIC_RELAXED, __HIP_MEMORY_SCOPE_AGENT); }
__device__ __forceinline__ unsigned xb_xcc_id() { return (unsigned)__builtin_amdgcn_s_getreg((3 << 11) | 20) & 0xFu; }
#define XB_SPIN(cond, bar) do { unsigned _sp = 0; while (cond) { __builtin_amdgcn_s_sleep(1); \
    if ((++_sp & 255u) == 0u) { if (xb_ld(&(bar)[XB_TMO])) break; if (_sp > XB_SPIN_CAP) { atomicAdd(&(bar)[XB_TMO], 1u); break; } } } } while (0)

struct XcdBarrier {
    unsigned* bar; unsigned x;
    volatile LAS unsigned* st;
};

__device__ __forceinline__ XcdBarrier xcd_barrier_post(unsigned* bar, volatile LAS unsigned* st) {
    XcdBarrier b; b.bar = bar; b.x = xb_xcc_id(); b.st = st;
    if (threadIdx.x == 0) (void)xb_add(&bar[XB_XCNT(b.x)], 1u);
    return b;
}
__device__ __forceinline__ void xcd_barrier_complete(unsigned* bar, unsigned x, unsigned& nloc, unsigned& nx) {
    const unsigned G = gridDim.x * gridDim.y * gridDim.z;
    unsigned sum, cnt, mine, sp = 0u;
    for (;;) {
        sum = 0u; cnt = 0u; mine = 0u;
#pragma unroll
        for (unsigned j = 0; j < 16; ++j) { const unsigned c = xb_ld(&bar[XB_XCNT(j)]); sum += c; cnt += (c > 0u) ? 1u : 0u; mine = (j == x) ? c : mine; }
        if (sum == G) break;
        __builtin_amdgcn_s_sleep(1);
        if ((++sp & 255u) == 0u) { if (xb_ld(&bar[XB_TMO])) break; if (sp > XB_SPIN_CAP) { atomicAdd(&bar[XB_TMO], 1u); break; } }
    }
    nloc = mine > 0u ? mine : 1u; nx = cnt > 0u ? cnt : 1u;
}

__device__ __forceinline__ void xcd_barrier(const XcdBarrier& b) {
    asm volatile("s_waitcnt vmcnt(0)" ::: "memory");
    __syncthreads();
    if (threadIdx.x == 0) {
        unsigned* bar = b.bar;
        __builtin_amdgcn_s_waitcnt(0);
        unsigned nloc = b.st[0], nx = b.st[1];
        if (nloc == 0u) { xcd_barrier_complete(bar, b.x, nloc, nx); b.st[0] = nloc; b.st[1] = nx; }
        const unsigned old = xb_add(&bar[XB_XSUB(b.x)], 1u);
        const unsigned gen = old / nloc;
        if (old + 1u == (gen + 1u) * nloc) {
            __builtin_amdgcn_fence(__ATOMIC_RELEASE, "agent");
            asm volatile("s_waitcnt vmcnt(0)" ::: "memory");
            const unsigned og = xb_add(&bar[XB_TOP], 1u);
            const unsigned tg = og / nx;
            if (og + 1u == (tg + 1u) * nx) xb_add(&bar[XB_TOPGEN], 1u);
            else XB_SPIN(xb_ld(&bar[XB_TOPGEN]) == tg, bar);
            __builtin_amdgcn_fence(__ATOMIC_ACQUIRE, "agent");
            xb_add(&bar[XB_XGEN(b.x)], 1u);
            asm volatile("s_waitcnt vmcnt(0)" ::: "memory");
        } else {
            XB_SPIN(xb_ld(&bar[XB_XGEN(b.x)]) == gen, bar);
            __builtin_amdgcn_fence(__ATOMIC_ACQUIRE, "agent");
            asm volatile("s_waitcnt vmcnt(0)" ::: "memory");
        }
    }
    __syncthreads();
}

typedef const Params __attribute__((address_space(4))) KParams;
DI void load_params(PW& q, KParams* k) { q.x = k->x; q.c = k->c; q.ctx = k->ctx; q.c_ctx = k->c_ctx; q.norm_g = k->norm_g; q.w_mod = k->w_mod; q.b_mod = k->b_mod; q.w_in = k->w_in; q.w_out = k->w_out; q.q_norm_g = k->q_norm_g; q.k_norm_g = k->k_norm_g; q.na_rpb = k->na_rpb; q.hy_conv_w = k->hy_conv_w; q.hy_conv_b = k->hy_conv_b; q.f_w1 = k->f_w1; q.f_b1 = k->f_b1; q.f_freq = k->f_freq; q.f_w2 = k->f_w2; q.f_b2 = k->f_b2; q.f_w3 = k->f_w3; q.f_b3 = k->f_b3; q.hy_skip = k->hy_skip; q.lq1 = k->lq1; q.lk1 = k->lk1; q.lq2 = k->lq2; q.lk2 = k->lk2; q.subln_g = k->subln_g; q.out = k->out; q.ws = k->ws; }
#define LAUNDER() do { ll = l; asm volatile("" : "+s"(ll)); KParams* k_ = kp; asm volatile("" : "+s"(k_)); load_params(q, k_); int w_ = wid0; asm volatile("" : "+s"(w_)); q.wid0 = w_; } while (0)
__global__ void __launch_bounds__(512) mega(Params p) {
  __shared__ __attribute__((aligned(16))) unsigned char smem[131072];
  __shared__ __attribute__((aligned(16))) unsigned xb_st[4];
  cg::grid_group grid = cg::this_grid();
  if (threadIdx.x < 4) xb_st[threadIdx.x] = 0u;
  __syncthreads();
  KParams* kp = (KParams*)__builtin_amdgcn_kernarg_segment_ptr();
  const int wid0 = __builtin_amdgcn_readfirstlane((int)(threadIdx.x >> 6));
  PW q; int ll = 0;
  { int l = 0; LAUNDER(); }
  if (blockIdx.x == 0) for (int i = threadIdx.x; i < 4096; i += 512) ((unsigned*)(q.ws + OFF_BAR))[i] = 0u;
  phase0(q, smem);
#if DUP & 8
  { int l = 0; LAUNDER(); phase0(q, smem); }
#endif
  grid.sync();
  const XcdBarrier xbar = xcd_barrier_post((unsigned*)(q.ws + OFF_BAR), (volatile LAS unsigned*)xb_st);
  for (int l = 0; l < 4; ++l) {
    LAUNDER();
    if (l == 0) finalize_filters(q);
    norm_phase(q, ll);
#if DUP & 16
    LAUNDER(); norm_phase(q, ll);
#endif
    xcd_barrier(xbar);
    LAUNDER();
    if (ll & 1) gemm_phase<1>(q, ll, smem); else gemm_phase<0>(q, ll, smem);
#if DUP & 1
    LAUNDER();
    if (ll & 1) gemm_phase<1>(q, ll, smem); else gemm_phase<0>(q, ll, smem);
#endif
    xcd_barrier(xbar);
    LAUNDER();
    if (ll & 1) mixer_odd(q, ll, smem); else mixer_even(q, ll, smem);
#if DUP & 2
    LAUNDER();
    if (!(ll & 1)) mixer_even(q, ll, smem);
#endif
#if DUP & 128
    LAUNDER();
    if (!(ll & 1)) mixer_even(q, ll, smem, 1);
#endif
#if DUP & 256
    LAUNDER();
    if (!(ll & 1)) mixer_even(q, ll, smem, 2);
#endif
#if DUP & 4
    LAUNDER();
    if (ll & 1) mixer_odd(q, ll, smem);
#endif
    xcd_barrier(xbar);
    LAUNDER();
    if (!(ll & 1)) { hy_transpose_phase(q, ll, smem); xcd_barrier(xbar); LAUNDER(); }
    gemm_phase<2>(q, ll, smem);
#if DUP & 32
    xcd_barrier(xbar); xcd_barrier(xbar); xcd_barrier(xbar); xcd_barrier(xbar);
#endif
#if DUP & 64
    if (l == 0) { LAUNDER(); gemm_phase<2>(q, ll, smem); }
#endif
    if (l < 3) xcd_barrier(xbar);
  }
}

extern "C" void kernel_launch(void* const* d_in, const int* in_sizes, int n_in, void* d_out, int out_size,
                              void* d_ws, size_t ws_size, hipStream_t stream) {
  static int grid_blocks = 0;
  if (!grid_blocks) {
    int dev = 0, cus = 0, per_cu = 0;
    (void)hipGetDevice(&dev);
    (void)hipDeviceGetAttribute(&cus, hipDeviceAttributeMultiprocessorCount, dev);
    (void)hipOccupancyMaxActiveBlocksPerMultiprocessor(&per_cu, mega, 512, 0);
    if (per_cu > 1) per_cu = 1;
    grid_blocks = cus * per_cu;
  }
  if (ws_size < WS_NEED) { fprintf(stderr, "workspace too small: %zu < %zu\n", ws_size, (size_t)WS_NEED); return; }
  Params p{};
  const float** pp = (const float**)&p;
  for (int i = 0; i < 27; ++i) pp[i] = (const float*)d_in[i];
  p.out = (float*)d_out; p.ws = (unsigned char*)d_ws;
  void* args[] = {&p};
  hipError_t e = hipLaunchCooperativeKernel((void*)mega, dim3(grid_blocks), dim3(512), args, 0, stream);
  if (e != hipSuccess) fprintf(stderr, "coop launch failed: %s (grid %d)\n", hipGetErrorString(e), grid_blocks);
}
```

```cpp
#ifndef DUP
#define DUP 0
#endif
#include <hip/hip_runtime.h>
#include <hip/hip_cooperative_groups.h>
#include <cstdio>
namespace cg = cooperative_groups;

typedef unsigned short bf16_t;
typedef short bf16x8 __attribute__((ext_vector_type(8)));
typedef float f32x16 __attribute__((ext_vector_type(16)));
typedef float f32x4 __attribute__((ext_vector_type(4)));
typedef unsigned u32x4 __attribute__((ext_vector_type(4)));
typedef unsigned u32x2 __attribute__((ext_vector_type(2)));
typedef __bf16 bf16v2 __attribute__((ext_vector_type(2)));
#define DI __device__ __forceinline__
#define MFMA32(a, b, c) __builtin_amdgcn_mfma_f32_32x32x16_bf16((a), (b), (c), 0, 0, 0)
#define UNR _Pragma("unroll")

constexpr int R = 34816, TB = 4352, SEQ = 4096, NCTX = 256;
constexpr float LOG2E = 1.4426950408889634f;
constexpr size_t SEG = (size_t)R * 512;
constexpr size_t OFF_WIN = 0;
constexpr size_t OFF_WOUT = OFF_WIN + 4ull * 4096 * 1024 * 2;
constexpr size_t OFF_MOD = OFF_WOUT + 4ull * 1024 * 1024 * 2;
constexpr size_t OFF_HN = OFF_MOD + 4ull * 9 * 3072 * 4;
constexpr size_t OFF_PB = OFF_HN + (size_t)R * 1024 * 2;
constexpr size_t OFF_Y = OFF_PB + (size_t)R * 4096 * 2;
constexpr size_t OFF_XC = OFF_Y + (size_t)R * 1024 * 2;
constexpr size_t OFF_GREV = OFF_XC + 8ull * 256 * 1024 * 4;
constexpr size_t OFF_GC = OFF_GREV + 2ull * 2 * 512 * 8192 * 2;
constexpr size_t OFF_MISC = OFF_GC + 2ull * 2 * 512 * 512 * 4;
constexpr size_t OFF_BAR = OFF_MISC + 4096;
constexpr size_t WS_NEED = OFF_BAR + 16384;
constexpr size_t OFF_HRAW = OFF_PB;
constexpr size_t OFF_HRAWC = OFF_HRAW + 2ull * 2 * 2 * 512 * 4096 * 4;
constexpr size_t OFF_SSP = OFF_HRAWC + 2ull * 2 * 2 * 512 * 256 * 4;

struct Params {
  const float *x, *c, *ctx, *c_ctx, *norm_g, *w_mod, *b_mod, *w_in, *w_out, *q_norm_g, *k_norm_g, *na_rpb, *hy_conv_w, *hy_conv_b,
      *f_w1, *f_b1, *f_freq, *f_w2, *f_b2, *f_w3, *f_b3, *hy_skip, *lq1, *lk1, *lq2, *lk2, *subln_g;
  float* out;
  unsigned char* ws;
};
struct PW : Params { int wid0; };

DI unsigned pk2(float a, float b) { bf16v2 v = {(__bf16)a, (__bf16)b}; return __builtin_bit_cast(unsigned, v); }
DI float bflo(unsigned u) { return __uint_as_float(u << 16); }
DI float bfhi(unsigned u) { return __uint_as_float(u & 0xffff0000u); }
DI float bf1(bf16_t u) { return __uint_as_float((unsigned)u << 16); }
DI int crow(int reg, int h) { return (reg & 3) + 8 * (reg >> 2) + 4 * h; }
DI float silu(float x) { return x / (1.f + __expf(-x)); }
DI int lane_l() { int l = __builtin_amdgcn_mbcnt_hi(~0u, __builtin_amdgcn_mbcnt_lo(~0u, 0u)); asm volatile("" : "+v"(l)); return l; }
DI float shx(float v, int o) { return __int_as_float(__builtin_amdgcn_ds_bpermute((lane_l() ^ o) << 2, __float_as_int(v))); }
DI float wave_sum(float v) { UNR for (int o = 32; o > 0; o >>= 1) v += shx(v, o); return v; }
DI float wave_max(float v) { UNR for (int o = 32; o > 0; o >>= 1) v = fmaxf(v, shx(v, o)); return v; }
DI f32x16 splat16(float v) { f32x16 r; UNR for (int i = 0; i < 16; ++i) r[i] = v; return r; }
DI bf16x8 pack8(const f32x16& s, int o) {
  u32x4 w; w[0] = pk2(s[o], s[o + 1]); w[1] = pk2(s[o + 2], s[o + 3]); w[2] = pk2(s[o + 4], s[o + 5]); w[3] = pk2(s[o + 6], s[o + 7]);
  return __builtin_bit_cast(bf16x8, w);
}

#define LTID(p) (((p).wid0 << 6) | lane_l())
DI int lbid() { int b = blockIdx.x; asm volatile("" : "+s"(b)); return b; }
DI void transpose_jobs(const PW& p, float* tile) {
  const int tid = LTID(p);
  constexpr int J_TIN = 4 * 16 * 64, J_ALL = J_TIN + 4 * 16 * 16;
  const int kk = tid >> 4, n4 = (tid & 15) * 4, n = tid >> 3, kc = tid & 7;
#define TJ_SRC(j, pass) ((j) < J_TIN ? p.w_in + (size_t)((j) >> 10) * 1024 * 4096 + (size_t)((((j) >> 6) & 15) * 64 + (pass) * 32 + kk) * 4096 + ((j) & 63) * 64 + n4 \
                                     : p.w_out + (size_t)(((j) - J_TIN) >> 8) * 1024 * 1024 + (size_t)(((((j) - J_TIN) >> 4) & 15) * 64 + (pass) * 32 + kk) * 1024 + (((j) - J_TIN) & 15) * 64 + n4)
  int j = lbid();
  f32x4 v0 = {0.f, 0.f, 0.f, 0.f}, v1 = v0;
  if (j < J_ALL) { v0 = *(const f32x4*)TJ_SRC(j, 0); v1 = *(const f32x4*)TJ_SRC(j, 1); }
  for (; j < J_ALL; j += gridDim.x) {
    UNR for (int e = 0; e < 4; ++e) { tile[kk * 65 + n4 + e] = v0[e]; tile[(32 + kk) * 65 + n4 + e] = v1[e]; }
    const int jn = j + gridDim.x;
    if (jn < J_ALL) { v0 = *(const f32x4*)TJ_SRC(jn, 0); v1 = *(const f32x4*)TJ_SRC(jn, 1); }
    __syncthreads();
    u32x4 w;
    UNR for (int q = 0; q < 4; ++q) w[q] = pk2(tile[(kc * 8 + 2 * q) * 65 + n], tile[(kc * 8 + 2 * q + 1) * 65 + n]);
    const bool isin = j < J_TIN; const int jj = isin ? j : j - J_TIN;
    const int l = isin ? jj >> 10 : jj >> 8, tk = isin ? (jj >> 6) & 15 : (jj >> 4) & 15, tn = isin ? jj & 63 : jj & 15;
    bf16_t* Wt = isin ? (bf16_t*)(p.ws + OFF_WIN) + (size_t)l * 4096 * 1024 : (bf16_t*)(p.ws + OFF_WOUT) + (size_t)l * 1024 * 1024;
    { const int cn = tn * 64 + n, c = cn & 255; const int pos = (cn & ~255) + 128 * ((c >> 5) & 1) + 32 * (c >> 6) + (c & 31);
      *(u32x4*)(Wt + (size_t)pos * 1024 + tk * 64 + kc * 8) = w; }
    __syncthreads();
  }
#undef TJ_SRC
}

DI void job_mod(const PW& p, int l, int cgp, float* sv, float* red) {
  const int tid = LTID(p);
  float* MOD = (float*)(p.ws + OFF_MOD);
  for (int i = tid; i < 9 * 1024; i += 512) { const int v = i >> 10, k = i & 1023; const float c = v < 8 ? p.c[v * 1024 + k] : p.c_ctx[k]; sv[i] = silu(c); }
  __syncthreads();
  const int kg = tid >> 6, cn = tid & 63, n = cgp * 64 + cn;
  float acc[9];
  UNR for (int v = 0; v < 9; ++v) acc[v] = 0.f;
  const float* W = p.w_mod + (size_t)l * 1024 * 3072 + n;
  for (int k = kg * 128; k < kg * 128 + 128; k += 16) {
    float w[16];
    UNR for (int u = 0; u < 16; ++u) w[u] = W[(size_t)(k + u) * 3072];
    UNR for (int v = 0; v < 9; ++v) UNR for (int u4 = 0; u4 < 4; ++u4) { const f32x4 s4 = *(const f32x4*)(sv + v * 1024 + k + u4 * 4); UNR for (int j = 0; j < 4; ++j) acc[v] += s4[j] * w[u4 * 4 + j]; }
  }
  UNR for (int v = 0; v < 9; ++v) red[(kg * 9 + v) * 64 + cn] = acc[v];
  __syncthreads();
  for (int i = tid; i < 9 * 64; i += 512) {
    const int v = i >> 6, c2 = i & 63; float s = 0.f;
    UNR for (int g = 0; g < 8; ++g) s += red[(g * 9 + v) * 64 + c2];
    MOD[(l * 9 + v) * 3072 + cgp * 64 + c2] = s + p.b_mod[l * 3072 + cgp * 64 + c2];
  }
  __syncthreads();
}

DI void job_filter(const PW& p, int e, int chunk, int cb, float* zs, float* h1, float* h2) {
  const int tid = LTID(p);
  const bool isc = chunk >= 256; const int L = isc ? 256 : 4096; const int t0 = (isc ? chunk - 256 : chunk) * 16;
  for (int i = tid; i < 16 * 33; i += 512) {
    const int tt = i / 33, f = i % 33, t = t0 + tt; float val;
    if (f == 0) val = (float)t / (float)(L - 1);
    else { const int k = (f - 1) & 15; const float fb = 1e-4f + (float)k * ((15.f - 1e-4f) / 15.f); float rev = fb * (float)t / (float)L; rev -= floorf(rev);
           val = f <= 16 ? __builtin_amdgcn_cosf(rev) : -__builtin_amdgcn_sinf(rev); }
    zs[i] = val;
  }
  __syncthreads();
  for (int i = tid; i < 1024; i += 512) {
    const int tt = i >> 6, j = i & 63; float a = p.f_b1[e * 64 + j];
    for (int f = 0; f < 33; ++f) a += zs[tt * 33 + f] * p.f_w1[(e * 33 + f) * 64 + j];
    h1[i] = __sinf(p.f_freq[e * 64 + j] * a);
  }
  __syncthreads();
  for (int i = tid; i < 1024; i += 512) {
    const int tt = i >> 6, j = i & 63; float a = p.f_b2[e * 64 + j];
    for (int k = 0; k < 64; ++k) a += h1[tt * 64 + k] * p.f_w2[(e * 64 + k) * 64 + j];
    h2[j * 16 + tt] = __sinf(p.f_freq[e * 64 + j] * a);
  }
  __syncthreads();
  const int n = cb * 512 + tid;
  float acc[16];
  { const float b3 = p.f_b3[e * 2048 + n]; UNR for (int tt = 0; tt < 16; ++tt) acc[tt] = b3; }
  _Pragma("unroll 4") for (int k = 0; k < 64; ++k) {
    const float w = p.f_w3[((size_t)e * 64 + k) * 2048 + n];
    UNR for (int q4 = 0; q4 < 4; ++q4) { const f32x4 hv = *(const f32x4*)(h2 + k * 16 + q4 * 4); UNR for (int j = 0; j < 4; ++j) acc[q4 * 4 + j] += hv[j] * w; }
  }
  const float mind = logf(1e-2f) / 1.5f, maxd = logf(1e-2f) / 0.3f;
  const float delta = fabsf(mind + (float)tid * ((maxd - mind) / 511.f));
  float ss = 0.f;
  UNR for (int tt = 0; tt < 16; ++tt) { const float tl = (float)(t0 + tt) / (float)(L - 1); acc[tt] *= __expf(-tl * delta); ss += acc[tt] * acc[tt]; }
  float* dst = isc ? (float*)(p.ws + OFF_HRAWC) + ((size_t)(e * 4 + cb) * 512 + tid) * 256 + t0 : (float*)(p.ws + OFF_HRAW) + ((size_t)(e * 4 + cb) * 512 + tid) * 4096 + t0;
  UNR for (int q = 0; q < 4; ++q) { f32x4 v = {acc[4 * q], acc[4 * q + 1], acc[4 * q + 2], acc[4 * q + 3]}; *(f32x4*)(dst + 4 * q) = v; }
  ((float*)(p.ws + OFF_SSP))[((size_t)e * 272 + chunk) * 2048 + n] = ss;
  __syncthreads();
}

DI void job_misc(const PW& p) {
  const int tid_ = LTID(p); const int wid = __builtin_amdgcn_readfirstlane(tid_ >> 6), lane = tid_ & 63;
  float* MISC = (float*)(p.ws + OFF_MISC);
  if (wid != 0) return;
  for (int l = 0; l < 4; ++l) {
    const float mq = wave_max(fabsf(p.q_norm_g[l * 64 + lane])), mk = wave_max(fabsf(p.k_norm_g[l * 64 + lane]));
    float bound = 8.f * mq * mk;
    if ((l & 1) == 0) { float mr = 0.f; const float* rp = p.na_rpb + (size_t)(l >> 1) * 8 * 15 * 31; for (int i = lane; i < 8 * 15 * 31; i += 64) mr = fmaxf(mr, fabsf(rp[i])); bound += wave_max(mr); }
    if (lane == 0) MISC[l] = -bound * LOG2E;
  }
  for (int o = 0; o < 2; ++o) {
    const float s1 = wave_sum(p.lq1[o * 64 + lane] * p.lk1[o * 64 + lane]), s2 = wave_sum(p.lq2[o * 64 + lane] * p.lk2[o * 64 + lane]);
    const float lam_init = 0.8f - 0.6f * expf(-0.3f * (float)(2 * o + 1));
    if (lane == 0) { MISC[4 + o] = expf(s1) - expf(s2) + lam_init; MISC[6 + o] = lam_init; }
  }
}

DI void phase0(const PW& p, unsigned char* smem) {
  float* fs = (float*)smem;
  transpose_jobs(p, fs);
  constexpr int J_MOD = 4 * 48, J_FIL = 2 * 272 * 4;
  constexpr int NJ = J_MOD + J_FIL + 1;
  for (int job = lbid(); job < NJ; job += gridDim.x) {
    int j = job;
    if (j < J_MOD) { job_mod(p, j / 48, j % 48, fs, fs + 9 * 1024); continue; }
    j -= J_MOD;
    if (j < J_FIL) { const int e = j / (272 * 4), chunk = (j / 4) % 272, cb = j % 4; job_filter(p, e, chunk, cb, fs, fs + 16 * 33, fs + 16 * 33 + 1024); continue; }
    job_misc(p);
  }
}

DI void finalize_filters(const PW& p) {
  const int tid_ = LTID(p); const int wid = __builtin_amdgcn_readfirstlane(tid_ >> 6), lane = tid_ & 63;
  const float* SSP = (const float*)(p.ws + OFF_SSP);
  for (int job = lbid() * 8 + wid; job < 2048; job += gridDim.x * 8) {
    const int e = job >> 10, o = (job >> 9) & 1, c = job & 511;
    float ss = 0.f;
    for (int i = lane; i < 512; i += 64) ss += SSP[((size_t)e * 272 + (i >> 1)) * 2048 + o * 1024 + (i & 1) * 512 + c];
    ss = wave_sum(ss);
    float ssc = 0.f;
    if (lane < 32) ssc = SSP[((size_t)e * 272 + 256 + (lane >> 1)) * 2048 + o * 1024 + (lane & 1) * 512 + c];
    ssc = wave_sum(ssc);
    const float rs = 1.0f / sqrtf(ss + 1e-6f), rsc = 1.0f / sqrtf(ssc + 1e-6f);
    const float skip = p.hy_skip[(e * 2 + o) * 512 + c];
    const float* hf = (const float*)(p.ws + OFF_HRAW) + ((size_t)((e * 2 + o) * 2 + 0) * 512 + c) * 4096;
    const float* hb = (const float*)(p.ws + OFF_HRAW) + ((size_t)((e * 2 + o) * 2 + 1) * 512 + c) * 4096;
    unsigned* dst = (unsigned*)((bf16_t*)(p.ws + OFF_GREV) + ((size_t)(e * 2 + o) * 512 + c) * 8192);
    const float diag = rs * (hf[0] + hb[0]) + skip;
    _Pragma("unroll 8") for (int pp = lane * 2; pp < 8192; pp += 128) {
      float v[2];
      UNR for (int u = 0; u < 2; ++u) { const int d = 4095 - (pp + u); v[u] = d > 0 ? rs * hf[d] : (d == 0 ? diag : (d > -4096 ? rs * hb[-d] : 0.f)); }
      dst[pp >> 1] = pk2(v[0], v[1]);
    }
    const float* hfc = (const float*)(p.ws + OFF_HRAWC) + ((size_t)((e * 2 + o) * 2 + 0) * 512 + c) * 256;
    const float* hbc = (const float*)(p.ws + OFF_HRAWC) + ((size_t)((e * 2 + o) * 2 + 1) * 512 + c) * 256;
    float* gc = (float*)(p.ws + OFF_GC) + ((size_t)(e * 2 + o) * 512 + c) * 512;
    for (int q = lane; q < 512; q += 64) {
      const int d = q - 256;
      gc[q] = q == 0 ? 0.f : (d > 0 ? rsc * hfc[d] : (d == 0 ? rsc * (hfc[0] + hbc[0]) + skip : rsc * hbc[-d]));
    }
  }
}

DI void norm_phase(const PW& p, int l) {
  const int tid_ = LTID(p); const int wid = __builtin_amdgcn_readfirstlane(tid_ >> 6), lane = tid_ & 63;
  const float* MOD = (const float*)(p.ws + OFF_MOD);
  bf16_t* HN = (bf16_t*)(p.ws + OFF_HN);
  const float* xc_in = l == 0 ? p.ctx : (const float*)(p.ws + OFF_XC);
  const float* x_in = l == 0 ? p.x : p.out;
  const int nw = gridDim.x * 8;
  for (int row = lbid() * 8 + wid; row < R; row += 2 * nw) {
    const float* src[2]; const float* mv[2]; int rr[2];
    UNR for (int q = 0; q < 2; ++q) {
      rr[q] = row + q * nw; const int rq = rr[q] < R ? rr[q] : row;
      const int b = rq / TB, t = rq % TB;
      src[q] = t < SEQ ? x_in + ((size_t)b * SEQ + t) * 1024 : xc_in + ((size_t)b * NCTX + (t - SEQ)) * 1024;
      mv[q] = MOD + (size_t)(l * 9 + (t < SEQ ? b : 8)) * 3072;
    }
    f32x4 v[2][4]; float ss[2] = {0.f, 0.f};
    UNR for (int q = 0; q < 2; ++q) UNR for (int i = 0; i < 4; ++i) v[q][i] = *(const f32x4*)(src[q] + i * 256 + lane * 4);
    UNR for (int q = 0; q < 2; ++q) UNR for (int i = 0; i < 4; ++i) ss[q] += v[q][i][0] * v[q][i][0] + v[q][i][1] * v[q][i][1] + v[q][i][2] * v[q][i][2] + v[q][i][3] * v[q][i][3];
    UNR for (int o = 32; o > 0; o >>= 1) { ss[0] += shx(ss[0], o); ss[1] += shx(ss[1], o); }
    UNR for (int q = 0; q < 2; ++q) {
      if (rr[q] >= R) continue;
      const float rstd = 1.0f / sqrtf(ss[q] * (1.f / 1024.f) + 1e-6f);
      UNR for (int i = 0; i < 4; ++i) {
        const int c0 = i * 256 + lane * 4;
        const f32x4 g = *(const f32x4*)(p.norm_g + l * 1024 + c0), sh = *(const f32x4*)(mv[q] + c0), sc = *(const f32x4*)(mv[q] + 1024 + c0);
        float o[4];
        UNR for (int j = 0; j < 4; ++j) o[j] = v[q][i][j] * rstd * g[j] * (1.f + sc[j]) + sh[j];
        u32x2 w = {pk2(o[0], o[1]), pk2(o[2], o[3])};
        *(u32x2*)(HN + (size_t)rr[q] * 1024 + c0) = w;
      }
    }
  }
}

namespace pg8 {
#define PG8_LAS __attribute__((address_space(3)))
typedef unsigned short bf16_t;
typedef short bf16x8 __attribute__((ext_vector_type(8)));
typedef float f32x4 __attribute__((ext_vector_type(4)));
typedef unsigned u32x4 __attribute__((ext_vector_type(4)));
constexpr int BM = 256, BK = 64, HALF = 128, HTB = HALF * BK * 2  , STAGE_BYTES = 8 * HTB, NXCD = 8, WGM = 8;

__host__ __device__ __forceinline__ int lds_byte(int r, int c) { const int st = (r >> 4) * 2 + (c >> 5), rr = r & 15, cc = c & 31, ob = rr * 64 + cc * 2; return st * 1024 + (ob ^ (((ob >> 9) & 1) << 5)); }
__host__ __device__ __forceinline__ void stage_rc(int b, int& R, int& C) { const int st = b / 1024, sb = b % 1024, swz = sb ^ (((sb >> 9) & 1) << 5); R = (st >> 1) * 16 + swz / 64; C = (st & 1) * 32 + (swz % 64) / 2; }
__host__ __device__ __forceinline__ int perm32(int rho) { const int n = rho >> 4, i = rho & 15; return 8 * (i >> 2) + 4 * n + (i & 3); }

struct Unit { int pm, pn; };
struct Gemm { const bf16_t* A; const bf16_t* Bt; int M, N, K; };

struct StaticOrder {
    int nM, nN, nwg, G, c;
    __host__ __device__ void init(int M, int N, int G_, int c_) { nM = M / BM; nN = N / BM; nwg = nM * nN; G = G_; c = c_; }
    __host__ __device__ bool next(int i, Unit& u) const {
        const long L = (long)i * G + c; if (L >= nwg) return false;
        int wgid = (int)L; { const int q = nwg / NXCD, r = nwg % NXCD, xcd = wgid % NXCD, off = wgid / NXCD; wgid = (xcd < r ? xcd * (q + 1) : r * (q + 1) + (xcd - r) * q) + off; }
        const int nig = WGM * nN, gid = wgid / nig, fm = gid * WGM, gsz = (nM - fm) < WGM ? (nM - fm) : WGM;
        u.pm = fm + ((wgid % nig) % gsz); u.pn = (wgid % nig) / gsz; return true;
    }
    __device__ __forceinline__ void a_ready(const Unit&) const {}
    __device__ __forceinline__ void done(const Unit&) const {}
};
template <class Epi, class Sched, bool ALIGN_EPI = false, bool SP2 = false>
__device__ __forceinline__ void gemm_phase(PG8_LAS unsigned char* lds, const Gemm g, const Sched& S, const Epi& E, const int tid0) {
    const int tid = tid0, wid = __builtin_amdgcn_readfirstlane(tid >> 6), lane = tid & 63, wr = wid >> 2, wc = wid & 3, fr = lane & 15, fq = lane >> 4;
    const int K = g.K, nt = K / BK;
    unsigned voffA[2], voffB[2];
#pragma unroll
    for (int i = 0; i < 2; ++i) { int R, C; stage_rc(tid * 16 + i * 8192, R, C); const int Rb = Epi::PERM ? ((R & ~31) + perm32(R & 31)) : R;
        voffA[i] = (unsigned)(R * K + C) * 2u; voffB[i] = (unsigned)(Rb * K + C) * 2u; }
    const size_t kstep = (size_t)(BK * 2);
    const size_t hstep = (size_t)HALF * K * 2;
    const size_t tstep = 2 * hstep;
    const unsigned ldsw = (unsigned)wid * 1024u;
    const int aoff = lds_byte(wr * 64 + fr, fq * 8), boff = lds_byte(wc * 32 + fr, fq * 8);
#define PG8_SA(b, h) (((b) * 2 + (h)) * HTB)
#define PG8_SB(b, h) ((4 + (b) * 2 + (h)) * HTB)
#define PG8_STAGE(bufoff, gbase, voff) do { _Pragma("unroll") for (int _i = 0; _i < 2; ++_i) \
        __builtin_amdgcn_global_load_lds((const unsigned*)((const char*)(gbase) + (voff)[_i]), (PG8_LAS unsigned*)(lds + (bufoff) + ldsw + _i * 8192), 16, 0, 0); } while (0)
#define PG8_LDA(dst, b, h) do { _Pragma("unroll") for (int m = 0; m < 4; ++m) _Pragma("unroll") for (int k = 0; k < 2; ++k) dst[m][k] = *(const PG8_LAS bf16x8*)(lds + PG8_SA(b, h) + aoff + m * 2048 + k * 1024); } while (0)
#define PG8_LDB(dst, b, h) do { _Pragma("unroll") for (int n = 0; n < 2; ++n) _Pragma("unroll") for (int k = 0; k < 2; ++k) dst[n][k] = *(const PG8_LAS bf16x8*)(lds + PG8_SB(b, h) + boff + n * 2048 + k * 1024); } while (0)
#define PG8_MMA(ai, bj, At, Bt) do { __builtin_amdgcn_s_setprio(1); _Pragma("unroll") for (int m = 0; m < 4; ++m) _Pragma("unroll") for (int n = 0; n < 2; ++n) _Pragma("unroll") for (int k = 0; k < 2; ++k) \
        acc[ai][bj][m][n] = __builtin_amdgcn_mfma_f32_16x16x32_bf16(Bt[n][k], At[m][k], acc[ai][bj][m][n], 0, 0, 0); __builtin_amdgcn_s_setprio(0); } while (0)
#define PG8_WAIT_V(n) asm volatile("s_waitcnt vmcnt(" #n ")" ::: "memory")
#define PG8_WAIT_L(n) asm volatile("s_waitcnt lgkmcnt(" #n ")" ::: "memory")
#define PG8_BAR __builtin_amdgcn_s_barrier()
#define PG8_SCHED __builtin_amdgcn_sched_barrier(0)
    Unit cur, nxt; int ui = 0;
    if (!S.next(0, cur)) return;
    f32x4 acc[2][2][4][2];
#pragma unroll
    for (int a = 0; a < 2; ++a)
#pragma unroll
        for (int b = 0; b < 2; ++b)
#pragma unroll
            for (int m = 0; m < 4; ++m)
#pragma unroll
                for (int n = 0; n < 2; ++n) acc[a][b][m][n] = (f32x4){0.f, 0.f, 0.f, 0.f};
    bf16x8 At[4][2], B0[2][2], B1[2][2];
    const char* cA = E.normal(cur) ? (const char*)g.Bt + (size_t)cur.pn * tstep : (const char*)g.A + (size_t)cur.pm * tstep; const char* cB = E.normal(cur) ? (const char*)g.A + (size_t)cur.pm * tstep : (const char*)g.Bt + (size_t)cur.pn * tstep;
    S.a_ready(cur);
    if constexpr (SP2) {
        PG8_STAGE(PG8_SB(0, 0), cB, voffB); PG8_STAGE(PG8_SB(0, 1), cB + hstep, voffB); PG8_STAGE(PG8_SA(0, 0), cA, voffA); PG8_STAGE(PG8_SA(0, 1), cA + hstep, voffA);
        if (wr == 1) PG8_BAR;
        PG8_WAIT_V(2); PG8_BAR;
        PG8_STAGE(PG8_SB(1, 0), cB + kstep, voffB); PG8_STAGE(PG8_SA(1, 0), cA + kstep, voffA); PG8_STAGE(PG8_SB(1, 1), cB + hstep + kstep, voffB);
        PG8_WAIT_V(6); PG8_BAR;
    } else {
        PG8_STAGE(PG8_SB(0, 0), cB, voffB); PG8_STAGE(PG8_SA(0, 0), cA, voffA); PG8_STAGE(PG8_SB(0, 1), cB + hstep, voffB); PG8_STAGE(PG8_SA(0, 1), cA + hstep, voffA);
        if (wr == 1) PG8_BAR;
        PG8_WAIT_V(4); PG8_BAR;
        PG8_STAGE(PG8_SB(1, 0), cB + kstep, voffB); PG8_STAGE(PG8_SA(1, 0), cA + kstep, voffA); PG8_STAGE(PG8_SB(1, 1), cB + hstep + kstep, voffB);
        PG8_WAIT_V(6); PG8_BAR;
    }
    for (;;) {
        const bool has_next = S.next(ui + 1, nxt);
        const bool nsw = has_next && E.normal(nxt); const char* nA = has_next ? (nsw ? (const char*)g.Bt + (size_t)nxt.pn * tstep : (const char*)g.A + (size_t)nxt.pm * tstep) : cA; const char* nB = has_next ? (nsw ? (const char*)g.A + (size_t)nxt.pm * tstep : (const char*)g.Bt + (size_t)nxt.pn * tstep) : cB;
        for (int t = 0; t < nt; t += 2) {
            const bool last = (t == nt - 2);
            const char* a1 = cA + (size_t)(t + 1) * kstep;
            const char* a2 = last ? nA : cA + (size_t)(t + 2) * kstep; const char* b2 = last ? nB : cB + (size_t)(t + 2) * kstep;
            const char* a3 = a2 + kstep; const char* b3 = b2 + kstep;
            if (last && has_next) S.a_ready(nxt);
            if constexpr (SP2) {
            PG8_LDB(B0, 0, 0); PG8_LDB(B1, 0, 1); PG8_SCHED; PG8_LDA(At, 0, 0); PG8_STAGE(PG8_SA(1, 1), a1 + hstep, voffA);
            PG8_WAIT_V(8); PG8_WAIT_L(0); PG8_BAR; PG8_MMA(0, 0, At, B0); PG8_MMA(0, 1, At, B1); PG8_BAR; PG8_SCHED;
            PG8_LDA(At, 0, 1); PG8_STAGE(PG8_SB(0, 0), b2, voffB); PG8_STAGE(PG8_SB(0, 1), b2 + hstep, voffB); PG8_STAGE(PG8_SA(0, 0), a2, voffA);
            PG8_WAIT_V(8); PG8_WAIT_L(0); PG8_BAR; PG8_MMA(1, 0, At, B0); PG8_MMA(1, 1, At, B1); PG8_BAR; PG8_SCHED;
            PG8_LDB(B0, 1, 0); PG8_LDB(B1, 1, 1); PG8_SCHED; PG8_LDA(At, 1, 0); PG8_STAGE(PG8_SA(0, 1), a2 + hstep, voffA);
            PG8_WAIT_V(8); PG8_WAIT_L(0); PG8_BAR; PG8_MMA(0, 0, At, B0); PG8_MMA(0, 1, At, B1); PG8_BAR; PG8_SCHED;
            PG8_LDA(At, 1, 1); PG8_STAGE(PG8_SB(1, 0), b3, voffB); PG8_STAGE(PG8_SB(1, 1), b3 + hstep, voffB); PG8_STAGE(PG8_SA(1, 0), a3, voffA);
            PG8_WAIT_V(8); PG8_WAIT_L(0); PG8_BAR; PG8_MMA(1, 0, At, B0); PG8_MMA(1, 1, At, B1); PG8_BAR; PG8_SCHED;
            } else {
            PG8_LDB(B0, 0, 0); PG8_SCHED; PG8_LDA(At, 0, 0); PG8_STAGE(PG8_SA(1, 1), a1 + hstep, voffA);
            PG8_WAIT_L(8); PG8_BAR; PG8_WAIT_L(0); PG8_MMA(0, 0, At, B0); PG8_BAR; PG8_SCHED;
            PG8_LDB(B1, 0, 1); PG8_STAGE(PG8_SB(0, 0), b2, voffB);
            PG8_BAR; PG8_WAIT_L(0); PG8_MMA(0, 1, At, B1); PG8_BAR;
            PG8_LDA(At, 0, 1); PG8_STAGE(PG8_SA(0, 0), a2, voffA);
            PG8_BAR; PG8_WAIT_L(0); PG8_MMA(1, 0, At, B0); PG8_BAR; PG8_SCHED;
            PG8_STAGE(PG8_SB(0, 1), b2 + hstep, voffB);
            PG8_WAIT_V(6); PG8_BAR; PG8_MMA(1, 1, At, B1); PG8_BAR;
            PG8_LDB(B0, 1, 0); PG8_SCHED; PG8_LDA(At, 1, 0); PG8_STAGE(PG8_SA(0, 1), a2 + hstep, voffA);
            PG8_WAIT_L(8); PG8_BAR; PG8_WAIT_L(0); PG8_MMA(0, 0, At, B0); PG8_BAR; PG8_SCHED;
            PG8_LDB(B1, 1, 1); PG8_STAGE(PG8_SB(1, 0), b3, voffB);
            PG8_BAR; PG8_WAIT_L(0); PG8_MMA(0, 1, At, B1); PG8_BAR;
            PG8_LDA(At, 1, 1); PG8_STAGE(PG8_SA(1, 0), a3, voffA);
            PG8_BAR; PG8_WAIT_L(0); PG8_MMA(1, 0, At, B0); PG8_BAR; PG8_SCHED;
            PG8_STAGE(PG8_SB(1, 1), b3 + hstep, voffB);
            PG8_WAIT_V(6); PG8_BAR; PG8_MMA(1, 1, At, B1); PG8_BAR;
            }
        }
        if constexpr (ALIGN_EPI) { if (wr == 0) PG8_BAR; }
        if constexpr (!Epi::AFTER_DRAIN) { E(acc, cur, wr, wc, fr, fq); S.done(cur); }
        if (!has_next) break;
#pragma unroll
        for (int a = 0; a < 2; ++a)
#pragma unroll
            for (int b = 0; b < 2; ++b)
#pragma unroll
                for (int m = 0; m < 4; ++m)
#pragma unroll
                    for (int n = 0; n < 2; ++n) acc[a][b][m][n] = (f32x4){0.f, 0.f, 0.f, 0.f};
        cur = nxt; cA = nA; cB = nB; ++ui;
        if constexpr (ALIGN_EPI) { if (wr == 1) PG8_BAR; }
    }
    PG8_WAIT_V(0);
    if constexpr (!ALIGN_EPI) { if (wr == 0) PG8_BAR; }
    PG8_BAR;
    if constexpr (Epi::AFTER_DRAIN) { E.fused(acc, cur, wr, wc, fr, fq, lds, wid, lane); S.done(cur); }
#undef PG8_SA
#undef PG8_SB
#undef PG8_STAGE
#undef PG8_LDA
#undef PG8_LDB
#undef PG8_MMA
#undef PG8_WAIT_V
#undef PG8_WAIT_L
#undef PG8_BAR
#undef PG8_SCHED
}
}

typedef const f32x4 (&AccRef)[2][2][4][2];
DI void epi2_qk(AccRef acc, bf16_t* dst, int pitch, const float* g, float scale, bool rope, int tq0, int fr, int fq) {
  f32x4 g0[2], g1[2];
  UNR for (int n = 0; n < 2; ++n) { g0[n] = *(const f32x4*)(g + 16 * n + 4 * fq); g1[n] = *(const f32x4*)(g + 32 + 16 * n + 4 * fq); }
  float inv[4];
  UNR for (int e = 0; e < 4; ++e) inv[e] = __builtin_amdgcn_exp2f(-(float)(4 * fq + e) * (13.287712379549449f / 16.f)) * 0.15915494309189535f;
  float ssq[2][4];
  UNR for (int ai = 0; ai < 2; ++ai) UNR for (int m = 0; m < 4; ++m) {
    float ss = 0.f;
    UNR for (int bj = 0; bj < 2; ++bj) UNR for (int n = 0; n < 2; ++n) UNR for (int e = 0; e < 4; ++e) ss += acc[ai][bj][m][n][e] * acc[ai][bj][m][n][e];
    ssq[ai][m] = ss;
  }
  UNR for (int ai = 0; ai < 2; ++ai) UNR for (int m = 0; m < 4; ++m) ssq[ai][m] += shx(ssq[ai][m], 16);
  UNR for (int ai = 0; ai < 2; ++ai) UNR for (int m = 0; m < 4; ++m) ssq[ai][m] += shx(ssq[ai][m], 32);
  UNR for (int ai = 0; ai < 2; ++ai) UNR for (int m = 0; m < 4; ++m) {
    const int t = tq0 + 128 * ai + 16 * m + fr;
    const float rstd = scale / sqrtf(ssq[ai][m] * (1.f / 64.f) + 1e-6f);
    const unsigned off = (unsigned)(t * pitch + 4 * fq);
    UNR for (int n = 0; n < 2; ++n) {
      f32x4 v0 = acc[ai][0][m][n] * rstd * g0[n];
      f32x4 v1 = acc[ai][1][m][n] * rstd * g1[n];
      if (rope) {
        const int pos = n == 0 ? (t >> 6) : (t & 63);
        UNR for (int e = 0; e < 4; ++e) {
          const float rev = (float)pos * inv[e];
          const float cs = __builtin_amdgcn_cosf(rev), sn = __builtin_amdgcn_sinf(rev);
          const float x1 = v0[e], x2 = v1[e];
          v0[e] = x1 * cs - x2 * sn; v1[e] = x1 * sn + x2 * cs;
        }
      }
      u32x2 w0 = {pk2(v0[0], v0[1]), pk2(v0[2], v0[3])}, w1 = {pk2(v1[0], v1[1]), pk2(v1[2], v1[3])};
      *(u32x2*)(dst + off + 16 * n) = w0;
      *(u32x2*)(dst + off + 32 + 16 * n) = w1;
    }
    asm volatile("" ::: "memory");
  }
}
DI void epi2_gate_tok(AccRef acc, bf16_t* dst, int pitch, int fr, int fq) {
  UNR for (int ai = 0; ai < 2; ++ai) UNR for (int m = 0; m < 4; ++m) {
    const unsigned off = (unsigned)((128 * ai + 16 * m + fr) * pitch + 4 * fq);
    UNR for (int bj = 0; bj < 2; ++bj) UNR for (int n = 0; n < 2; ++n) {
      const f32x4 a = acc[ai][bj][m][n];
      u32x2 w = {pk2(silu(a[0]), silu(a[1])), pk2(silu(a[2]), silu(a[3]))};
      *(u32x2*)(dst + off + (32 * bj + 16 * n)) = w;
    }
    asm volatile("" ::: "memory");
  }
}
DI void epi2_S(AccRef acc, bf16_t* dst, unsigned chmul, bool dosilu, bool qperm, int wr, int wc, int fr, int fq_) {
  const int fq = qperm ? (((fq_ & 1) << 1) | (fq_ >> 1)) : fq_;
  UNR for (int ai = 0; ai < 2; ++ai) UNR for (int m = 0; m < 4; ++m) {
    const int ch = 64 * (2 * wr + (m >> 1)) + 32 * ai + 16 * (m & 1) + fr;
    const unsigned off = (unsigned)ch * chmul + (unsigned)(32 * wc + 4 * fq);
    UNR for (int bj = 0; bj < 2; ++bj) UNR for (int n = 0; n < 2; ++n) {
      f32x4 a = acc[ai][bj][m][n];
      if (dosilu) { a[0] = silu(a[0]); a[1] = silu(a[1]); a[2] = silu(a[2]); a[3] = silu(a[3]); }
      u32x2 w = {pk2(a[0], a[1]), pk2(a[2], a[3])};
      *(u32x2*)(dst + off + (128 * bj + 16 * n)) = w;
    }
    asm volatile("" ::: "memory");
  }
}
struct EpiIn {
  static constexpr bool PERM = false, AFTER_DRAIN = false;
  bf16_t* PB; const float* gq; const float* gk; int odd;
  DI bool normal(const pg8::Unit& u) const { const int n0 = u.pn * 256; return odd ? (n0 >= 2048 && n0 < 3072) : ((n0 >= 1024 && n0 < 3072) || n0 >= 3584); }
  DI void operator()(AccRef acc, const pg8::Unit& u, int wr, int wc, int fr_, int fq_) const {
    int fr = fr_, fq = fq_; asm volatile("" : "+v"(fr), "+v"(fq));
    const int n0 = u.pn * 256, cb = n0 + 64 * wc, b = u.pm / 17, tmi = u.pm % 17; const bool isctx = tmi == 16;
    const int tq0 = tmi * 256 + 64 * wr; const size_t row0 = (size_t)u.pm * 256 + 64 * wr;
    if (normal(u)) {
      const int t0 = tmi * 256; bf16_t* dst; unsigned chmul = (unsigned)(8 * TB); bool sl = false, qp = odd != 0;
      if (!odd) {
        if (n0 < 1536) { dst = PB + 2 * SEG + ((size_t)b * 512 + (n0 - 1024)) * TB + t0; chmul = (unsigned)TB; qp = true; }
        else if (n0 < 3072) dst = PB + 3 * SEG + ((size_t)(n0 - 1536) * 8 + b) * TB + t0;
        else { dst = PB + 7 * SEG + ((size_t)(n0 - 3584) * 8 + b) * TB + t0; sl = true; }
      } else { dst = PB + 4 * SEG + ((size_t)b * 1024 + (n0 - 2048)) * TB + t0; chmul = (unsigned)TB; }
      epi2_S(acc, dst, chmul, sl, qp, wr, wc, fr, fq);
      return;
    }
    if (n0 >= 3072) {
      const int pitch = odd ? 1024 : 512;
      epi2_gate_tok(acc, PB + 6 * SEG + row0 * pitch + (cb - 3072), pitch, fr, fq);
      return;
    }
    {
      bf16_t* dst; int pitch; const float* g; float scale; bool rope = false;
      if (!odd) {
        pitch = 64;
        if (cb < 512) { dst = PB + ((size_t)(b * 8 + (cb >> 6)) * TB) * 64; g = gq; scale = LOG2E * 0.125f; }
        else { dst = PB + SEG + ((size_t)(b * 8 + ((cb - 512) >> 6)) * TB) * 64; g = gk; scale = 1.f; }
      } else {
        pitch = 128; rope = !isctx;
        if (cb < 1024) { dst = PB + ((size_t)(b * 8 + (cb >> 7)) * TB) * 128 + ((cb >> 6) & 1) * 64; g = gq; scale = LOG2E * 0.125f; }
        else { const int c2 = cb - 1024; dst = PB + 2 * SEG + ((size_t)(b * 8 + (c2 >> 7)) * TB) * 128 + ((c2 >> 6) & 1) * 64; g = gk; scale = 1.f; }
      }
      epi2_qk(acc, dst, pitch, g, scale, rope, tq0, fr, fq);
    }
  }
};
struct EpiOut {
  static constexpr bool PERM = false, AFTER_DRAIN = false;
  const float* x_in; const float* xc_in; float* out; float* xc; const float* mod; int l;
  DI bool normal(const pg8::Unit&) const { return false; }
  DI void operator()(AccRef acc, const pg8::Unit& u, int wr, int wc, int fr, int fq) const {
    const int cb = u.pn * 256 + 64 * wc, b = u.pm / 17, tmi = u.pm % 17; const bool isctx = tmi == 16;
    if (isctx && l == 3) return;
    const float* gate = mod + (size_t)(l * 9 + (isctx ? 8 : b)) * 3072 + 2048;
    const float* src; float* dst;
    if (isctx) { src = xc_in + ((size_t)b * NCTX + 64 * wr) * 1024; dst = xc + ((size_t)b * NCTX + 64 * wr) * 1024; }
    else { const size_t o = ((size_t)b * SEQ + tmi * 256 + 64 * wr) * 1024; src = x_in + o; dst = out + o; }
    UNR for (int bj = 0; bj < 2; ++bj) {
      f32x4 xo[2][2][4], gg[2];
      UNR for (int n = 0; n < 2; ++n) {
        const int c = cb + 32 * bj + 16 * n + 4 * fq; gg[n] = *(const f32x4*)(gate + c);
        UNR for (int ai = 0; ai < 2; ++ai) UNR for (int m = 0; m < 4; ++m) xo[n][ai][m] = *(const f32x4*)(src + (size_t)(128 * ai + 16 * m + fr) * 1024 + c);
      }
      UNR for (int n = 0; n < 2; ++n) {
        const int c = cb + 32 * bj + 16 * n + 4 * fq;
        UNR for (int ai = 0; ai < 2; ++ai) UNR for (int m = 0; m < 4; ++m) *(f32x4*)(dst + (size_t)(128 * ai + 16 * m + fr) * 1024 + c) = xo[n][ai][m] + gg[n] * acc[ai][bj][m][n];
      }
      asm volatile("" ::: "memory");
    }
  }
};
struct LatentOrder : pg8::StaticOrder {
  __device__ bool next(int i, pg8::Unit& u) const { if (!pg8::StaticOrder::next(i, u)) return false; u.pm += u.pm >> 4; return true; }
};
template <int MODE>
DI void gemm_phase(const PW& p, int l, unsigned char* smem) {
  pg8::Gemm g; g.M = R; g.K = 1024;
  pg8::StaticOrder S;
  PG8_LAS unsigned char* lds = (PG8_LAS unsigned char*)smem;
  if (MODE == 2) {
    g.A = (const bf16_t*)(p.ws + OFF_Y); g.Bt = (const bf16_t*)(p.ws + OFF_WOUT) + (size_t)l * 1024 * 1024; g.N = 1024;
    S.init(R, 1024, gridDim.x, lbid());
    EpiOut E; E.x_in = l == 0 ? p.x : p.out; E.xc_in = l == 0 ? p.ctx : (const float*)(p.ws + OFF_XC); E.out = p.out; E.xc = (float*)(p.ws + OFF_XC); E.mod = (const float*)(p.ws + OFF_MOD); E.l = l;
    if (l == 3) { LatentOrder S3; S3.init(128 * 256, 1024, gridDim.x, lbid()); pg8::gemm_phase<EpiOut, LatentOrder, true, true>(lds, g, S3, E, LTID(p)); }
    else pg8::gemm_phase<EpiOut, pg8::StaticOrder, true, true>(lds, g, S, E, LTID(p));
  } else {
    g.A = (const bf16_t*)(p.ws + OFF_HN); g.Bt = (const bf16_t*)(p.ws + OFF_WIN) + (size_t)l * 4096 * 1024; g.N = 4096;
    S.init(R, 4096, gridDim.x, lbid());
    EpiIn E; E.PB = (bf16_t*)(p.ws + OFF_PB); E.gq = p.q_norm_g + l * 64; E.gk = p.k_norm_g + l * 64; E.odd = MODE;
    pg8::gemm_phase<EpiIn, pg8::StaticOrder, true, true>(lds, g, S, E, LTID(p));
  }
  __syncthreads();
}

DI void na_unit(const PW& p, int e, int b, int hd, int tq0, bool ctxq, float negM, int r, int h) {
  const bf16_t* PB = (const bf16_t*)(p.ws + OFF_PB);
  const bf16_t* Q = PB + ((size_t)(b * 8 + hd) * TB) * 64;
  const bf16_t* K = PB + SEG + ((size_t)(b * 8 + hd) * TB) * 64;
  const bf16_t* VT = PB + 2 * SEG + ((size_t)(b * 8 + hd) * 64) * TB;
  const int tq = tq0 + r;
  f32x16 O[2]; O[0] = splat16(0.f); O[1] = splat16(0.f);
  float lsum = 0.f;
  const int qrow = tq0 >> 6, qcol = tq & 63;
  const int rs = min(max(qrow - 4, 0), 56), cs = min(max(qcol - 8, 0), 48);
  const float* rpb = p.na_rpb + (size_t)(e * 8 + hd) * 15 * 31;
  constexpr int NB = 2; const int ngrp = ctxq ? 8 / NB : 24 / NB;
  _Pragma("unroll 1") for (int g = 0; g < ngrp; ++g) {
    const bool local = !ctxq && g < 16 / NB;
    bf16x8 kf[NB][4], vf[NB][4], qf[4];
    UNR for (int ks = 0; ks < 4; ++ks) qf[ks] = *(const bf16x8*)(Q + (size_t)tq * 64 + ks * 16 + h * 8);
    UNR for (int u = 0; u < NB; ++u) {
      const int it = g * NB + u;
      const int kb = local ? (rs + (it >> 1)) * 64 + (it & 1) * 32 : SEQ + (ctxq ? it : it - 16) * 32;
      UNR for (int ks = 0; ks < 4; ++ks) kf[u][ks] = *(const bf16x8*)(K + (size_t)(kb + r) * 64 + ks * 16 + h * 8);
      UNR for (int dvt = 0; dvt < 2; ++dvt) UNR for (int s2 = 0; s2 < 2; ++s2) vf[u][dvt * 2 + s2] = *(const bf16x8*)(VT + (size_t)(dvt * 32 + r) * TB + kb + s2 * 16 + 8 * h);
    }
    asm volatile("" ::: "memory");
    UNR for (int u = 0; u < NB; ++u) {
      const int it = g * NB + u;
      const int krow = rs + (it >> 1), ct = it & 1;
      f32x16 s = splat16(negM);
      UNR for (int ks = 0; ks < 4; ++ks) s = MFMA32(kf[u][ks], qf[ks], s);
      if (local) {
        const float* rp = rpb + (krow - qrow + 7) * 31;
        UNR for (int i = 0; i < 16; ++i) {
          const int kcol = ct * 32 + crow(i, h); const bool valid = kcol >= cs && kcol < cs + 16;
          const int dc = min(max(kcol - qcol + 15, 0), 30);
          const float pv = __builtin_amdgcn_exp2f(s[i] + rp[dc] * LOG2E);
          s[i] = valid ? pv : 0.f;
        }
      } else {
        UNR for (int i = 0; i < 16; ++i) s[i] = __builtin_amdgcn_exp2f(s[i]);
      }
      UNR for (int i = 0; i < 16; ++i) lsum += s[i];
      bf16x8 pf[2]; pf[0] = pack8(s, 0); pf[1] = pack8(s, 8);
      UNR for (int dvt = 0; dvt < 2; ++dvt) UNR for (int s2 = 0; s2 < 2; ++s2) O[dvt] = MFMA32(vf[u][dvt * 2 + s2], pf[s2], O[dvt]);
      asm volatile("" ::: "memory");
    }
  }
  lsum += shx(lsum, 32);
  const float inv = 1.f / lsum;
  const size_t row = (size_t)b * TB + tq;
  const bf16_t* G = PB + 6 * SEG + row * 512 + hd * 64;
  bf16_t* Y = (bf16_t*)(p.ws + OFF_Y) + row * 1024 + hd * 64;
  UNR for (int dvt = 0; dvt < 2; ++dvt) UNR for (int gq = 0; gq < 4; ++gq) {
    const int dv = dvt * 32 + 8 * gq + 4 * h;
    const u32x2 gg = *(const u32x2*)(G + dv);
    u32x2 w = {pk2(O[dvt][4 * gq] * inv * bflo(gg[0]), O[dvt][4 * gq + 1] * inv * bfhi(gg[0])), pk2(O[dvt][4 * gq + 2] * inv * bflo(gg[1]), O[dvt][4 * gq + 3] * inv * bfhi(gg[1]))};
    *(u32x2*)(Y + dv) = w;
  }
}

DI void na_block(const PW& p, int e, int b, int hd, int r0, bool ctxq, float negM, unsigned char* smem) {
  const int tid = LTID(p), wid = __builtin_amdgcn_readfirstlane(tid >> 6), lane = tid & 63, r = lane & 31, h = lane >> 5;
  const bf16_t* PB = (const bf16_t*)(p.ws + OFF_PB);
  const bf16_t* Q = PB + ((size_t)(b * 8 + hd) * TB) * 64;
  const bf16_t* K = PB + SEG + ((size_t)(b * 8 + hd) * TB) * 64;
  const bf16_t* VT = PB + 2 * SEG + ((size_t)(b * 8 + hd) * 64) * TB;
  PG8_LAS unsigned char* lds = (PG8_LAS unsigned char*)smem;
  const int qrow = ctxq ? 0 : r0 + (wid >> 1);
  const int tq0 = ctxq ? SEQ + wid * 32 : qrow * 64 + (wid & 1) * 32;
  const int tq = tq0 + r, qcol = tq & 63;
  const int rsw = min(max(qrow - 4, 0), 56), cs = min(max(qcol - 8, 0), 48);
  const int kr_lo = min(max(r0 - 4, 0), 56), kr_hi = min(max(r0 - 1, 0), 56) + 7;
  const int nloc = ctxq ? 0 : (kr_hi - kr_lo + 2) >> 1, nch = nloc + 2;
  bf16x8 qf[4];
  UNR for (int ks = 0; ks < 4; ++ks) qf[ks] = *(const bf16x8*)(Q + (size_t)tq * 64 + ks * 16 + h * 8);
  f32x16 O[2]; O[0] = splat16(0.f); O[1] = splat16(0.f);
  float lsum = 0.f;
  const float* rpb = p.na_rpb + (size_t)(e * 8 + hd) * 15 * 31;
  unsigned offK[2], offV[2];
  UNR for (int j = 0; j < 2; ++j) {
    const int s = (wid * 2 + j) * 64 + lane;
    { const int row = s >> 3, c = (s & 7) ^ ((row >> 1) & 7); offK[j] = (unsigned)(row * 64 + c * 8) * 2u; }
    { const int row = s >> 4, c = (s & 15) ^ (row & 15); offV[j] = (unsigned)(row * TB + c * 8) * 2u; }
  }
#define NA_KB(ci) ((ci) < nloc ? (kr_lo + 2 * (ci)) * 64 : SEQ + ((ci) - nloc) * 128)
#define NA_STAGE(st, ci) do { const int kb_ = NA_KB(ci); const char* kp_ = (const char*)(K + (size_t)kb_ * 64); const char* vp_ = (const char*)(VT + kb_); \
    UNR for (int j = 0; j < 2; ++j) { __builtin_amdgcn_global_load_lds((const unsigned*)(kp_ + offK[j]), (PG8_LAS unsigned*)(lds + (st) * 32768 + (wid * 2 + j) * 1024), 16, 0, 0); \
                                      __builtin_amdgcn_global_load_lds((const unsigned*)(vp_ + offV[j]), (PG8_LAS unsigned*)(lds + (st) * 32768 + 16384 + (wid * 2 + j) * 1024), 16, 0, 0); } } while (0)
  float* btab = (float*)(smem + 65536);
  __syncthreads();
  if (!ctxq && tid < 465) btab[tid] = rpb[tid] * LOG2E;
  NA_STAGE(0, 0);
  asm volatile("s_waitcnt vmcnt(0)" ::: "memory");
  __syncthreads();
  for (int ci = 0; ci < nch; ++ci) {
    if (ci + 1 < nch) NA_STAGE((ci + 1) & 1, ci + 1);
    const unsigned char* Kl = smem + (ci & 1) * 32768; const unsigned char* Vl = Kl + 16384;
    const bool local = ci < nloc;
    _Pragma("unroll 2") for (int sub = 0; sub < 4; ++sub) {
      const int krow = kr_lo + 2 * ci + (sub >> 1), ct = sub & 1;
      if (local && (krow < rsw || krow >= rsw + 8)) continue;
      f32x16 s = splat16(negM);
      const int kr_ = sub * 32 + r;
      UNR for (int ks = 0; ks < 4; ++ks) { const bf16x8 kf = *(const bf16x8*)(Kl + kr_ * 128 + (((ks * 2 + h) ^ ((kr_ >> 1) & 7)) << 4)); s = MFMA32(kf, qf[ks], s); }
      if (local) {
        const float* rp = btab + (krow - qrow + 7) * 31;
        UNR for (int i = 0; i < 16; ++i) {
          const int kcol = ct * 32 + crow(i, h); const bool valid = kcol >= cs && kcol < cs + 16;
          const int dc = min(max(kcol - qcol + 15, 0), 30);
          const float pv = __builtin_amdgcn_exp2f(s[i] + rp[dc]);
          s[i] = valid ? pv : 0.f;
        }
      } else {
        UNR for (int i = 0; i < 16; ++i) s[i] = __builtin_amdgcn_exp2f(s[i]);
      }
      UNR for (int i = 0; i < 16; ++i) lsum += s[i];
      bf16x8 pf[2]; pf[0] = pack8(s, 0); pf[1] = pack8(s, 8);
      UNR for (int dvt = 0; dvt < 2; ++dvt) UNR for (int s2 = 0; s2 < 2; ++s2) {
        const int vrow = dvt * 32 + r;
        const bf16x8 vf = *(const bf16x8*)(Vl + vrow * 256 + (((sub * 4 + s2 * 2 + h) ^ (vrow & 15)) << 4));
        O[dvt] = MFMA32(vf, pf[s2], O[dvt]);
      }
    }
    asm volatile("s_waitcnt vmcnt(0)" ::: "memory");
    __syncthreads();
  }
#undef NA_STAGE
#undef NA_KB
  lsum += shx(lsum, 32);
  const float inv = 1.f / lsum;
  const size_t row = (size_t)b * TB + tq;
  const bf16_t* G = PB + 6 * SEG + row * 512 + hd * 64;
  bf16_t* Y = (bf16_t*)(p.ws + OFF_Y) + row * 1024 + hd * 64;
  UNR for (int dvt = 0; dvt < 2; ++dvt) UNR for (int gq = 0; gq < 4; ++gq) {
    const int dv = dvt * 32 + 8 * gq + 4 * h;
    const u32x2 gg = *(const u32x2*)(G + dv);
    u32x2 w = {pk2(O[dvt][4 * gq] * inv * bflo(gg[0]), O[dvt][4 * gq + 1] * inv * bfhi(gg[0])), pk2(O[dvt][4 * gq + 2] * inv * bflo(gg[1]), O[dvt][4 * gq + 3] * inv * bfhi(gg[1]))};
    *(u32x2*)(Y + dv) = w;
  }
}

#ifndef HY_FENCE
#define HY_FENCE do { } while (0)
#endif
DI float sconv3(float um, float u0, float up, float w0, float w1, float w2, float cb) { return cb + w0 * um + w1 * u0 + w2 * up; }

DI void conv4(const bf16_t* rowp, int seq0, int len, int t0, float w0, float w1, float w2, float cb, float (&o)[4]) {
  const u32x2 m = *(const u32x2*)(rowp + seq0 + t0);
  const float um = t0 > 0 ? bf1(rowp[seq0 + t0 - 1]) : 0.f, up = t0 + 4 < len ? bf1(rowp[seq0 + t0 + 4]) : 0.f;
  const float u0 = bflo(m[0]), u1 = bfhi(m[0]), u2 = bflo(m[1]), u3 = bfhi(m[1]);
  o[0] = sconv3(um, u0, u1, w0, w1, w2, cb); o[1] = sconv3(u0, u1, u2, w0, w1, w2, cb); o[2] = sconv3(u1, u2, u3, w0, w1, w2, cb); o[3] = sconv3(u2, u3, up, w0, w1, w2, cb);
}

DI void hy_load_filter(const PW& p, int e, int o, int c, unsigned char* C0, unsigned char* C1) {
  const int tid = LTID(p);
  const bf16_t* grev = (const bf16_t*)(p.ws + OFF_GREV) + ((size_t)(e * 2 + o) * 512 + c) * 8192;
  UNR for (int i = 0; i < 2; ++i) { const int q = tid + i * 512; *(u32x4*)(C0 + q * 16) = *(const u32x4*)(grev + q * 8); }
  __syncthreads();
  const unsigned* c0d = (const unsigned*)C0; unsigned* c1d = (unsigned*)C1;
  UNR for (int i = 0; i < 8; ++i) { const int w = tid + i * 512; const unsigned a = c0d[w], bnx = w + 1 < 4096 ? c0d[w + 1] : 0u; c1d[w] = (a >> 16) | (bnx << 16); }
  __syncthreads();
}

DI u32x4 hy_loadA(const unsigned char* C0, const unsigned char* C1, int d, int off, int r, int h) {
  const int P0 = 4095 - 64 * d - off - r + 8 * h;
  const int odd = P0 & 1;
  const unsigned* ap = (const unsigned*)((odd ? C1 : C0) + (P0 - odd) * 2);
  u32x4 w = {ap[0], ap[1], ap[2], ap[3]};
  return w;
}
DI void hy_conv(f32x16 (&acc)[2][2], const unsigned char* Z, const unsigned char* ZR, const unsigned char* C0, const unsigned char* C1, int wid, int r, int h) {
  UNR for (int i = 0; i < 2; ++i) UNR for (int j = 0; j < 2; ++j) acc[i][j] = splat16(0.f);
  const int abase = wid * 8;
  const int bb = r & 7, ar = r >> 3;
  u32x4 F[6];
  int d = abase - 63;
  UNR for (int k = 0; k < 6; ++k) F[k] = hy_loadA(C0, C1, d, 32 - 16 * k, r, h);
  for (;;) {
    UNR for (int nt = 0; nt < 2; ++nt) {
      const int ap_ = abase + 4 * nt - d + ar; const bool valid = (unsigned)ap_ < 64u;
      const unsigned char* zp = valid ? Z + (ap_ * 8 + bb) * 144 + h * 16 : ZR + h * 16;
      UNR for (int ks = 0; ks < 4; ++ks) {
        const bf16x8 zf = *(const bf16x8*)(zp + ks * 32);
        acc[0][nt] = MFMA32(__builtin_bit_cast(bf16x8, F[2 + ks]), zf, acc[0][nt]);
        acc[1][nt] = MFMA32(__builtin_bit_cast(bf16x8, F[ks]), zf, acc[1][nt]);
      }
    }
    if (d == abase + 7) break;
    ++d;
    F[4] = F[0]; F[5] = F[1];
    UNR for (int k = 0; k < 4; ++k) F[k] = hy_loadA(C0, C1, d, 32 - 16 * k, r, h);
  }
}

DI void hyena_unit(const PW& p, int e, int c, unsigned char* smem) {
  const int tid = LTID(p), wid = __builtin_amdgcn_readfirstlane(tid >> 6), lane = tid & 63, r = lane & 31, h = lane >> 5;
  unsigned char* Z = smem; unsigned char* C0 = smem + 73728; unsigned char* C1 = C0 + 16384 + 64; unsigned char* ZR = smem + 106624;
  if (tid < 32) ((unsigned*)ZR)[tid] = 0u;
  const bf16_t* PB = (const bf16_t*)(p.ws + OFF_PB);
  const bf16_t* UT = PB + 3 * SEG;
  const bf16_t* GHT = PB + 7 * SEG;
  bf16_t* Y = (bf16_t*)(p.ws + OFF_Y);
  float cw[3][3], cbias[3];
  UNR for (int s = 0; s < 3; ++s) { UNR for (int j = 0; j < 3; ++j) cw[s][j] = p.hy_conv_w[(e * 3 + j) * 1536 + s * 512 + c]; cbias[s] = p.hy_conv_b[e * 1536 + s * 512 + c]; }
  __syncthreads();
  hy_load_filter(p, e, 0, c, C0, C1);
  _Pragma("unroll 4") for (int i = 0; i < 8; ++i) {
    const int cid = tid + i * 512, b = cid >> 9, t0 = (cid & 511) * 8;
    const bf16_t* rowp = UT + ((size_t)c * 8 + b) * TB;
    float o0[4], o1[4];
    conv4(rowp, 0, SEQ, t0, cw[0][0], cw[0][1], cw[0][2], cbias[0], o0);
    conv4(rowp, 0, SEQ, t0 + 4, cw[0][0], cw[0][1], cw[0][2], cbias[0], o1);
    u32x4 w = {pk2(o0[0], o0[1]), pk2(o0[2], o0[3]), pk2(o1[0], o1[1]), pk2(o1[2], o1[3])};
    *(u32x4*)(Z + ((t0 >> 6) * 8 + b) * 144 + (t0 & 63) * 2) = w;
  }
  __syncthreads();
  f32x16 acc[2][2];
#if DUP & 512
  hy_conv(acc, Z, ZR, C0, C1, wid, r, h);
  UNR for (int i_ = 0; i_ < 2; ++i_) UNR for (int j_ = 0; j_ < 2; ++j_) asm volatile("" :: "v"(acc[i_][j_]));
#endif
  hy_conv(acc, Z, ZR, C0, C1, wid, r, h);
  __syncthreads();
  {
    const int bb = r & 7;
    UNR for (int nt = 0; nt < 2; ++nt) {
      const int a = wid * 8 + 4 * nt + (r >> 3);
      const bf16_t* rowp = UT + ((size_t)(512 + c) * 8 + bb) * TB;
      UNR for (int mt = 0; mt < 2; ++mt) UNR for (int gq = 0; gq < 4; ++gq) {
        const int i0 = 32 * mt + 8 * gq + 4 * h; float x1[4];
        conv4(rowp, 0, SEQ, 64 * a + i0, cw[1][0], cw[1][1], cw[1][2], cbias[1], x1);
        u32x2 w = {pk2(x1[0] * acc[mt][nt][4 * gq], x1[1] * acc[mt][nt][4 * gq + 1]), pk2(x1[2] * acc[mt][nt][4 * gq + 2], x1[3] * acc[mt][nt][4 * gq + 3])};
        *(u32x2*)(Z + (a * 8 + bb) * 144 + i0 * 2) = w;
        HY_FENCE;
      }
    }
  }
  hy_load_filter(p, e, 1, c, C0, C1);
#if DUP & 512
  hy_conv(acc, Z, ZR, C0, C1, wid, r, h);
  UNR for (int i_ = 0; i_ < 2; ++i_) UNR for (int j_ = 0; j_ < 2; ++j_) asm volatile("" :: "v"(acc[i_][j_]));
#endif
  hy_conv(acc, Z, ZR, C0, C1, wid, r, h);
  __syncthreads();
  {
    const int bb = r & 7;
    UNR for (int nt = 0; nt < 2; ++nt) {
      const int a = wid * 8 + 4 * nt + (r >> 3);
      const bf16_t* rowp = UT + ((size_t)(1024 + c) * 8 + bb) * TB;
      const bf16_t* gp = GHT + ((size_t)c * 8 + bb) * TB;
      UNR for (int mt = 0; mt < 2; ++mt) UNR for (int gq = 0; gq < 4; ++gq) {
        const int i0 = 32 * mt + 8 * gq + 4 * h; float x2[4];
        conv4(rowp, 0, SEQ, 64 * a + i0, cw[2][0], cw[2][1], cw[2][2], cbias[2], x2);
        const u32x2 gg = *(const u32x2*)(gp + 64 * a + i0);
        u32x2 w = {pk2(x2[0] * acc[mt][nt][4 * gq] * bflo(gg[0]), x2[1] * acc[mt][nt][4 * gq + 1] * bfhi(gg[0])),
                   pk2(x2[2] * acc[mt][nt][4 * gq + 2] * bflo(gg[1]), x2[3] * acc[mt][nt][4 * gq + 3] * bfhi(gg[1]))};
        *(u32x2*)(Z + (a * 8 + bb) * 144 + i0 * 2) = w;
        HY_FENCE;
      }
    }
  }
  __syncthreads();
  {
    bf16_t* OT = (bf16_t*)(p.ws + OFF_HN);
    _Pragma("unroll 2") for (int i = 0; i < 8; ++i) {
      const int cid = tid + i * 512, b = cid >> 9, t0 = (cid & 511) * 8;
      *(u32x4*)(OT + ((size_t)c * 8 + b) * TB + t0) = *(const u32x4*)(Z + ((t0 >> 6) * 8 + b) * 144 + (t0 & 63) * 2);
    }
  }
  __syncthreads();
  {
    float* zc = (float*)smem;
    float* gl = zc + 2048;
    const int bb = tid >> 6, tq = tid & 63, t0 = 4 * tq;
    const bf16_t* r0 = UT + ((size_t)c * 8 + bb) * TB;
    const bf16_t* r1 = UT + ((size_t)(512 + c) * 8 + bb) * TB;
    const bf16_t* r2 = UT + ((size_t)(1024 + c) * 8 + bb) * TB;
    const bf16_t* gp = GHT + ((size_t)c * 8 + bb) * TB + SEQ;
    bf16_t* OTc = (bf16_t*)(p.ws + OFF_HN) + ((size_t)c * 8 + bb) * TB + SEQ;
    { float v4[4]; conv4(r0, SEQ, NCTX, t0, cw[0][0], cw[0][1], cw[0][2], cbias[0], v4);
      f32x4 vv = {v4[0], v4[1], v4[2], v4[3]}; *(f32x4*)(zc + bb * 256 + t0) = vv; }
    for (int o = 0; o < 2; ++o) {
      const float* gc = (const float*)(p.ws + OFF_GC) + ((size_t)(e * 2 + o) * 512 + c) * 512;
      gl[tid] = gc[tid];
      __syncthreads();
      f32x4 a4 = {0.f, 0.f, 0.f, 0.f};
      for (int s0 = 0; s0 < 256; s0 += 4) {
        const f32x4 zv = *(const f32x4*)(zc + bb * 256 + s0);
        const int base4 = 256 + t0 - s0;
        const f32x4 glo = *(const f32x4*)(gl + base4 - 4), ghi = *(const f32x4*)(gl + base4);
        const float G[8] = {glo[0], glo[1], glo[2], glo[3], ghi[0], ghi[1], ghi[2], ghi[3]};
        UNR for (int j = 0; j < 4; ++j) UNR for (int k = 0; k < 4; ++k) a4[j] += G[4 + j - k] * zv[k];
      }
      __syncthreads();
      float xv[4];
      conv4(o == 0 ? r1 : r2, SEQ, NCTX, t0, cw[1 + o][0], cw[1 + o][1], cw[1 + o][2], cbias[1 + o], xv);
      if (o == 0) { f32x4 zn = {xv[0] * a4[0], xv[1] * a4[1], xv[2] * a4[2], xv[3] * a4[3]}; *(f32x4*)(zc + bb * 256 + t0) = zn; }
      else {
        const u32x2 gg = *(const u32x2*)(gp + t0);
        u32x2 w = {pk2(xv[0] * a4[0] * bflo(gg[0]), xv[1] * a4[1] * bfhi(gg[0])), pk2(xv[2] * a4[2] * bflo(gg[1]), xv[3] * a4[3] * bfhi(gg[1]))};
        *(u32x2*)(OTc + t0) = w;
      }
      __syncthreads();
    }
  }
}

DI void hy_transpose_phase(const PW& p, int l, unsigned char* smem) {
  const int tid = LTID(p);
  const bf16_t* OT = (const bf16_t*)(p.ws + OFF_HN);
  bf16_t* Y = (bf16_t*)(p.ws + OFF_Y);
  unsigned* T = (unsigned*)smem;
  const int tb_per_b = l == 3 ? 64 : 68;
  const int ntile = 8 * tb_per_b * 8;
  const int cl = tid >> 3, part = tid & 7;
#define HT_SRC(tile) (OT + ((size_t)(((tile) & 7) * 64 + cl) * 8 + ((tile) >> 3) / tb_per_b) * TB + (((tile) >> 3) % tb_per_b) * 64 + part * 8)
  int tile = lbid();
  u32x4 v = {0u, 0u, 0u, 0u};
  if (tile < ntile) v = *(const u32x4*)HT_SRC(tile);
  for (; tile < ntile; tile += gridDim.x) {
    const int cbk = tile & 7, tb = tile >> 3, b = tb / tb_per_b, t0 = (tb % tb_per_b) * 64;
    UNR for (int j = 0; j < 4; ++j) T[cl * 33 + part * 4 + j] = v[j];
    const int nxt = tile + gridDim.x;
    if (nxt < ntile) v = *(const u32x4*)HT_SRC(nxt);
    __syncthreads();
    { const int tl = tid >> 3;
      const bf16_t* Tb = (const bf16_t*)T;
      unsigned short e[8];
      UNR for (int j = 0; j < 8; ++j) e[j] = Tb[(part * 8 + j) * 66 + tl];
      u32x4 w = {(unsigned)e[0] | ((unsigned)e[1] << 16), (unsigned)e[2] | ((unsigned)e[3] << 16), (unsigned)e[4] | ((unsigned)e[5] << 16), (unsigned)e[6] | ((unsigned)e[7] << 16)};
      *(u32x4*)(Y + ((size_t)b * TB + t0 + tl) * 1024 + 512 + cbk * 64 + part * 8) = w; }
    __syncthreads();
  }
#undef HT_SRC
}

DI void mixer_even(const PW& p, int l, unsigned char* smem, int what = 3) {
  const int e = l >> 1;
  if (what & 1) for (int c = lbid(); c < 512; c += gridDim.x) hyena_unit(p, e, c, smem);
  if (!(what & 2)) return;
  const float negM = ((const float*)(p.ws + OFF_MISC))[l];
  const int G = gridDim.x, bid = lbid();
  if ((G & 7) == 0) {
    const int hd = bid & 7, slot = bid >> 3, S = G >> 3;
    for (int i = slot; i < 128; i += S) na_block(p, e, i >> 4, hd, (i & 15) * 4, false, negM, smem);
    for (int i = slot; i < 8; i += S) na_block(p, e, i, hd, 0, true, negM, smem);
  } else {
    for (int u = bid; u < 1024 + 64; u += G) {
      if (u < 1024) { const int rg = u & 15, hd = (u >> 4) & 7, b = u >> 7; na_block(p, e, b, hd, rg * 4, false, negM, smem); }
      else { const int v = u - 1024, hd = v & 7, b = v >> 3; na_block(p, e, b, hd, 0, true, negM, smem); }
    }
  }
}

DI void diff_unit(const PW& p, int l, int b, int hd, int q0, int kbeg, int kend, float negM, float lam, float lam_init, unsigned char* smem) {
  const int tid = LTID(p), wid = __builtin_amdgcn_readfirstlane(tid >> 6), lane = tid & 63, r = lane & 31, h = lane >> 5, m = wid & 1, qg = wid >> 1;
  const bf16_t* PB = (const bf16_t*)(p.ws + OFF_PB);
  const bf16_t* Q = PB + ((size_t)(b * 8 + hd) * TB) * 128;
  const bf16_t* K = PB + 2 * SEG + ((size_t)(b * 8 + hd) * TB) * 128;
  const bf16_t* VT = PB + 4 * SEG + ((size_t)(b * 8 + hd) * 128) * TB;
  const int tq = q0 + qg * 32 + r;
  bf16x8 qf[4];
  UNR for (int ks = 0; ks < 4; ++ks) qf[ks] = *(const bf16x8*)(Q + (size_t)tq * 128 + m * 64 + ks * 16 + h * 8);
  f32x16 O[4];
  UNR for (int d = 0; d < 4; ++d) O[d] = splat16(0.f);
  float lsum = 0.f;
  const int kkey0 = tid >> 4, kpart = tid & 15;
  const int vdv0 = tid >> 3, vpart = tid & 7;
  u32x4 rk[2], rv[2];
  const int nt = (kend - kbeg) >> 6;
  UNR for (int i = 0; i < 2; ++i) { rk[i] = *(const u32x4*)(K + (size_t)(kbeg + kkey0 + 32 * i) * 128 + kpart * 8); rv[i] = *(const u32x4*)(VT + (size_t)(vdv0 + 64 * i) * TB + kbeg + vpart * 8); }
  UNR for (int i = 0; i < 2; ++i) { *(u32x4*)(smem + (kkey0 + 32 * i) * 272 + kpart * 16) = rk[i]; *(u32x4*)(smem + 17408 + (vdv0 + 64 * i) * 144 + vpart * 16) = rv[i]; }
  __syncthreads();
  for (int it = 0; it < nt; ++it) {
    const unsigned char* Kl = smem + (it & 1) * 35840; const unsigned char* Vl = Kl + 17408;
    if (it + 1 < nt) {
      const int k0 = kbeg + (it + 1) * 64;
      UNR for (int i = 0; i < 2; ++i) { rk[i] = *(const u32x4*)(K + (size_t)(k0 + kkey0 + 32 * i) * 128 + kpart * 8); rv[i] = *(const u32x4*)(VT + (size_t)(vdv0 + 64 * i) * TB + k0 + vpart * 8); }
    }
    {
      f32x16 s0 = splat16(negM), s1 = splat16(negM);
      UNR for (int ks = 0; ks < 4; ++ks) { const bf16x8 kf = *(const bf16x8*)(Kl + r * 272 + m * 128 + ks * 32 + h * 16); s0 = MFMA32(kf, qf[ks], s0); }
      UNR for (int ks = 0; ks < 4; ++ks) { const bf16x8 kf = *(const bf16x8*)(Kl + (32 + r) * 272 + m * 128 + ks * 32 + h * 16); s1 = MFMA32(kf, qf[ks], s1); }
      UNR for (int i = 0; i < 16; ++i) { s0[i] = __builtin_amdgcn_exp2f(s0[i]); lsum += s0[i]; }
      bf16x8 pf0[2]; pf0[0] = pack8(s0, 0); pf0[1] = pack8(s0, 8);
      __builtin_amdgcn_sched_barrier(0);
      UNR for (int dvt = 0; dvt < 4; ++dvt) UNR for (int s2 = 0; s2 < 2; ++s2) {
        const bf16x8 vf = *(const bf16x8*)(Vl + (dvt * 32 + r) * 144 + (s2 * 16 + 8 * h) * 2);
        O[dvt] = MFMA32(vf, pf0[s2], O[dvt]);
      }
      UNR for (int i = 0; i < 16; ++i) { s1[i] = __builtin_amdgcn_exp2f(s1[i]); lsum += s1[i]; }
      bf16x8 pf1[2]; pf1[0] = pack8(s1, 0); pf1[1] = pack8(s1, 8);
      UNR for (int g = 0; g < 8; ++g) { __builtin_amdgcn_sched_group_barrier(0x008, 1, 0); __builtin_amdgcn_sched_group_barrier(0x002, 5, 0); }
      __builtin_amdgcn_sched_barrier(0);
      UNR for (int dvt = 0; dvt < 4; ++dvt) UNR for (int s2 = 0; s2 < 2; ++s2) {
        const bf16x8 vf = *(const bf16x8*)(Vl + (dvt * 32 + r) * 144 + (32 + s2 * 16 + 8 * h) * 2);
        O[dvt] = MFMA32(vf, pf1[s2], O[dvt]);
      }
    }
    if (it + 1 < nt) {
      unsigned char* nx = smem + ((it + 1) & 1) * 35840;
      UNR for (int i = 0; i < 2; ++i) { *(u32x4*)(nx + (kkey0 + 32 * i) * 272 + kpart * 16) = rk[i]; *(u32x4*)(nx + 17408 + (vdv0 + 64 * i) * 144 + vpart * 16) = rv[i]; }
    }
    __syncthreads();
  }
  lsum += shx(lsum, 32);
  float* X = (float*)smem + qg * 4096;
  if (m == 1) {
    const float sc = lam / lsum;
    UNR for (int d = 0; d < 4; ++d) UNR for (int i = 0; i < 16; ++i) X[(d * 16 + i) * 64 + lane] = O[d][i] * sc;
  }
  __syncthreads();
  if (m == 0) {
    const float i0 = 1.f / lsum;
    float ss = 0.f;
    UNR for (int d = 0; d < 4; ++d) UNR for (int i = 0; i < 16; ++i) { const float o = O[d][i] * i0 - X[(d * 16 + i) * 64 + lane]; O[d][i] = o; ss += o * o; }
    ss += shx(ss, 32);
    const float rstd = (1.0f / sqrtf(ss * (1.f / 128.f) + 1e-6f)) * (1.f - lam_init);
    const size_t row = (size_t)b * TB + tq;
    const bf16_t* G = PB + 6 * SEG + row * 1024 + hd * 128;
    bf16_t* Y = (bf16_t*)(p.ws + OFF_Y) + row * 1024 + hd * 128;
    const float* sg = p.subln_g + (l >> 1) * 128;
    UNR for (int d = 0; d < 4; ++d) UNR for (int gq = 0; gq < 4; ++gq) {
      const int dv = d * 32 + 8 * gq + 4 * h;
      const u32x2 gg = *(const u32x2*)(G + dv); const f32x4 s4 = *(const f32x4*)(sg + dv);
      u32x2 w = {pk2(O[d][4 * gq] * rstd * s4[0] * bflo(gg[0]), O[d][4 * gq + 1] * rstd * s4[1] * bfhi(gg[0])),
                 pk2(O[d][4 * gq + 2] * rstd * s4[2] * bflo(gg[1]), O[d][4 * gq + 3] * rstd * s4[3] * bfhi(gg[1]))};
      *(u32x2*)(Y + dv) = w;
    }
  }
  __syncthreads();
}

DI void mixer_odd(const PW& p, int l, unsigned char* smem) {
  const float* MISC = (const float*)(p.ws + OFF_MISC);
  const float negM = MISC[l], lam = MISC[4 + (l >> 1)], lam_init = MISC[6 + (l >> 1)];
  const int G = gridDim.x, bid = lbid();
  if ((G & 7) == 0) {
    const int hd = bid & 7, slot = bid >> 3, S = G >> 3;
    for (int i = slot; i < 256; i += S) diff_unit(p, l, i >> 5, hd, (i & 31) * 128, 0, TB, negM, lam, lam_init, smem);
    if (l < 3) for (int i = slot; i < 16; i += S) diff_unit(p, l, i >> 1, hd, SEQ + (i & 1) * 128, SEQ, TB, negM, lam, lam_init, smem);
  } else {
    const int nun = l < 3 ? 2048 + 128 : 2048;
    for (int u = bid; u < nun; u += G) {
      if (u < 2048) { const int qb = u & 31, hd = (u >> 5) & 7, b = u >> 8; diff_unit(p, l, b, hd, qb * 128, 0, TB, negM, lam, lam_init, smem); }
      else { const int v = u - 2048, qb = v & 1, hd = (v >> 1) & 7, b = v >> 4; diff_unit(p, l, b, hd, SEQ + qb * 128, SEQ, TB, negM, lam, lam_init, smem); }
    }
  }
}

#define XB_TMO      128
#define XB_XCNT(j)  (256  + 64 * (j))
#define XB_XSUB(j)  (1280 + 64 * (j))
#define XB_XGEN(j)  (2304 + 64 * (j))
#define XB_TOP      3328
#define XB_TOPGEN   3392
#define XCD_BAR_WORDS 3456
#define XB_SPIN_CAP (1u << 18)
#ifndef LAS
#define LAS __attribute__((address_space(3)))
#endif

__device__ __forceinline__ unsigned xb_ld(unsigned* p)              { return __hip_atomic_load(p, __ATOMIC_RELAXED, __HIP_MEMORY_SCOPE_AGENT); }
__device__ __forceinline__ unsigned xb_add(unsigned* p, unsigned v) { return __hip_atomic_fetch_add(p, v, __ATOMIC_RELAXED, __HIP_MEMORY_SCOPE_AGENT); }
__device__ __forceinline__ unsigned xb_xcc_id() { return (unsigned)__builtin_amdgcn_s_getreg((3 << 11) | 20) & 0xFu; }
#define XB_SPIN(cond, bar) do { unsigned _sp = 0; while (cond) { __builtin_amdgcn_s_sleep(1); \
    if ((++_sp & 255u) == 0u) { if (xb_ld(&(bar)[XB_TMO])) break; if (_sp > XB_SPIN_CAP) { atomicAdd(&(bar)[XB_TMO], 1u); break; } } } } while (0)

struct XcdBarrier {
    unsigned* bar; unsigned x;
    volatile LAS unsigned* st;
};

__device__ __forceinline__ XcdBarrier xcd_barrier_post(unsigned* bar, volatile LAS unsigned* st) {
    XcdBarrier b; b.bar = bar; b.x = xb_xcc_id(); b.st = st;
    if (threadIdx.x == 0) (void)xb_add(&bar[XB_XCNT(b.x)], 1u);
    return b;
}
__device__ __forceinline__ void xcd_barrier_complete(unsigned* bar, unsigned x, unsigned& nloc, unsigned& nx) {
    const unsigned G = gridDim.x * gridDim.y * gridDim.z;
    unsigned sum, cnt, mine, sp = 0u;
    for (;;) {
        sum = 0u; cnt = 0u; mine = 0u;
#pragma unroll
        for (unsigned j = 0; j < 16; ++j) { const unsigned c = xb_ld(&bar[XB_XCNT(j)]); sum += c; cnt += (c > 0u) ? 1u : 0u; mine = (j == x) ? c : mine; }
        if (sum == G) break;
        __builtin_amdgcn_s_sleep(1);
        if ((++sp & 255u) == 0u) { if (xb_ld(&bar[XB_TMO])) break; if (sp > XB_SPIN_CAP) { atomicAdd(&bar[XB_TMO], 1u); break; } }
    }
    nloc = mine > 0u ? mine : 1u; nx = cnt > 0u ? cnt : 1u;
}

__device__ __forceinline__ void xcd_barrier(const XcdBarrier& b) {
    asm volatile("s_waitcnt vmcnt(0)" ::: "memory");
    __syncthreads();
    if (threadIdx.x == 0) {
        unsigned* bar = b.bar;
        __builtin_amdgcn_s_waitcnt(0);
        unsigned nloc = b.st[0], nx = b.st[1];
        if (nloc == 0u) { xcd_barrier_complete(bar, b.x, nloc, nx); b.st[0] = nloc; b.st[1] = nx; }
        const unsigned old = xb_add(&bar[XB_XSUB(b.x)], 1u);
        const unsigned gen = old / nloc;
        if (old + 1u == (gen + 1u) * nloc) {
            __builtin_amdgcn_fence(__ATOMIC_RELEASE, "agent");
            asm volatile("s_waitcnt vmcnt(0)" ::: "memory");
            const unsigned og = xb_add(&bar[XB_TOP], 1u);
            const unsigned tg = og / nx;
            if (og + 1u == (tg + 1u) * nx) xb_add(&bar[XB_TOPGEN], 1u);
            else XB_SPIN(xb_ld(&bar[XB_TOPGEN]) == tg, bar);
            __builtin_amdgcn_fence(__ATOMIC_ACQUIRE, "agent");
            xb_add(&bar[XB_XGEN(b.x)], 1u);
            asm volatile("s_waitcnt vmcnt(0)" ::: "memory");
        } else {
            XB_SPIN(xb_ld(&bar[XB_XGEN(b.x)]) == gen, bar);
            __builtin_amdgcn_fence(__ATOMIC_ACQUIRE, "agent");
            asm volatile("s_waitcnt vmcnt(0)" ::: "memory");
        }
    }
    __syncthreads();
}

typedef const Params __attribute__((address_space(4))) KParams;
DI void load_params(PW& q, KParams* k) { q.x = k->x; q.c = k->c; q.ctx = k->ctx; q.c_ctx = k->c_ctx; q.norm_g = k->norm_g; q.w_mod = k->w_mod; q.b_mod = k->b_mod; q.w_in = k->w_in; q.w_out = k->w_out; q.q_norm_g = k->q_norm_g; q.k_norm_g = k->k_norm_g; q.na_rpb = k->na_rpb; q.hy_conv_w = k->hy_conv_w; q.hy_conv_b = k->hy_conv_b; q.f_w1 = k->f_w1; q.f_b1 = k->f_b1; q.f_freq = k->f_freq; q.f_w2 = k->f_w2; q.f_b2 = k->f_b2; q.f_w3 = k->f_w3; q.f_b3 = k->f_b3; q.hy_skip = k->hy_skip; q.lq1 = k->lq1; q.lk1 = k->lk1; q.lq2 = k->lq2; q.lk2 = k->lk2; q.subln_g = k->subln_g; q.out = k->out; q.ws = k->ws; }
#define LAUNDER() do { ll = l; asm volatile("" : "+s"(ll)); KParams* k_ = kp; asm volatile("" : "+s"(k_)); load_params(q, k_); int w_ = wid0; asm volatile("" : "+s"(w_)); q.wid0 = w_; } while (0)
__global__ void __launch_bounds__(512) mega(Params p) {
  __shared__ __attribute__((aligned(16))) unsigned char smem[131072];
  __shared__ __attribute__((aligned(16))) unsigned xb_st[4];
  cg::grid_group grid = cg::this_grid();
  if (threadIdx.x < 4) xb_st[threadIdx.x] = 0u;
  __syncthreads();
  KParams* kp = (KParams*)__builtin_amdgcn_kernarg_segment_ptr();
  const int wid0 = __builtin_amdgcn_readfirstlane((int)(threadIdx.x >> 6));
  PW q; int ll = 0;
  { int l = 0; LAUNDER(); }
  if (blockIdx.x == 0) for (int i = threadIdx.x; i < 4096; i += 512) ((unsigned*)(q.ws + OFF_BAR))[i] = 0u;
  phase0(q, smem);
#if DUP & 8
  { int l = 0; LAUNDER(); phase0(q, smem); }
#endif
  grid.sync();
  const XcdBarrier xbar = xcd_barrier_post((unsigned*)(q.ws + OFF_BAR), (volatile LAS unsigned*)xb_st);
  for (int l = 0; l < 4; ++l) {
    LAUNDER();
    if (l == 0) finalize_filters(q);
    norm_phase(q, ll);
#if DUP & 16
    LAUNDER(); norm_phase(q, ll);
#endif
    xcd_barrier(xbar);
    LAUNDER();
    if (ll & 1) gemm_phase<1>(q, ll, smem); else gemm_phase<0>(q, ll, smem);
#if DUP & 1
    LAUNDER();
    if (ll & 1) gemm_phase<1>(q, ll, smem); else gemm_phase<0>(q, ll, smem);
#endif
    xcd_barrier(xbar);
    LAUNDER();
    if (ll & 1) mixer_odd(q, ll, smem); else mixer_even(q, ll, smem);
#if DUP & 2
    LAUNDER();
    if (!(ll & 1)) mixer_even(q, ll, smem);
#endif
#if DUP & 128
    LAUNDER();
    if (!(ll & 1)) mixer_even(q, ll, smem, 1);
#endif
#if DUP & 256
    LAUNDER();
    if (!(ll & 1)) mixer_even(q, ll, smem, 2);
#endif
#if DUP & 4
    LAUNDER();
    if (ll & 1) mixer_odd(q, ll, smem);
#endif
    xcd_barrier(xbar);
    LAUNDER();
    if (!(ll & 1)) { hy_transpose_phase(q, ll, smem); xcd_barrier(xbar); LAUNDER(); }
    gemm_phase<2>(q, ll, smem);
#if DUP & 32
    xcd_barrier(xbar); xcd_barrier(xbar); xcd_barrier(xbar); xcd_barrier(xbar);
#endif
#if DUP & 64
    if (l == 0) { LAUNDER(); gemm_phase<2>(q, ll, smem); }
#endif
    if (l < 3) xcd_barrier(xbar);
  }
}

extern "C" void kernel_launch(void* const* d_in, const int* in_sizes, int n_in, void* d_out, int out_size,
                              void* d_ws, size_t ws_size, hipStream_t stream) {
  static int grid_blocks = 0;
  if (!grid_blocks) {
    int dev = 0, cus = 0, per_cu = 0;
    (void)hipGetDevice(&dev);
    (void)hipDeviceGetAttribute(&cus, hipDeviceAttributeMultiprocessorCount, dev);
    (void)hipOccupancyMaxActiveBlocksPerMultiprocessor(&per_cu, mega, 512, 0);
    if (per_cu > 1) per_cu = 1;
    grid_blocks = cus * per_cu;
  }
  if (ws_size < WS_NEED) { fprintf(stderr, "workspace too small: %zu < %zu\n", ws_size, (size_t)WS_NEED); return; }
  Params p{};
  const float** pp = (const float**)&p;
  for (int i = 0; i < 27; ++i) pp[i] = (const float*)d_in[i];
  p.out = (float*)d_out; p.ws = (unsigned char*)d_ws;
  void* args[] = {&p};
  hipError_t e = hipLaunchCooperativeKernel((void*)mega, dim3(grid_blocks), dim3(512), args, 0, stream);
  if (e != hipSuccess) fprintf(stderr, "coop launch failed: %s (grid %d)\n", hipGetErrorString(e), grid_blocks);
}
```

```cpp
#ifndef DUP
#define DUP 0
#endif
#include <hip/hip_runtime.h>
#include <hip/hip_cooperative_groups.h>
#include <cstdio>
namespace cg = cooperative_groups;

typedef unsigned short bf16_t;
typedef short bf16x8 __attribute__((ext_vector_type(8)));
typedef float f32x16 __attribute__((ext_vector_type(16)));
typedef float f32x4 __attribute__((ext_vector_type(4)));
typedef unsigned u32x4 __attribute__((ext_vector_type(4)));
typedef unsigned u32x2 __attribute__((ext_vector_type(2)));
typedef __bf16 bf16v2 __attribute__((ext_vector_type(2)));
#define DI __device__ __forceinline__
#define MFMA32(a, b, c) __builtin_amdgcn_mfma_f32_32x32x16_bf16((a), (b), (c), 0, 0, 0)
#define UNR _Pragma("unroll")

constexpr int R = 34816, TB = 4352, SEQ = 4096, NCTX = 256;
constexpr float LOG2E = 1.4426950408889634f;
constexpr size_t SEG = (size_t)R * 512;
constexpr size_t OFF_WIN = 0;
constexpr size_t OFF_WOUT = OFF_WIN + 4ull * 4096 * 1024 * 2;
constexpr size_t OFF_MOD = OFF_WOUT + 4ull * 1024 * 1024 * 2;
constexpr size_t OFF_HN = OFF_MOD + 4ull * 9 * 3072 * 4;
constexpr size_t OFF_PB = OFF_HN + (size_t)R * 1024 * 2;
constexpr size_t OFF_Y = OFF_PB + (size_t)R * 4096 * 2;
constexpr size_t OFF_XC = OFF_Y + (size_t)R * 1024 * 2;
constexpr size_t OFF_GREV = OFF_XC + 8ull * 256 * 1024 * 4;
constexpr size_t OFF_GC = OFF_GREV + 2ull * 2 * 512 * 8192 * 2;
constexpr size_t OFF_MISC = OFF_GC + 2ull * 2 * 512 * 512 * 4;
constexpr size_t OFF_BAR = OFF_MISC + 4096;
constexpr size_t WS_NEED = OFF_BAR + 16384;
constexpr size_t OFF_HRAW = OFF_PB;
constexpr size_t OFF_HRAWC = OFF_HRAW + 2ull * 2 * 2 * 512 * 4096 * 4;
constexpr size_t OFF_SSP = OFF_HRAWC + 2ull * 2 * 2 * 512 * 256 * 4;

struct Params {
  const float *x, *c, *ctx, *c_ctx, *norm_g, *w_mod, *b_mod, *w_in, *w_out, *q_norm_g, *k_norm_g, *na_rpb, *hy_conv_w, *hy_conv_b,
      *f_w1, *f_b1, *f_freq, *f_w2, *f_b2, *f_w3, *f_b3, *hy_skip, *lq1, *lk1, *lq2, *lk2, *subln_g;
  float* out;
  unsigned char* ws;
};
struct PW : Params { int wid0; };

DI unsigned pk2(float a, float b) { bf16v2 v = {(__bf16)a, (__bf16)b}; return __builtin_bit_cast(unsigned, v); }
DI float bflo(unsigned u) { return __uint_as_float(u << 16); }
DI float bfhi(unsigned u) { return __uint_as_float(u & 0xffff0000u); }
DI float bf1(bf16_t u) { return __uint_as_float((unsigned)u << 16); }
DI int crow(int reg, int h) { return (reg & 3) + 8 * (reg >> 2) + 4 * h; }
DI float silu(float x) { return x / (1.f + __expf(-x)); }
DI int lane_l() { int l = __builtin_amdgcn_mbcnt_hi(~0u, __builtin_amdgcn_mbcnt_lo(~0u, 0u)); asm volatile("" : "+v"(l)); return l; }
DI float shx(float v, int o) { return __int_as_float(__builtin_amdgcn_ds_bpermute((lane_l() ^ o) << 2, __float_as_int(v))); }
DI float wave_sum(float v) { UNR for (int o = 32; o > 0; o >>= 1) v += shx(v, o); return v; }
DI float wave_max(float v) { UNR for (int o = 32; o > 0; o >>= 1) v = fmaxf(v, shx(v, o)); return v; }
DI f32x16 splat16(float v) { f32x16 r; UNR for (int i = 0; i < 16; ++i) r[i] = v; return r; }
DI bf16x8 pack8(const f32x16& s, int o) {
  u32x4 w; w[0] = pk2(s[o], s[o + 1]); w[1] = pk2(s[o + 2], s[o + 3]); w[2] = pk2(s[o + 4], s[o + 5]); w[3] = pk2(s[o + 6], s[o + 7]);
  return __builtin_bit_cast(bf16x8, w);
}

#define LTID(p) (((p).wid0 << 6) | lane_l())
DI int lbid() { int b = blockIdx.x; asm volatile("" : "+s"(b)); return b; }
DI void transpose_jobs(const PW& p, float* tile) {
  const int tid = LTID(p);
  constexpr int J_TIN = 4 * 16 * 64, J_ALL = J_TIN + 4 * 16 * 16;
  const int kk = tid >> 4, n4 = (tid & 15) * 4, n = tid >> 3, kc = tid & 7;
#define TJ_SRC(j, pass) ((j) < J_TIN ? p.w_in + (size_t)((j) >> 10) * 1024 * 4096 + (size_t)((((j) >> 6) & 15) * 64 + (pass) * 32 + kk) * 4096 + ((j) & 63) * 64 + n4 \
                                     : p.w_out + (size_t)(((j) - J_TIN) >> 8) * 1024 * 1024 + (size_t)(((((j) - J_TIN) >> 4) & 15) * 64 + (pass) * 32 + kk) * 1024 + (((j) - J_TIN) & 15) * 64 + n4)
  int j = lbid();
  f32x4 v0 = {0.f, 0.f, 0.f, 0.f}, v1 = v0;
  if (j < J_ALL) { v0 = *(const f32x4*)TJ_SRC(j, 0); v1 = *(const f32x4*)TJ_SRC(j, 1); }
  for (; j < J_ALL; j += gridDim.x) {
    UNR for (int e = 0; e < 4; ++e) { tile[kk * 65 + n4 + e] = v0[e]; tile[(32 + kk) * 65 + n4 + e] = v1[e]; }
    const int jn = j + gridDim.x;
    if (jn < J_ALL) { v0 = *(const f32x4*)TJ_SRC(jn, 0); v1 = *(const f32x4*)TJ_SRC(jn, 1); }
    __syncthreads();
    u32x4 w;
    UNR for (int q = 0; q < 4; ++q) w[q] = pk2(tile[(kc * 8 + 2 * q) * 65 + n], tile[(kc * 8 + 2 * q + 1) * 65 + n]);
    const bool isin = j < J_TIN; const int jj = isin ? j : j - J_TIN;
    const int l = isin ? jj >> 10 : jj >> 8, tk = isin ? (jj >> 6) & 15 : (jj >> 4) & 15, tn = isin ? jj & 63 : jj & 15;
    bf16_t* Wt = isin ? (bf16_t*)(p.ws + OFF_WIN) + (size_t)l * 4096 * 1024 : (bf16_t*)(p.ws + OFF_WOUT) + (size_t)l * 1024 * 1024;
    { const int cn = tn * 64 + n, c = cn & 255; const int pos = (cn & ~255) + 128 * ((c >> 5) & 1) + 32 * (c >> 6) + (c & 31);
      *(u32x4*)(Wt + (size_t)pos * 1024 + tk * 64 + kc * 8) = w; }
    __syncthreads();
  }
#undef TJ_SRC
}

DI void job_mod(const PW& p, int l, int cgp, float* sv, float* red) {
  const int tid = LTID(p);
  float* MOD = (float*)(p.ws + OFF_MOD);
  for (int i = tid; i < 9 * 1024; i += 512) { const int v = i >> 10, k = i & 1023; const float c = v < 8 ? p.c[v * 1024 + k] : p.c_ctx[k]; sv[i] = silu(c); }
  __syncthreads();
  const int kg = tid >> 6, cn = tid & 63, n = cgp * 64 + cn;
  float acc[9];
  UNR for (int v = 0; v < 9; ++v) acc[v] = 0.f;
  const float* W = p.w_mod + (size_t)l * 1024 * 3072 + n;
  for (int k = kg * 128; k < kg * 128 + 128; k += 16) {
    float w[16];
    UNR for (int u = 0; u < 16; ++u) w[u] = W[(size_t)(k + u) * 3072];
    UNR for (int v = 0; v < 9; ++v) UNR for (int u4 = 0; u4 < 4; ++u4) { const f32x4 s4 = *(const f32x4*)(sv + v * 1024 + k + u4 * 4); UNR for (int j = 0; j < 4; ++j) acc[v] += s4[j] * w[u4 * 4 + j]; }
  }
  UNR for (int v = 0; v < 9; ++v) red[(kg * 9 + v) * 64 + cn] = acc[v];
  __syncthreads();
  for (int i = tid; i < 9 * 64; i += 512) {
    const int v = i >> 6, c2 = i & 63; float s = 0.f;
    UNR for (int g = 0; g < 8; ++g) s += red[(g * 9 + v) * 64 + c2];
    MOD[(l * 9 + v) * 3072 + cgp * 64 + c2] = s + p.b_mod[l * 3072 + cgp * 64 + c2];
  }
  __syncthreads();
}

DI void job_filter(const PW& p, int e, int chunk, int cb, float* zs, float* h1, float* h2) {
  const int tid = LTID(p);
  const bool isc = chunk >= 256; const int L = isc ? 256 : 4096; const int t0 = (isc ? chunk - 256 : chunk) * 16;
  for (int i = tid; i < 16 * 33; i += 512) {
    const int tt = i / 33, f = i % 33, t = t0 + tt; float val;
    if (f == 0) val = (float)t / (float)(L - 1);
    else { const int k = (f - 1) & 15; const float fb = 1e-4f + (float)k * ((15.f - 1e-4f) / 15.f); float rev = fb * (float)t / (float)L; rev -= floorf(rev);
           val = f <= 16 ? __builtin_amdgcn_cosf(rev) : -__builtin_amdgcn_sinf(rev); }
    zs[i] = val;
  }
  __syncthreads();
  for (int i = tid; i < 1024; i += 512) {
    const int tt = i >> 6, j = i & 63; float a = p.f_b1[e * 64 + j];
    for (int f = 0; f < 33; ++f) a += zs[tt * 33 + f] * p.f_w1[(e * 33 + f) * 64 + j];
    h1[i] = __sinf(p.f_freq[e * 64 + j] * a);
  }
  __syncthreads();
  for (int i = tid; i < 1024; i += 512) {
    const int tt = i >> 6, j = i & 63; float a = p.f_b2[e * 64 + j];
    for (int k = 0; k < 64; ++k) a += h1[tt * 64 + k] * p.f_w2[(e * 64 + k) * 64 + j];
    h2[j * 16 + tt] = __sinf(p.f_freq[e * 64 + j] * a);
  }
  __syncthreads();
  const int n = cb * 512 + tid;
  float acc[16];
  { const float b3 = p.f_b3[e * 2048 + n]; UNR for (int tt = 0; tt < 16; ++tt) acc[tt] = b3; }
  _Pragma("unroll 4") for (int k = 0; k < 64; ++k) {
    const float w = p.f_w3[((size_t)e * 64 + k) * 2048 + n];
    UNR for (int q4 = 0; q4 < 4; ++q4) { const f32x4 hv = *(const f32x4*)(h2 + k * 16 + q4 * 4); UNR for (int j = 0; j < 4; ++j) acc[q4 * 4 + j] += hv[j] * w; }
  }
  const float mind = logf(1e-2f) / 1.5f, maxd = logf(1e-2f) / 0.3f;
  const float delta = fabsf(mind + (float)tid * ((maxd - mind) / 511.f));
  float ss = 0.f;
  UNR for (int tt = 0; tt < 16; ++tt) { const float tl = (float)(t0 + tt) / (float)(L - 1); acc[tt] *= __expf(-tl * delta); ss += acc[tt] * acc[tt]; }
  float* dst = isc ? (float*)(p.ws + OFF_HRAWC) + ((size_t)(e * 4 + cb) * 512 + tid) * 256 + t0 : (float*)(p.ws + OFF_HRAW) + ((size_t)(e * 4 + cb) * 512 + tid) * 4096 + t0;
  UNR for (int q = 0; q < 4; ++q) { f32x4 v = {acc[4 * q], acc[4 * q + 1], acc[4 * q + 2], acc[4 * q + 3]}; *(f32x4*)(dst + 4 * q) = v; }
  ((float*)(p.ws + OFF_SSP))[((size_t)e * 272 + chunk) * 2048 + n] = ss;
  __syncthreads();
}

DI void job_misc(const PW& p) {
  const int tid_ = LTID(p); const int wid = __builtin_amdgcn_readfirstlane(tid_ >> 6), lane = tid_ & 63;
  float* MISC = (float*)(p.ws + OFF_MISC);
  if (wid != 0) return;
  for (int l = 0; l < 4; ++l) {
    const float mq = wave_max(fabsf(p.q_norm_g[l * 64 + lane])), mk = wave_max(fabsf(p.k_norm_g[l * 64 + lane]));
    float bound = 8.f * mq * mk;
    if ((l & 1) == 0) { float mr = 0.f; const float* rp = p.na_rpb + (size_t)(l >> 1) * 8 * 15 * 31; for (int i = lane; i < 8 * 15 * 31; i += 64) mr = fmaxf(mr, fabsf(rp[i])); bound += wave_max(mr); }
    if (lane == 0) MISC[l] = -bound * LOG2E;
  }
  for (int o = 0; o < 2; ++o) {
    const float s1 = wave_sum(p.lq1[o * 64 + lane] * p.lk1[o * 64 + lane]), s2 = wave_sum(p.lq2[o * 64 + lane] * p.lk2[o * 64 + lane]);
    const float lam_init = 0.8f - 0.6f * expf(-0.3f * (float)(2 * o + 1));
    if (lane == 0) { MISC[4 + o] = expf(s1) - expf(s2) + lam_init; MISC[6 + o] = lam_init; }
  }
}

DI void phase0(const PW& p, unsigned char* smem) {
  float* fs = (float*)smem;
  transpose_jobs(p, fs);
  constexpr int J_MOD = 4 * 48, J_FIL = 2 * 272 * 4;
  constexpr int NJ = J_MOD + J_FIL + 1;
  for (int job = lbid(); job < NJ; job += gridDim.x) {
    int j = job;
    if (j < J_MOD) { job_mod(p, j / 48, j % 48, fs, fs + 9 * 1024); continue; }
    j -= J_MOD;
    if (j < J_FIL) { const int e = j / (272 * 4), chunk = (j / 4) % 272, cb = j % 4; job_filter(p, e, chunk, cb, fs, fs + 16 * 33, fs + 16 * 33 + 1024); continue; }
    job_misc(p);
  }
}

DI void finalize_filters(const PW& p) {
  const int tid_ = LTID(p); const int wid = __builtin_amdgcn_readfirstlane(tid_ >> 6), lane = tid_ & 63;
  const float* SSP = (const float*)(p.ws + OFF_SSP);
  for (int job = lbid() * 8 + wid; job < 2048; job += gridDim.x * 8) {
    const int e = job >> 10, o = (job >> 9) & 1, c = job & 511;
    float ss = 0.f;
    for (int i = lane; i < 512; i += 64) ss += SSP[((size_t)e * 272 + (i >> 1)) * 2048 + o * 1024 + (i & 1) * 512 + c];
    ss = wave_sum(ss);
    float ssc = 0.f;
    if (lane < 32) ssc = SSP[((size_t)e * 272 + 256 + (lane >> 1)) * 2048 + o * 1024 + (lane & 1) * 512 + c];
    ssc = wave_sum(ssc);
    const float rs = 1.0f / sqrtf(ss + 1e-6f), rsc = 1.0f / sqrtf(ssc + 1e-6f);
    const float skip = p.hy_skip[(e * 2 + o) * 512 + c];
    const float* hf = (const float*)(p.ws + OFF_HRAW) + ((size_t)((e * 2 + o) * 2 + 0) * 512 + c) * 4096;
    const float* hb = (const float*)(p.ws + OFF_HRAW) + ((size_t)((e * 2 + o) * 2 + 1) * 512 + c) * 4096;
    unsigned* dst = (unsigned*)((bf16_t*)(p.ws + OFF_GREV) + ((size_t)(e * 2 + o) * 512 + c) * 8192);
    const float diag = rs * (hf[0] + hb[0]) + skip;
    _Pragma("unroll 8") for (int pp = lane * 2; pp < 8192; pp += 128) {
      float v[2];
      UNR for (int u = 0; u < 2; ++u) { const int d = 4095 - (pp + u); v[u] = d > 0 ? rs * hf[d] : (d == 0 ? diag : (d > -4096 ? rs * hb[-d] : 0.f)); }
      dst[pp >> 1] = pk2(v[0], v[1]);
    }
    const float* hfc = (const float*)(p.ws + OFF_HRAWC) + ((size_t)((e * 2 + o) * 2 + 0) * 512 + c) * 256;
    const float* hbc = (const float*)(p.ws + OFF_HRAWC) + ((size_t)((e * 2 + o) * 2 + 1) * 512 + c) * 256;
    float* gc = (float*)(p.ws + OFF_GC) + ((size_t)(e * 2 + o) * 512 + c) * 512;
    for (int q = lane; q < 512; q += 64) {
      const int d = q - 256;
      gc[q] = q == 0 ? 0.f : (d > 0 ? rsc * hfc[d] : (d == 0 ? rsc * (hfc[0] + hbc[0]) + skip : rsc * hbc[-d]));
    }
  }
}

DI void norm_phase(const PW& p, int l) {
  const int tid_ = LTID(p); const int wid = __builtin_amdgcn_readfirstlane(tid_ >> 6), lane = tid_ & 63;
  const float* MOD = (const float*)(p.ws + OFF_MOD);
  bf16_t* HN = (bf16_t*)(p.ws + OFF_HN);
  const float* xc_in = l == 0 ? p.ctx : (const float*)(p.ws + OFF_XC);
  const float* x_in = l == 0 ? p.x : p.out;
  const int nw = gridDim.x * 8;
  for (int row = lbid() * 8 + wid; row < R; row += 2 * nw) {
    const float* src[2]; const float* mv[2]; int rr[2];
    UNR for (int q = 0; q < 2; ++q) {
      rr[q] = row + q * nw; const int rq = rr[q] < R ? rr[q] : row;
      const int b = rq / TB, t = rq % TB;
      src[q] = t < SEQ ? x_in + ((size_t)b * SEQ + t) * 1024 : xc_in + ((size_t)b * NCTX + (t - SEQ)) * 1024;
      mv[q] = MOD + (size_t)(l * 9 + (t < SEQ ? b : 8)) * 3072;
    }
    f32x4 v[2][4]; float ss[2] = {0.f, 0.f};
    UNR for (int q = 0; q < 2; ++q) UNR for (int i = 0; i < 4; ++i) v[q][i] = *(const f32x4*)(src[q] + i * 256 + lane * 4);
    UNR for (int q = 0; q < 2; ++q) UNR for (int i = 0; i < 4; ++i) ss[q] += v[q][i][0] * v[q][i][0] + v[q][i][1] * v[q][i][1] + v[q][i][2] * v[q][i][2] + v[q][i][3] * v[q][i][3];
    UNR for (int o = 32; o > 0; o >>= 1) { ss[0] += shx(ss[0], o); ss[1] += shx(ss[1], o); }
    UNR for (int q = 0; q < 2; ++q) {
      if (rr[q] >= R) continue;
      const float rstd = 1.0f / sqrtf(ss[q] * (1.f / 1024.f) + 1e-6f);
      UNR for (int i = 0; i < 4; ++i) {
        const int c0 = i * 256 + lane * 4;
        const f32x4 g = *(const f32x4*)(p.norm_g + l * 1024 + c0), sh = *(const f32x4*)(mv[q] + c0), sc = *(const f32x4*)(mv[q] + 1024 + c0);
        float o[4];
        UNR for (int j = 0; j < 4; ++j) o[j] = v[q][i][j] * rstd * g[j] * (1.f + sc[j]) + sh[j];
        u32x2 w = {pk2(o[0], o[1]), pk2(o[2], o[3])};
        *(u32x2*)(HN + (size_t)rr[q] * 1024 + c0) = w;
      }
    }
  }
}

namespace pg8 {
#define PG8_LAS __attribute__((address_space(3)))
typedef unsigned short bf16_t;
typedef short bf16x8 __attribute__((ext_vector_type(8)));
typedef float f32x4 __attribute__((ext_vector_type(4)));
typedef unsigned u32x4 __attribute__((ext_vector_type(4)));
constexpr int BM = 256, BK = 64, HALF = 128, HTB = HALF * BK * 2  , STAGE_BYTES = 8 * HTB, NXCD = 8, WGM = 8;

__host__ __device__ __forceinline__ int lds_byte(int r, int c) { const int st = (r >> 4) * 2 + (c >> 5), rr = r & 15, cc = c & 31, ob = rr * 64 + cc * 2; return st * 1024 + (ob ^ (((ob >> 9) & 1) << 5)); }
__host__ __device__ __forceinline__ void stage_rc(int b, int& R, int& C) { const int st = b / 1024, sb = b % 1024, swz = sb ^ (((sb >> 9) & 1) << 5); R = (st >> 1) * 16 + swz / 64; C = (st & 1) * 32 + (swz % 64) / 2; }
__host__ __device__ __forceinline__ int perm32(int rho) { const int n = rho >> 4, i = rho & 15; return 8 * (i >> 2) + 4 * n + (i & 3); }

struct Unit { int pm, pn; };
struct Gemm { const bf16_t* A; const bf16_t* Bt; int M, N, K; };

struct StaticOrder {
    int nM, nN, nwg, G, c;
    __host__ __device__ void init(int M, int N, int G_, int c_) { nM = M / BM; nN = N / BM; nwg = nM * nN; G = G_; c = c_; }
    __host__ __device__ bool next(int i, Unit& u) const {
        const long L = (long)i * G + c; if (L >= nwg) return false;
        int wgid = (int)L; { const int q = nwg / NXCD, r = nwg % NXCD, xcd = wgid % NXCD, off = wgid / NXCD; wgid = (xcd < r ? xcd * (q + 1) : r * (q + 1) + (xcd - r) * q) + off; }
        const int nig = WGM * nN, gid = wgid / nig, fm = gid * WGM, gsz = (nM - fm) < WGM ? (nM - fm) : WGM;
        u.pm = fm + ((wgid % nig) % gsz); u.pn = (wgid % nig) / gsz; return true;
    }
    __device__ __forceinline__ void a_ready(const Unit&) const {}
    __device__ __forceinline__ void done(const Unit&) const {}
};
template <class Epi, class Sched, bool ALIGN_EPI = false, bool SP2 = false>
__device__ __forceinline__ void gemm_phase(PG8_LAS unsigned char* lds, const Gemm g, const Sched& S, const Epi& E, const int tid0) {
    const int tid = tid0, wid = __builtin_amdgcn_readfirstlane(tid >> 6), lane = tid & 63, wr = wid >> 2, wc = wid & 3, fr = lane & 15, fq = lane >> 4;
    const int K = g.K, nt = K / BK;
    unsigned voffA[2], voffB[2];
#pragma unroll
    for (int i = 0; i < 2; ++i) { int R, C; stage_rc(tid * 16 + i * 8192, R, C); const int Rb = Epi::PERM ? ((R & ~31) + perm32(R & 31)) : R;
        voffA[i] = (unsigned)(R * K + C) * 2u; voffB[i] = (unsigned)(Rb * K + C) * 2u; }
    const size_t kstep = (size_t)(BK * 2);
    const size_t hstep = (size_t)HALF * K * 2;
    const size_t tstep = 2 * hstep;
    const unsigned ldsw = (unsigned)wid * 1024u;
    const int aoff = lds_byte(wr * 64 + fr, fq * 8), boff = lds_byte(wc * 32 + fr, fq * 8);
#define PG8_SA(b, h) (((b) * 2 + (h)) * HTB)
#define PG8_SB(b, h) ((4 + (b) * 2 + (h)) * HTB)
#define PG8_STAGE(bufoff, gbase, voff) do { _Pragma("unroll") for (int _i = 0; _i < 2; ++_i) \
        __builtin_amdgcn_global_load_lds((const unsigned*)((const char*)(gbase) + (voff)[_i]), (PG8_LAS unsigned*)(lds + (bufoff) + ldsw + _i * 8192), 16, 0, 0); } while (0)
#define PG8_LDA(dst, b, h) do { _Pragma("unroll") for (int m = 0; m < 4; ++m) _Pragma("unroll") for (int k = 0; k < 2; ++k) dst[m][k] = *(const PG8_LAS bf16x8*)(lds + PG8_SA(b, h) + aoff + m * 2048 + k * 1024); } while (0)
#define PG8_LDB(dst, b, h) do { _Pragma("unroll") for (int n = 0; n < 2; ++n) _Pragma("unroll") for (int k = 0; k < 2; ++k) dst[n][k] = *(const PG8_LAS bf16x8*)(lds + PG8_SB(b, h) + boff + n * 2048 + k * 1024); } while (0)
#define PG8_MMA(ai, bj, At, Bt) do { __builtin_amdgcn_s_setprio(1); _Pragma("unroll") for (int m = 0; m < 4; ++m) _Pragma("unroll") for (int n = 0; n < 2; ++n) _Pragma("unroll") for (int k = 0; k < 2; ++k) \
        acc[ai][bj][m][n] = __builtin_amdgcn_mfma_f32_16x16x32_bf16(Bt[n][k], At[m][k], acc[ai][bj][m][n], 0, 0, 0); __builtin_amdgcn_s_setprio(0); } while (0)
#define PG8_WAIT_V(n) asm volatile("s_waitcnt vmcnt(" #n ")" ::: "memory")
#define PG8_WAIT_L(n) asm volatile("s_waitcnt lgkmcnt(" #n ")" ::: "memory")
#define PG8_BAR __builtin_amdgcn_s_barrier()
#define PG8_SCHED __builtin_amdgcn_sched_barrier(0)
    Unit cur, nxt; int ui = 0;
    if (!S.next(0, cur)) return;
    f32x4 acc[2][2][4][2];
#pragma unroll
    for (int a = 0; a < 2; ++a)
#pragma unroll
        for (int b = 0; b < 2; ++b)
#pragma unroll
            for (int m = 0; m < 4; ++m)
#pragma unroll
                for (int n = 0; n < 2; ++n) acc[a][b][m][n] = (f32x4){0.f, 0.f, 0.f, 0.f};
    bf16x8 At[4][2], B0[2][2], B1[2][2];
    const char* cA = E.normal(cur) ? (const char*)g.Bt + (size_t)cur.pn * tstep : (const char*)g.A + (size_t)cur.pm * tstep; const char* cB = E.normal(cur) ? (const char*)g.A + (size_t)cur.pm * tstep : (const char*)g.Bt + (size_t)cur.pn * tstep;
    S.a_ready(cur);
    if constexpr (SP2) {
        PG8_STAGE(PG8_SB(0, 0), cB, voffB); PG8_STAGE(PG8_SB(0, 1), cB + hstep, voffB); PG8_STAGE(PG8_SA(0, 0), cA, voffA); PG8_STAGE(PG8_SA(0, 1), cA + hstep, voffA);
        if (wr == 1) PG8_BAR;
        PG8_WAIT_V(2); PG8_BAR;
        PG8_STAGE(PG8_SB(1, 0), cB + kstep, voffB); PG8_STAGE(PG8_SA(1, 0), cA + kstep, voffA); PG8_STAGE(PG8_SB(1, 1), cB + hstep + kstep, voffB);
        PG8_WAIT_V(6); PG8_BAR;
    } else {
        PG8_STAGE(PG8_SB(0, 0), cB, voffB); PG8_STAGE(PG8_SA(0, 0), cA, voffA); PG8_STAGE(PG8_SB(0, 1), cB + hstep, voffB); PG8_STAGE(PG8_SA(0, 1), cA + hstep, voffA);
        if (wr == 1) PG8_BAR;
        PG8_WAIT_V(4); PG8_BAR;
        PG8_STAGE(PG8_SB(1, 0), cB + kstep, voffB); PG8_STAGE(PG8_SA(1, 0), cA + kstep, voffA); PG8_STAGE(PG8_SB(1, 1), cB + hstep + kstep, voffB);
        PG8_WAIT_V(6); PG8_BAR;
    }
    for (;;) {
        const bool has_next = S.next(ui + 1, nxt);
        const bool nsw = has_next && E.normal(nxt); const char* nA = has_next ? (nsw ? (const char*)g.Bt + (size_t)nxt.pn * tstep : (const char*)g.A + (size_t)nxt.pm * tstep) : cA; const char* nB = has_next ? (nsw ? (const char*)g.A + (size_t)nxt.pm * tstep : (const char*)g.Bt + (size_t)nxt.pn * tstep) : cB;
        for (int t = 0; t < nt; t += 2) {
            const bool last = (t == nt - 2);
            const char* a1 = cA + (size_t)(t + 1) * kstep;
            const char* a2 = last ? nA : cA + (size_t)(t + 2) * kstep; const char* b2 = last ? nB : cB + (size_t)(t + 2) * kstep;
            const char* a3 = a2 + kstep; const char* b3 = b2 + kstep;
            if (last && has_next) S.a_ready(nxt);
            if constexpr (SP2) {
            PG8_LDB(B0, 0, 0); PG8_LDB(B1, 0, 1); PG8_SCHED; PG8_LDA(At, 0, 0); PG8_STAGE(PG8_SA(1, 1), a1 + hstep, voffA);
            PG8_WAIT_V(8); PG8_WAIT_L(0); PG8_BAR; PG8_MMA(0, 0, At, B0); PG8_MMA(0, 1, At, B1); PG8_BAR; PG8_SCHED;
            PG8_LDA(At, 0, 1); PG8_STAGE(PG8_SB(0, 0), b2, voffB); PG8_STAGE(PG8_SB(0, 1), b2 + hstep, voffB); PG8_STAGE(PG8_SA(0, 0), a2, voffA);
            PG8_WAIT_V(8); PG8_WAIT_L(0); PG8_BAR; PG8_MMA(1, 0, At, B0); PG8_MMA(1, 1, At, B1); PG8_BAR; PG8_SCHED;
            PG8_LDB(B0, 1, 0); PG8_LDB(B1, 1, 1); PG8_SCHED; PG8_LDA(At, 1, 0); PG8_STAGE(PG8_SA(0, 1), a2 + hstep, voffA);
            PG8_WAIT_V(8); PG8_WAIT_L(0); PG8_BAR; PG8_MMA(0, 0, At, B0); PG8_MMA(0, 1, At, B1); PG8_BAR; PG8_SCHED;
            PG8_LDA(At, 1, 1); PG8_STAGE(PG8_SB(1, 0), b3, voffB); PG8_STAGE(PG8_SB(1, 1), b3 + hstep, voffB); PG8_STAGE(PG8_SA(1, 0), a3, voffA);
            PG8_WAIT_V(8); PG8_WAIT_L(0); PG8_BAR; PG8_MMA(1, 0, At, B0); PG8_MMA(1, 1, At, B1); PG8_BAR; PG8_SCHED;
            } else {
            PG8_LDB(B0, 0, 0); PG8_SCHED; PG8_LDA(At, 0, 0); PG8_STAGE(PG8_SA(1, 1), a1 + hstep, voffA);
            PG8_WAIT_L(8); PG8_BAR; PG8_WAIT_L(0); PG8_MMA(0, 0, At, B0); PG8_BAR; PG8_SCHED;
            PG8_LDB(B1, 0, 1); PG8_STAGE(PG8_SB(0, 0), b2, voffB);
            PG8_BAR; PG8_WAIT_L(0); PG8_MMA(0, 1, At, B1); PG8_BAR;
            PG8_LDA(At, 0, 1); PG8_STAGE(PG8_SA(0, 0), a2, voffA);
            PG8_BAR; PG8_WAIT_L(0); PG8_MMA(1, 0, At, B0); PG8_BAR; PG8_SCHED;
            PG8_STAGE(PG8_SB(0, 1), b2 + hstep, voffB);
            PG8_WAIT_V(6); PG8_BAR; PG8_MMA(1, 1, At, B1); PG8_BAR;
            PG8_LDB(B0, 1, 0); PG8_SCHED; PG8_LDA(At, 1, 0); PG8_STAGE(PG8_SA(0, 1), a2 + hstep, voffA);
            PG8_WAIT_L(8); PG8_BAR; PG8_WAIT_L(0); PG8_MMA(0, 0, At, B0); PG8_BAR; PG8_SCHED;
            PG8_LDB(B1, 1, 1); PG8_STAGE(PG8_SB(1, 0), b3, voffB);
            PG8_BAR; PG8_WAIT_L(0); PG8_MMA(0, 1, At, B1); PG8_BAR;
            PG8_LDA(At, 1, 1); PG8_STAGE(PG8_SA(1, 0), a3, voffA);
            PG8_BAR; PG8_WAIT_L(0); PG8_MMA(1, 0, At, B0); PG8_BAR; PG8_SCHED;
            PG8_STAGE(PG8_SB(1, 1), b3 + hstep, voffB);
            PG8_WAIT_V(6); PG8_BAR; PG8_MMA(1, 1, At, B1); PG8_BAR;
            }
        }
        if constexpr (ALIGN_EPI) { if (wr == 0) PG8_BAR; }
        if constexpr (!Epi::AFTER_DRAIN) { E(acc, cur, wr, wc, fr, fq); S.done(cur); }
        if (!has_next) break;
#pragma unroll
        for (int a = 0; a < 2; ++a)
#pragma unroll
            for (int b = 0; b < 2; ++b)
#pragma unroll
                for (int m = 0; m < 4; ++m)
#pragma unroll
                    for (int n = 0; n < 2; ++n) acc[a][b][m][n] = (f32x4){0.f, 0.f, 0.f, 0.f};
        cur = nxt; cA = nA; cB = nB; ++ui;
        if constexpr (ALIGN_EPI) { if (wr == 1) PG8_BAR; }
    }
    PG8_WAIT_V(0);
    if constexpr (!ALIGN_EPI) { if (wr == 0) PG8_BAR; }
    PG8_BAR;
    if constexpr (Epi::AFTER_DRAIN) { E.fused(acc, cur, wr, wc, fr, fq, lds, wid, lane); S.done(cur); }
#undef PG8_SA
#undef PG8_SB
#undef PG8_STAGE
#undef PG8_LDA
#undef PG8_LDB
#undef PG8_MMA
#undef PG8_WAIT_V
#undef PG8_WAIT_L
#undef PG8_BAR
#undef PG8_SCHED
}
}

typedef const f32x4 (&AccRef)[2][2][4][2];
DI void epi2_qk(AccRef acc, bf16_t* dst, int pitch, const float* g, float scale, bool rope, int tq0, int fr, int fq) {
  f32x4 g0[2], g1[2];
  UNR for (int n = 0; n < 2; ++n) { g0[n] = *(const f32x4*)(g + 16 * n + 4 * fq); g1[n] = *(const f32x4*)(g + 32 + 16 * n + 4 * fq); }
  float inv[4];
  UNR for (int e = 0; e < 4; ++e) inv[e] = __builtin_amdgcn_exp2f(-(float)(4 * fq + e) * (13.287712379549449f / 16.f)) * 0.15915494309189535f;
  float ssq[2][4];
  UNR for (int ai = 0; ai < 2; ++ai) UNR for (int m = 0; m < 4; ++m) {
    float ss = 0.f;
    UNR for (int bj = 0; bj < 2; ++bj) UNR for (int n = 0; n < 2; ++n) UNR for (int e = 0; e < 4; ++e) ss += acc[ai][bj][m][n][e] * acc[ai][bj][m][n][e];
    ssq[ai][m] = ss;
  }
  UNR for (int ai = 0; ai < 2; ++ai) UNR for (int m = 0; m < 4; ++m) ssq[ai][m] += shx(ssq[ai][m], 16);
  UNR for (int ai = 0; ai < 2; ++ai) UNR for (int m = 0; m < 4; ++m) ssq[ai][m] += shx(ssq[ai][m], 32);
  UNR for (int ai = 0; ai < 2; ++ai) UNR for (int m = 0; m < 4; ++m) {
    const int t = tq0 + 128 * ai + 16 * m + fr;
    const float rstd = scale / sqrtf(ssq[ai][m] * (1.f / 64.f) + 1e-6f);
    const unsigned off = (unsigned)(t * pitch + 4 * fq);
    UNR for (int n = 0; n < 2; ++n) {
      f32x4 v0 = acc[ai][0][m][n] * rstd * g0[n];
      f32x4 v1 = acc[ai][1][m][n] * rstd * g1[n];
      if (rope) {
        const int pos = n == 0 ? (t >> 6) : (t & 63);
        UNR for (int e = 0; e < 4; ++e) {
          const float rev = (float)pos * inv[e];
          const float cs = __builtin_amdgcn_cosf(rev), sn = __builtin_amdgcn_sinf(rev);
          const float x1 = v0[e], x2 = v1[e];
          v0[e] = x1 * cs - x2 * sn; v1[e] = x1 * sn + x2 * cs;
        }
      }
      u32x2 w0 = {pk2(v0[0], v0[1]), pk2(v0[2], v0[3])}, w1 = {pk2(v1[0], v1[1]), pk2(v1[2], v1[3])};
      *(u32x2*)(dst + off + 16 * n) = w0;
      *(u32x2*)(dst + off + 32 + 16 * n) = w1;
    }
    asm volatile("" ::: "memory");
  }
}
DI void epi2_gate_tok(AccRef acc, bf16_t* dst, int pitch, int fr, int fq) {
  UNR for (int ai = 0; ai < 2; ++ai) UNR for (int m = 0; m < 4; ++m) {
    const unsigned off = (unsigned)((128 * ai + 16 * m + fr) * pitch + 4 * fq);
    UNR for (int bj = 0; bj < 2; ++bj) UNR for (int n = 0; n < 2; ++n) {
      const f32x4 a = acc[ai][bj][m][n];
      u32x2 w = {pk2(silu(a[0]), silu(a[1])), pk2(silu(a[2]), silu(a[3]))};
      *(u32x2*)(dst + off + (32 * bj + 16 * n)) = w;
    }
    asm volatile("" ::: "memory");
  }
}
DI void epi2_S(AccRef acc, bf16_t* dst, unsigned chmul, bool dosilu, bool qperm, int wr, int wc, int fr, int fq_) {
  const int fq = qperm ? (((fq_ & 1) << 1) | (fq_ >> 1)) : fq_;
  UNR for (int ai = 0; ai < 2; ++ai) UNR for (int m = 0; m < 4; ++m) {
    const int ch = 64 * (2 * wr + (m >> 1)) + 32 * ai + 16 * (m & 1) + fr;
    const unsigned off = (unsigned)ch * chmul + (unsigned)(32 * wc + 4 * fq);
    UNR for (int bj = 0; bj < 2; ++bj) UNR for (int n = 0; n < 2; ++n) {
      f32x4 a = acc[ai][bj][m][n];
      if (dosilu) { a[0] = silu(a[0]); a[1] = silu(a[1]); a[2] = silu(a[2]); a[3] = silu(a[3]); }
      u32x2 w = {pk2(a[0], a[1]), pk2(a[2], a[3])};
      *(u32x2*)(dst + off + (128 * bj + 16 * n)) = w;
    }
    asm volatile("" ::: "memory");
  }
}
struct EpiIn {
  static constexpr bool PERM = false, AFTER_DRAIN = false;
  bf16_t* PB; const float* gq; const float* gk; int odd;
  DI bool normal(const pg8::Unit& u) const { const int n0 = u.pn * 256; return odd ? (n0 >= 2048 && n0 < 3072) : ((n0 >= 1024 && n0 < 3072) || n0 >= 3584); }
  DI void operator()(AccRef acc, const pg8::Unit& u, int wr, int wc, int fr_, int fq_) const {
    int fr = fr_, fq = fq_; asm volatile("" : "+v"(fr), "+v"(fq));
    const int n0 = u.pn * 256, cb = n0 + 64 * wc, b = u.pm / 17, tmi = u.pm % 17; const bool isctx = tmi == 16;
    const int tq0 = tmi * 256 + 64 * wr; const size_t row0 = (size_t)u.pm * 256 + 64 * wr;
    if (normal(u)) {
      const int t0 = tmi * 256; bf16_t* dst; unsigned chmul = (unsigned)(8 * TB); bool sl = false, qp = odd != 0;
      if (!odd) {
        if (n0 < 1536) { dst = PB + 2 * SEG + ((size_t)b * 512 + (n0 - 1024)) * TB + t0; chmul = (unsigned)TB; qp = true; }
        else if (n0 < 3072) dst = PB + 3 * SEG + ((size_t)(n0 - 1536) * 8 + b) * TB + t0;
        else { dst = PB + 7 * SEG + ((size_t)(n0 - 3584) * 8 + b) * TB + t0; sl = true; }
      } else { dst = PB + 4 * SEG + ((size_t)b * 1024 + (n0 - 2048)) * TB + t0; chmul = (unsigned)TB; }
      epi2_S(acc, dst, chmul, sl, qp, wr, wc, fr, fq);
      return;
    }
    if (n0 >= 3072) {
      const int pitch = odd ? 1024 : 512;
      epi2_gate_tok(acc, PB + 6 * SEG + row0 * pitch + (cb - 3072), pitch, fr, fq);
      return;
    }
    {
      bf16_t* dst; int pitch; const float* g; float scale; bool rope = false;
      if (!odd) {
        pitch = 64;
        if (cb < 512) { dst = PB + ((size_t)(b * 8 + (cb >> 6)) * TB) * 64; g = gq; scale = LOG2E * 0.125f; }
        else { dst = PB + SEG + ((size_t)(b * 8 + ((cb - 512) >> 6)) * TB) * 64; g = gk; scale = 1.f; }
      } else {
        pitch = 128; rope = !isctx;
        if (cb < 1024) { dst = PB + ((size_t)(b * 8 + (cb >> 7)) * TB) * 128 + ((cb >> 6) & 1) * 64; g = gq; scale = LOG2E * 0.125f; }
        else { const int c2 = cb - 1024; dst = PB + 2 * SEG + ((size_t)(b * 8 + (c2 >> 7)) * TB) * 128 + ((c2 >> 6) & 1) * 64; g = gk; scale = 1.f; }
      }
      epi2_qk(acc, dst, pitch, g, scale, rope, tq0, fr, fq);
    }
  }
};
struct EpiOut {
  static constexpr bool PERM = false, AFTER_DRAIN = false;
  const float* x_in; const float* xc_in; float* out; float* xc; const float* mod; int l;
  DI bool normal(const pg8::Unit&) const { return false; }
  DI void operator()(AccRef acc, const pg8::Unit& u, int wr, int wc, int fr, int fq) const {
    const int cb = u.pn * 256 + 64 * wc, b = u.pm / 17, tmi = u.pm % 17; const bool isctx = tmi == 16;
    if (isctx && l == 3) return;
    const float* gate = mod + (size_t)(l * 9 + (isctx ? 8 : b)) * 3072 + 2048;
    const float* src; float* dst;
    if (isctx) { src = xc_in + ((size_t)b * NCTX + 64 * wr) * 1024; dst = xc + ((size_t)b * NCTX + 64 * wr) * 1024; }
    else { const size_t o = ((size_t)b * SEQ + tmi * 256 + 64 * wr) * 1024; src = x_in + o; dst = out + o; }
    UNR for (int bj = 0; bj < 2; ++bj) {
      f32x4 xo[2][2][4], gg[2];
      UNR for (int n = 0; n < 2; ++n) {
        const int c = cb + 32 * bj + 16 * n + 4 * fq; gg[n] = *(const f32x4*)(gate + c);
        UNR for (int ai = 0; ai < 2; ++ai) UNR for (int m = 0; m < 4; ++m) xo[n][ai][m] = *(const f32x4*)(src + (size_t)(128 * ai + 16 * m + fr) * 1024 + c);
      }
      UNR for (int n = 0; n < 2; ++n) {
        const int c = cb + 32 * bj + 16 * n + 4 * fq;
        UNR for (int ai = 0; ai < 2; ++ai) UNR for (int m = 0; m < 4; ++m) *(f32x4*)(dst + (size_t)(128 * ai + 16 * m + fr) * 1024 + c) = xo[n][ai][m] + gg[n] * acc[ai][bj][m][n];
      }
      asm volatile("" ::: "memory");
    }
  }
};
struct LatentOrder : pg8::StaticOrder {
  __device__ bool next(int i, pg8::Unit& u) const { if (!pg8::StaticOrder::next(i, u)) return false; u.pm += u.pm >> 4; return true; }
};
template <int MODE>
DI void gemm_phase(const PW& p, int l, unsigned char* smem) {
  pg8::Gemm g; g.M = R; g.K = 1024;
  pg8::StaticOrder S;
  PG8_LAS unsigned char* lds = (PG8_LAS unsigned char*)smem;
  if (MODE == 2) {
    g.A = (const bf16_t*)(p.ws + OFF_Y); g.Bt = (const bf16_t*)(p.ws + OFF_WOUT) + (size_t)l * 1024 * 1024; g.N = 1024;
    S.init(R, 1024, gridDim.x, lbid());
    EpiOut E; E.x_in = l == 0 ? p.x : p.out; E.xc_in = l == 0 ? p.ctx : (const float*)(p.ws + OFF_XC); E.out = p.out; E.xc = (float*)(p.ws + OFF_XC); E.mod = (const float*)(p.ws + OFF_MOD); E.l = l;
    if (l == 3) { LatentOrder S3; S3.init(128 * 256, 1024, gridDim.x, lbid()); pg8::gemm_phase<EpiOut, LatentOrder, true, true>(lds, g, S3, E, LTID(p)); }
    else pg8::gemm_phase<EpiOut, pg8::StaticOrder, true, true>(lds, g, S, E, LTID(p));
  } else {
    g.A = (const bf16_t*)(p.ws + OFF_HN); g.Bt = (const bf16_t*)(p.ws + OFF_WIN) + (size_t)l * 4096 * 1024; g.N = 4096;
    S.init(R, 4096, gridDim.x, lbid());
    EpiIn E; E.PB = (bf16_t*)(p.ws + OFF_PB); E.gq = p.q_norm_g + l * 64; E.gk = p.k_norm_g + l * 64; E.odd = MODE;
    pg8::gemm_phase<EpiIn, pg8::StaticOrder, true, true>(lds, g, S, E, LTID(p));
  }
  __syncthreads();
}

DI void na_unit(const PW& p, int e, int b, int hd, int tq0, bool ctxq, float negM, int r, int h) {
  const bf16_t* PB = (const bf16_t*)(p.ws + OFF_PB);
  const bf16_t* Q = PB + ((size_t)(b * 8 + hd) * TB) * 64;
  const bf16_t* K = PB + SEG + ((size_t)(b * 8 + hd) * TB) * 64;
  const bf16_t* VT = PB + 2 * SEG + ((size_t)(b * 8 + hd) * 64) * TB;
  const int tq = tq0 + r;
  f32x16 O[2]; O[0] = splat16(0.f); O[1] = splat16(0.f);
  float lsum = 0.f;
  const int qrow = tq0 >> 6, qcol = tq & 63;
  const int rs = min(max(qrow - 4, 0), 56), cs = min(max(qcol - 8, 0), 48);
  const float* rpb = p.na_rpb + (size_t)(e * 8 + hd) * 15 * 31;
  constexpr int NB = 2; const int ngrp = ctxq ? 8 / NB : 24 / NB;
  _Pragma("unroll 1") for (int g = 0; g < ngrp; ++g) {
    const bool local = !ctxq && g < 16 / NB;
    bf16x8 kf[NB][4], vf[NB][4], qf[4];
    UNR for (int ks = 0; ks < 4; ++ks) qf[ks] = *(const bf16x8*)(Q + (size_t)tq * 64 + ks * 16 + h * 8);
    UNR for (int u = 0; u < NB; ++u) {
      const int it = g * NB + u;
      const int kb = local ? (rs + (it >> 1)) * 64 + (it & 1) * 32 : SEQ + (ctxq ? it : it - 16) * 32;
      UNR for (int ks = 0; ks < 4; ++ks) kf[u][ks] = *(const bf16x8*)(K + (size_t)(kb + r) * 64 + ks * 16 + h * 8);
      UNR for (int dvt = 0; dvt < 2; ++dvt) UNR for (int s2 = 0; s2 < 2; ++s2) vf[u][dvt * 2 + s2] = *(const bf16x8*)(VT + (size_t)(dvt * 32 + r) * TB + kb + s2 * 16 + 8 * h);
    }
    asm volatile("" ::: "memory");
    UNR for (int u = 0; u < NB; ++u) {
      const int it = g * NB + u;
      const int krow = rs + (it >> 1), ct = it & 1;
      f32x16 s = splat16(negM);
      UNR for (int ks = 0; ks < 4; ++ks) s = MFMA32(kf[u][ks], qf[ks], s);
      if (local) {
        const float* rp = rpb + (krow - qrow + 7) * 31;
        UNR for (int i = 0; i < 16; ++i) {
          const int kcol = ct * 32 + crow(i, h); const bool valid = kcol >= cs && kcol < cs + 16;
          const int dc = min(max(kcol - qcol + 15, 0), 30);
          const float pv = __builtin_amdgcn_exp2f(s[i] + rp[dc] * LOG2E);
          s[i] = valid ? pv : 0.f;
        }
      } else {
        UNR for (int i = 0; i < 16; ++i) s[i] = __builtin_amdgcn_exp2f(s[i]);
      }
      UNR for (int i = 0; i < 16; ++i) lsum += s[i];
      bf16x8 pf[2]; pf[0] = pack8(s, 0); pf[1] = pack8(s, 8);
      UNR for (int dvt = 0; dvt < 2; ++dvt) UNR for (int s2 = 0; s2 < 2; ++s2) O[dvt] = MFMA32(vf[u][dvt * 2 + s2], pf[s2], O[dvt]);
      asm volatile("" ::: "memory");
    }
  }
  lsum += shx(lsum, 32);
  const float inv = 1.f / lsum;
  const size_t row = (size_t)b * TB + tq;
  const bf16_t* G = PB + 6 * SEG + row * 512 + hd * 64;
  bf16_t* Y = (bf16_t*)(p.ws + OFF_Y) + row * 1024 + hd * 64;
  UNR for (int dvt = 0; dvt < 2; ++dvt) UNR for (int gq = 0; gq < 4; ++gq) {
    const int dv = dvt * 32 + 8 * gq + 4 * h;
    const u32x2 gg = *(const u32x2*)(G + dv);
    u32x2 w = {pk2(O[dvt][4 * gq] * inv * bflo(gg[0]), O[dvt][4 * gq + 1] * inv * bfhi(gg[0])), pk2(O[dvt][4 * gq + 2] * inv * bflo(gg[1]), O[dvt][4 * gq + 3] * inv * bfhi(gg[1]))};
    *(u32x2*)(Y + dv) = w;
  }
}

DI void na_block(const PW& p, int e, int b, int hd, int r0, bool ctxq, float negM, unsigned char* smem) {
  const int tid = LTID(p), wid = __builtin_amdgcn_readfirstlane(tid >> 6), lane = tid & 63, r = lane & 31, h = lane >> 5;
  const bf16_t* PB = (const bf16_t*)(p.ws + OFF_PB);
  const bf16_t* Q = PB + ((size_t)(b * 8 + hd) * TB) * 64;
  const bf16_t* K = PB + SEG + ((size_t)(b * 8 + hd) * TB) * 64;
  const bf16_t* VT = PB + 2 * SEG + ((size_t)(b * 8 + hd) * 64) * TB;
  PG8_LAS unsigned char* lds = (PG8_LAS unsigned char*)smem;
  const int qrow = ctxq ? 0 : r0 + (wid >> 1);
  const int tq0 = ctxq ? SEQ + wid * 32 : qrow * 64 + (wid & 1) * 32;
  const int tq = tq0 + r, qcol = tq & 63;
  const int rsw = min(max(qrow - 4, 0), 56), cs = min(max(qcol - 8, 0), 48);
  const int kr_lo = min(max(r0 - 4, 0), 56), kr_hi = min(max(r0 - 1, 0), 56) + 7;
  const int nloc = ctxq ? 0 : (kr_hi - kr_lo + 2) >> 1, nch = nloc + 2;
  bf16x8 qf[4];
  UNR for (int ks = 0; ks < 4; ++ks) qf[ks] = *(const bf16x8*)(Q + (size_t)tq * 64 + ks * 16 + h * 8);
  f32x16 O[2]; O[0] = splat16(0.f); O[1] = splat16(0.f);
  float lsum = 0.f;
  const float* rpb = p.na_rpb + (size_t)(e * 8 + hd) * 15 * 31;
  unsigned offK[2], offV[2];
  UNR for (int j = 0; j < 2; ++j) {
    const int s = (wid * 2 + j) * 64 + lane;
    { const int row = s >> 3, c = (s & 7) ^ ((row >> 1) & 7); offK[j] = (unsigned)(row * 64 + c * 8) * 2u; }
    { const int row = s >> 4, c = (s & 15) ^ (row & 15); offV[j] = (unsigned)(row * TB + c * 8) * 2u; }
  }
#define NA_KB(ci) ((ci) < nloc ? (kr_lo + 2 * (ci)) * 64 : SEQ + ((ci) - nloc) * 128)
#define NA_STAGE(st, ci) do { const int kb_ = NA_KB(ci); const char* kp_ = (const char*)(K + (size_t)kb_ * 64); const char* vp_ = (const char*)(VT + kb_); \
    UNR for (int j = 0; j < 2; ++j) { __builtin_amdgcn_global_load_lds((const unsigned*)(kp_ + offK[j]), (PG8_LAS unsigned*)(lds + (st) * 32768 + (wid * 2 + j) * 1024), 16, 0, 0); \
                                      __builtin_amdgcn_global_load_lds((const unsigned*)(vp_ + offV[j]), (PG8_LAS unsigned*)(lds + (st) * 32768 + 16384 + (wid * 2 + j) * 1024), 16, 0, 0); } } while (0)
  float* btab = (float*)(smem + 65536);
  __syncthreads();
  if (!ctxq && tid < 465) btab[tid] = rpb[tid] * LOG2E;
  NA_STAGE(0, 0);
  asm volatile("s_waitcnt vmcnt(0)" ::: "memory");
  __syncthreads();
  for (int ci = 0; ci < nch; ++ci) {
    if (ci + 1 < nch) NA_STAGE((ci + 1) & 1, ci + 1);
    const unsigned char* Kl = smem + (ci & 1) * 32768; const unsigned char* Vl = Kl + 16384;
    const bool local = ci < nloc;
    _Pragma("unroll 2") for (int sub = 0; sub < 4; ++sub) {
      const int krow = kr_lo + 2 * ci + (sub >> 1), ct = sub & 1;
      if (local && (krow < rsw || krow >= rsw + 8)) continue;
      f32x16 s = splat16(negM);
      const int kr_ = sub * 32 + r;
      UNR for (int ks = 0; ks < 4; ++ks) { const bf16x8 kf = *(const bf16x8*)(Kl + kr_ * 128 + (((ks * 2 + h) ^ ((kr_ >> 1) & 7)) << 4)); s = MFMA32(kf, qf[ks], s); }
      if (local) {
        const float* rp = btab + (krow - qrow + 7) * 31;
        UNR for (int i = 0; i < 16; ++i) {
          const int kcol = ct * 32 + crow(i, h); const bool valid = kcol >= cs && kcol < cs + 16;
          const int dc = min(max(kcol - qcol + 15, 0), 30);
          const float pv = __builtin_amdgcn_exp2f(s[i] + rp[dc]);
          s[i] = valid ? pv : 0.f;
        }
      } else {
        UNR for (int i = 0; i < 16; ++i) s[i] = __builtin_amdgcn_exp2f(s[i]);
      }
      UNR for (int i = 0; i < 16; ++i) lsum += s[i];
      bf16x8 pf[2]; pf[0] = pack8(s, 0); pf[1] = pack8(s, 8);
      UNR for (int dvt = 0; dvt < 2; ++dvt) UNR for (int s2 = 0; s2 < 2; ++s2) {
        const int vrow = dvt * 32 + r;
        const bf16x8 vf = *(const bf16x8*)(Vl + vrow * 256 + (((sub * 4 + s2 * 2 + h) ^ (vrow & 15)) << 4));
        O[dvt] = MFMA32(vf, pf[s2], O[dvt]);
      }
    }
    asm volatile("s_waitcnt vmcnt(0)" ::: "memory");
    __syncthreads();
  }
#undef NA_STAGE
#undef NA_KB
  lsum += shx(lsum, 32);
  const float inv = 1.f / lsum;
  const size_t row = (size_t)b * TB + tq;
  const bf16_t* G = PB + 6 * SEG + row * 512 + hd * 64;
  bf16_t* Y = (bf16_t*)(p.ws + OFF_Y) + row * 1024 + hd * 64;
  UNR for (int dvt = 0; dvt < 2; ++dvt) UNR for (int gq = 0; gq < 4; ++gq) {
    const int dv = dvt * 32 + 8 * gq + 4 * h;
    const u32x2 gg = *(const u32x2*)(G + dv);
    u32x2 w = {pk2(O[dvt][4 * gq] * inv * bflo(gg[0]), O[dvt][4 * gq + 1] * inv * bfhi(gg[0])), pk2(O[dvt][4 * gq + 2] * inv * bflo(gg[1]), O[dvt][4 * gq + 3] * inv * bfhi(gg[1]))};
    *(u32x2*)(Y + dv) = w;
  }
}

#ifndef HY_FENCE
#define HY_FENCE do { } while (0)
#endif
DI float sconv3(float um, float u0, float up, float w0, float w1, float w2, float cb) { return cb + w0 * um + w1 * u0 + w2 * up; }

DI void conv4(const bf16_t* rowp, int seq0, int len, int t0, float w0, float w1, float w2, float cb, float (&o)[4]) {
  const u32x2 m = *(const u32x2*)(rowp + seq0 + t0);
  const float um = t0 > 0 ? bf1(rowp[seq0 + t0 - 1]) : 0.f, up = t0 + 4 < len ? bf1(rowp[seq0 + t0 + 4]) : 0.f;
  const float u0 = bflo(m[0]), u1 = bfhi(m[0]), u2 = bflo(m[1]), u3 = bfhi(m[1]);
  o[0] = sconv3(um, u0, u1, w0, w1, w2, cb); o[1] = sconv3(u0, u1, u2, w0, w1, w2, cb); o[2] = sconv3(u1, u2, u3, w0, w1, w2, cb); o[3] = sconv3(u2, u3, up, w0, w1, w2, cb);
}

DI void hy_load_filter(const PW& p, int e, int o, int c, unsigned char* C0, unsigned char* C1) {
  const int tid = LTID(p);
  const bf16_t* grev = (const bf16_t*)(p.ws + OFF_GREV) + ((size_t)(e * 2 + o) * 512 + c) * 8192;
  UNR for (int i = 0; i < 2; ++i) { const int q = tid + i * 512; *(u32x4*)(C0 + q * 16) = *(const u32x4*)(grev + q * 8); }
  __syncthreads();
  const unsigned* c0d = (const unsigned*)C0; unsigned* c1d = (unsigned*)C1;
  UNR for (int i = 0; i < 8; ++i) { const int w = tid + i * 512; const unsigned a = c0d[w], bnx = w + 1 < 4096 ? c0d[w + 1] : 0u; c1d[w] = (a >> 16) | (bnx << 16); }
  __syncthreads();
}

DI u32x4 hy_loadA(const unsigned char* C0, const unsigned char* C1, int d, int off, int r, int h) {
  const int P0 = 4095 - 64 * d - off - r + 8 * h;
  const int odd = P0 & 1;
  const unsigned* ap = (const unsigned*)((odd ? C1 : C0) + (P0 - odd) * 2);
  u32x4 w = {ap[0], ap[1], ap[2], ap[3]};
  return w;
}
DI void hy_conv(f32x16 (&acc)[2][2], const unsigned char* Z, const unsigned char* ZR, const unsigned char* C0, const unsigned char* C1, int wid, int r, int h) {
  UNR for (int i = 0; i < 2; ++i) UNR for (int j = 0; j < 2; ++j) acc[i][j] = splat16(0.f);
  const int abase = wid * 8;
  const int bb = r & 7, ar = r >> 3;
  u32x4 F[6];
  int d = abase - 63;
  UNR for (int k = 0; k < 6; ++k) F[k] = hy_loadA(C0, C1, d, 32 - 16 * k, r, h);
  for (;;) {
    UNR for (int nt = 0; nt < 2; ++nt) {
      const int ap_ = abase + 4 * nt - d + ar; const bool valid = (unsigned)ap_ < 64u;
      const unsigned char* zp = valid ? Z + (ap_ * 8 + bb) * 144 + h * 16 : ZR + h * 16;
      UNR for (int ks = 0; ks < 4; ++ks) {
        const bf16x8 zf = *(const bf16x8*)(zp + ks * 32);
        acc[0][nt] = MFMA32(__builtin_bit_cast(bf16x8, F[2 + ks]), zf, acc[0][nt]);
        acc[1][nt] = MFMA32(__builtin_bit_cast(bf16x8, F[ks]), zf, acc[1][nt]);
      }
    }
    if (d == abase + 7) break;
    ++d;
    F[4] = F[0]; F[5] = F[1];
    UNR for (int k = 0; k < 4; ++k) F[k] = hy_loadA(C0, C1, d, 32 - 16 * k, r, h);
  }
}

DI void hyena_unit(const PW& p, int e, int c, unsigned char* smem) {
  const int tid = LTID(p), wid = __builtin_amdgcn_readfirstlane(tid >> 6), lane = tid & 63, r = lane & 31, h = lane >> 5;
  unsigned char* Z = smem; unsigned char* C0 = smem + 73728; unsigned char* C1 = C0 + 16384 + 64; unsigned char* ZR = smem + 106624;
  if (tid < 32) ((unsigned*)ZR)[tid] = 0u;
  const bf16_t* PB = (const bf16_t*)(p.ws + OFF_PB);
  const bf16_t* UT = PB + 3 * SEG;
  const bf16_t* GHT = PB + 7 * SEG;
  bf16_t* Y = (bf16_t*)(p.ws + OFF_Y);
  float cw[3][3], cbias[3];
  UNR for (int s = 0; s < 3; ++s) { UNR for (int j = 0; j < 3; ++j) cw[s][j] = p.hy_conv_w[(e * 3 + j) * 1536 + s * 512 + c]; cbias[s] = p.hy_conv_b[e * 1536 + s * 512 + c]; }
  __syncthreads();
  hy_load_filter(p, e, 0, c, C0, C1);
  _Pragma("unroll 4") for (int i = 0; i < 8; ++i) {
    const int cid = tid + i * 512, b = cid >> 9, t0 = (cid & 511) * 8;
    const bf16_t* rowp = UT + ((size_t)c * 8 + b) * TB;
    float o0[4], o1[4];
    conv4(rowp, 0, SEQ, t0, cw[0][0], cw[0][1], cw[0][2], cbias[0], o0);
    conv4(rowp, 0, SEQ, t0 + 4, cw[0][0], cw[0][1], cw[0][2], cbias[0], o1);
    u32x4 w = {pk2(o0[0], o0[1]), pk2(o0[2], o0[3]), pk2(o1[0], o1[1]), pk2(o1[2], o1[3])};
    *(u32x4*)(Z + ((t0 >> 6) * 8 + b) * 144 + (t0 & 63) * 2) = w;
  }
  __syncthreads();
  f32x16 acc[2][2];
#if DUP & 512
  hy_conv(acc, Z, ZR, C0, C1, wid, r, h);
  UNR for (int i_ = 0; i_ < 2; ++i_) UNR for (int j_ = 0; j_ < 2; ++j_) asm volatile("" :: "v"(acc[i_][j_]));
#endif
  hy_conv(acc, Z, ZR, C0, C1, wid, r, h);
  __syncthreads();
  {
    const int bb = r & 7;
    UNR for (int nt = 0; nt < 2; ++nt) {
      const int a = wid * 8 + 4 * nt + (r >> 3);
      const bf16_t* rowp = UT + ((size_t)(512 + c) * 8 + bb) * TB;
      UNR for (int mt = 0; mt < 2; ++mt) UNR for (int gq = 0; gq < 4; ++gq) {
        const int i0 = 32 * mt + 8 * gq + 4 * h; float x1[4];
        conv4(rowp, 0, SEQ, 64 * a + i0, cw[1][0], cw[1][1], cw[1][2], cbias[1], x1);
        u32x2 w = {pk2(x1[0] * acc[mt][nt][4 * gq], x1[1] * acc[mt][nt][4 * gq + 1]), pk2(x1[2] * acc[mt][nt][4 * gq + 2], x1[3] * acc[mt][nt][4 * gq + 3])};
        *(u32x2*)(Z + (a * 8 + bb) * 144 + i0 * 2) = w;
        HY_FENCE;
      }
    }
  }
  hy_load_filter(p, e, 1, c, C0, C1);
#if DUP & 512
  hy_conv(acc, Z, ZR, C0, C1, wid, r, h);
  UNR for (int i_ = 0; i_ < 2; ++i_) UNR for (int j_ = 0; j_ < 2; ++j_) asm volatile("" :: "v"(acc[i_][j_]));
#endif
  hy_conv(acc, Z, ZR, C0, C1, wid, r, h);
  __syncthreads();
  {
    const int bb = r & 7;
    UNR for (int nt = 0; nt < 2; ++nt) {
      const int a = wid * 8 + 4 * nt + (r >> 3);
      const bf16_t* rowp = UT + ((size_t)(1024 + c) * 8 + bb) * TB;
      const bf16_t* gp = GHT + ((size_t)c * 8 + bb) * TB;
      UNR for (int mt = 0; mt < 2; ++mt) UNR for (int gq = 0; gq < 4; ++gq) {
        const int i0 = 32 * mt + 8 * gq + 4 * h; float x2[4];
        conv4(rowp, 0, SEQ, 64 * a + i0, cw[2][0], cw[2][1], cw[2][2], cbias[2], x2);
        const u32x2 gg = *(const u32x2*)(gp + 64 * a + i0);
        u32x2 w = {pk2(x2[0] * acc[mt][nt][4 * gq] * bflo(gg[0]), x2[1] * acc[mt][nt][4 * gq + 1] * bfhi(gg[0])),
                   pk2(x2[2] * acc[mt][nt][4 * gq + 2] * bflo(gg[1]), x2[3] * acc[mt][nt][4 * gq + 3] * bfhi(gg[1]))};
        *(u32x2*)(Z + (a * 8 + bb) * 144 + i0 * 2) = w;
        HY_FENCE;
      }
    }
  }
  __syncthreads();
  {
    bf16_t* OT = (bf16_t*)(p.ws + OFF_HN);
    _Pragma("unroll 2") for (int i = 0; i < 8; ++i) {
      const int cid = tid + i * 512, b = cid >> 9, t0 = (cid & 511) * 8;
      *(u32x4*)(OT + ((size_t)c * 8 + b) * TB + t0) = *(const u32x4*)(Z + ((t0 >> 6) * 8 + b) * 144 + (t0 & 63) * 2);
    }
  }
  __syncthreads();
  {
    float* zc = (float*)smem;
    float* gl = zc + 2048;
    const int bb = tid >> 6, tq = tid & 63, t0 = 4 * tq;
    const bf16_t* r0 = UT + ((size_t)c * 8 + bb) * TB;
    const bf16_t* r1 = UT + ((size_t)(512 + c) * 8 + bb) * TB;
    const bf16_t* r2 = UT + ((size_t)(1024 + c) * 8 + bb) * TB;
    const bf16_t* gp = GHT + ((size_t)c * 8 + bb) * TB + SEQ;
    bf16_t* OTc = (bf16_t*)(p.ws + OFF_HN) + ((size_t)c * 8 + bb) * TB + SEQ;
    { float v4[4]; conv4(r0, SEQ, NCTX, t0, cw[0][0], cw[0][1], cw[0][2], cbias[0], v4);
      f32x4 vv = {v4[0], v4[1], v4[2], v4[3]}; *(f32x4*)(zc + bb * 256 + t0) = vv; }
    for (int o = 0; o < 2; ++o) {
      const float* gc = (const float*)(p.ws + OFF_GC) + ((size_t)(e * 2 + o) * 512 + c) * 512;
      gl[tid] = gc[tid];
      __syncthreads();
      f32x4 a4 = {0.f, 0.f, 0.f, 0.f};
      for (int s0 = 0; s0 < 256; s0 += 4) {
        const f32x4 zv = *(const f32x4*)(zc + bb * 256 + s0);
        const int base4 = 256 + t0 - s0;
        const f32x4 glo = *(const f32x4*)(gl + base4 - 4), ghi = *(const f32x4*)(gl + base4);
        const float G[8] = {glo[0], glo[1], glo[2], glo[3], ghi[0], ghi[1], ghi[2], ghi[3]};
        UNR for (int j = 0; j < 4; ++j) UNR for (int k = 0; k < 4; ++k) a4[j] += G[4 + j - k] * zv[k];
      }
      __syncthreads();
      float xv[4];
      conv4(o == 0 ? r1 : r2, SEQ, NCTX, t0, cw[1 + o][0], cw[1 + o][1], cw[1 + o][2], cbias[1 + o], xv);
      if (o == 0) { f32x4 zn = {xv[0] * a4[0], xv[1] * a4[1], xv[2] * a4[2], xv[3] * a4[3]}; *(f32x4*)(zc + bb * 256 + t0) = zn; }
      else {
        const u32x2 gg = *(const u32x2*)(gp + t0);
        u32x2 w = {pk2(xv[0] * a4[0] * bflo(gg[0]), xv[1] * a4[1] * bfhi(gg[0])), pk2(xv[2] * a4[2] * bflo(gg[1]), xv[3] * a4[3] * bfhi(gg[1]))};
        *(u32x2*)(OTc + t0) = w;
      }
      __syncthreads();
    }
  }
}

DI void hy_transpose_phase(const PW& p, int l, unsigned char* smem) {
  const int tid = LTID(p);
  const bf16_t* OT = (const bf16_t*)(p.ws + OFF_HN);
  bf16_t* Y = (bf16_t*)(p.ws + OFF_Y);
  unsigned* T = (unsigned*)smem;
  const int tb_per_b = l == 3 ? 64 : 68;
  const int ntile = 8 * tb_per_b * 8;
  const int cl = tid >> 3, part = tid & 7;
#define HT_SRC(tile) (OT + ((size_t)(((tile) & 7) * 64 + cl) * 8 + ((tile) >> 3) / tb_per_b) * TB + (((tile) >> 3) % tb_per_b) * 64 + part * 8)
  int tile = lbid();
  u32x4 v = {0u, 0u, 0u, 0u};
  if (tile < ntile) v = *(const u32x4*)HT_SRC(tile);
  for (; tile < ntile; tile += gridDim.x) {
    const int cbk = tile & 7, tb = tile >> 3, b = tb / tb_per_b, t0 = (tb % tb_per_b) * 64;
    UNR for (int j = 0; j < 4; ++j) T[cl * 33 + part * 4 + j] = v[j];
    const int nxt = tile + gridDim.x;
    if (nxt < ntile) v = *(const u32x4*)HT_SRC(nxt);
    __syncthreads();
    { const int tl = tid >> 3;
      const bf16_t* Tb = (const bf16_t*)T;
      unsigned short e[8];
      UNR for (int j = 0; j < 8; ++j) e[j] = Tb[(part * 8 + j) * 66 + tl];
      u32x4 w = {(unsigned)e[0] | ((unsigned)e[1] << 16), (unsigned)e[2] | ((unsigned)e[3] << 16), (unsigned)e[4] | ((unsigned)e[5] << 16), (unsigned)e[6] | ((unsigned)e[7] << 16)};
      *(u32x4*)(Y + ((size_t)b * TB + t0 + tl) * 1024 + 512 + cbk * 64 + part * 8) = w; }
    __syncthreads();
  }
#undef HT_SRC
}

DI void mixer_even(const PW& p, int l, unsigned char* smem, int what = 3) {
  const int e = l >> 1;
  if (what & 1) for (int c = lbid(); c < 512; c += gridDim.x) hyena_unit(p, e, c, smem);
  if (!(what & 2)) return;
  const float negM = ((const float*)(p.ws + OFF_MISC))[l];
  const int G = gridDim.x, bid = lbid();
  if ((G & 7) == 0) {
    const int hd = bid & 7, slot = bid >> 3, S = G >> 3;
    for (int i = slot; i < 128; i += S) na_block(p, e, i >> 4, hd, (i & 15) * 4, false, negM, smem);
    for (int i = slot; i < 8; i += S) na_block(p, e, i, hd, 0, true, negM, smem);
  } else {
    for (int u = bid; u < 1024 + 64; u += G) {
      if (u < 1024) { const int rg = u & 15, hd = (u >> 4) & 7, b = u >> 7; na_block(p, e, b, hd, rg * 4, false, negM, smem); }
      else { const int v = u - 1024, hd = v & 7, b = v >> 3; na_block(p, e, b, hd, 0, true, negM, smem); }
    }
  }
}

DI void diff_unit(const PW& p, int l, int b, int hd, int q0, int kbeg, int kend, float negM, float lam, float lam_init, unsigned char* smem) {
  const int tid = LTID(p), wid = __builtin_amdgcn_readfirstlane(tid >> 6), lane = tid & 63, r = lane & 31, h = lane >> 5, m = wid & 1, qg = wid >> 1;
  const bf16_t* PB = (const bf16_t*)(p.ws + OFF_PB);
  const bf16_t* Q = PB + ((size_t)(b * 8 + hd) * TB) * 128;
  const bf16_t* K = PB + 2 * SEG + ((size_t)(b * 8 + hd) * TB) * 128;
  const bf16_t* VT = PB + 4 * SEG + ((size_t)(b * 8 + hd) * 128) * TB;
  const int tq = q0 + qg * 32 + r;
  bf16x8 qf[4];
  UNR for (int ks = 0; ks < 4; ++ks) qf[ks] = *(const bf16x8*)(Q + (size_t)tq * 128 + m * 64 + ks * 16 + h * 8);
  f32x16 O[4];
  UNR for (int d = 0; d < 4; ++d) O[d] = splat16(0.f);
  float lsum = 0.f;
  const int kkey0 = tid >> 4, kpart = tid & 15;
  const int vdv0 = tid >> 3, vpart = tid & 7;
  u32x4 rk[2], rv[2];
  const int nt = (kend - kbeg) >> 6;
  UNR for (int i = 0; i < 2; ++i) { rk[i] = *(const u32x4*)(K + (size_t)(kbeg + kkey0 + 32 * i) * 128 + kpart * 8); rv[i] = *(const u32x4*)(VT + (size_t)(vdv0 + 64 * i) * TB + kbeg + vpart * 8); }
  UNR for (int i = 0; i < 2; ++i) { *(u32x4*)(smem + (kkey0 + 32 * i) * 272 + kpart * 16) = rk[i]; *(u32x4*)(smem + 17408 + (vdv0 + 64 * i) * 144 + vpart * 16) = rv[i]; }
  __syncthreads();
  for (int it = 0; it < nt; ++it) {
    const unsigned char* Kl = smem + (it & 1) * 35840; const unsigned char* Vl = Kl + 17408;
    if (it + 1 < nt) {
      const int k0 = kbeg + (it + 1) * 64;
      UNR for (int i = 0; i < 2; ++i) { rk[i] = *(const u32x4*)(K + (size_t)(k0 + kkey0 + 32 * i) * 128 + kpart * 8); rv[i] = *(const u32x4*)(VT + (size_t)(vdv0 + 64 * i) * TB + k0 + vpart * 8); }
    }
    {
      f32x16 s0 = splat16(negM), s1 = splat16(negM);
      __builtin_amdgcn_s_setprio(1);
      UNR for (int ks = 0; ks < 4; ++ks) { const bf16x8 kf = *(const bf16x8*)(Kl + r * 272 + m * 128 + ks * 32 + h * 16); s0 = MFMA32(kf, qf[ks], s0); }
      UNR for (int ks = 0; ks < 4; ++ks) { const bf16x8 kf = *(const bf16x8*)(Kl + (32 + r) * 272 + m * 128 + ks * 32 + h * 16); s1 = MFMA32(kf, qf[ks], s1); }
      __builtin_amdgcn_s_setprio(0);
      UNR for (int i = 0; i < 16; ++i) { s0[i] = __builtin_amdgcn_exp2f(s0[i]); lsum += s0[i]; }
      bf16x8 pf0[2]; pf0[0] = pack8(s0, 0); pf0[1] = pack8(s0, 8);
      __builtin_amdgcn_sched_barrier(0);
      UNR for (int dvt = 0; dvt < 4; ++dvt) UNR for (int s2 = 0; s2 < 2; ++s2) {
        const bf16x8 vf = *(const bf16x8*)(Vl + (dvt * 32 + r) * 144 + (s2 * 16 + 8 * h) * 2);
        O[dvt] = MFMA32(vf, pf0[s2], O[dvt]);
      }
      UNR for (int i = 0; i < 16; ++i) { s1[i] = __builtin_amdgcn_exp2f(s1[i]); lsum += s1[i]; }
      bf16x8 pf1[2]; pf1[0] = pack8(s1, 0); pf1[1] = pack8(s1, 8);
      UNR for (int g = 0; g < 8; ++g) { __builtin_amdgcn_sched_group_barrier(0x008, 1, 0); __builtin_amdgcn_sched_group_barrier(0x002, 5, 0); }
      __builtin_amdgcn_sched_barrier(0);
      UNR for (int dvt = 0; dvt < 4; ++dvt) UNR for (int s2 = 0; s2 < 2; ++s2) {
        const bf16x8 vf = *(const bf16x8*)(Vl + (dvt * 32 + r) * 144 + (32 + s2 * 16 + 8 * h) * 2);
        O[dvt] = MFMA32(vf, pf1[s2], O[dvt]);
      }
    }
    if (it + 1 < nt) {
      unsigned char* nx = smem + ((it + 1) & 1) * 35840;
      UNR for (int i = 0; i < 2; ++i) { *(u32x4*)(nx + (kkey0 + 32 * i) * 272 + kpart * 16) = rk[i]; *(u32x4*)(nx + 17408 + (vdv0 + 64 * i) * 144 + vpart * 16) = rv[i]; }
    }
    __syncthreads();
  }
  lsum += shx(lsum, 32);
  float* X = (float*)smem + qg * 4096;
  if (m == 1) {
    const float sc = lam / lsum;
    UNR for (int d = 0; d < 4; ++d) UNR for (int i = 0; i < 16; ++i) X[(d * 16 + i) * 64 + lane] = O[d][i] * sc;
  }
  __syncthreads();
  if (m == 0) {
    const float i0 = 1.f / lsum;
    float ss = 0.f;
    UNR for (int d = 0; d < 4; ++d) UNR for (int i = 0; i < 16; ++i) { const float o = O[d][i] * i0 - X[(d * 16 + i) * 64 + lane]; O[d][i] = o; ss += o * o; }
    ss += shx(ss, 32);
    const float rstd = (1.0f / sqrtf(ss * (1.f / 128.f) + 1e-6f)) * (1.f - lam_init);
    const size_t row = (size_t)b * TB + tq;
    const bf16_t* G = PB + 6 * SEG + row * 1024 + hd * 128;
    bf16_t* Y = (bf16_t*)(p.ws + OFF_Y) + row * 1024 + hd * 128;
    const float* sg = p.subln_g + (l >> 1) * 128;
    UNR for (int d = 0; d < 4; ++d) UNR for (int gq = 0; gq < 4; ++gq) {
      const int dv = d * 32 + 8 * gq + 4 * h;
      const u32x2 gg = *(const u32x2*)(G + dv); const f32x4 s4 = *(const f32x4*)(sg + dv);
      u32x2 w = {pk2(O[d][4 * gq] * rstd * s4[0] * bflo(gg[0]), O[d][4 * gq + 1] * rstd * s4[1] * bfhi(gg[0])),
                 pk2(O[d][4 * gq + 2] * rstd * s4[2] * bflo(gg[1]), O[d][4 * gq + 3] * rstd * s4[3] * bfhi(gg[1]))};
      *(u32x2*)(Y + dv) = w;
    }
  }
  __syncthreads();
}

DI void mixer_odd(const PW& p, int l, unsigned char* smem) {
  const float* MISC = (const float*)(p.ws + OFF_MISC);
  const float negM = MISC[l], lam = MISC[4 + (l >> 1)], lam_init = MISC[6 + (l >> 1)];
  const int G = gridDim.x, bid = lbid();
  if ((G & 7) == 0) {
    const int hd = bid & 7, slot = bid >> 3, S = G >> 3;
    for (int i = slot; i < 256; i += S) diff_unit(p, l, i >> 5, hd, (i & 31) * 128, 0, TB, negM, lam, lam_init, smem);
    if (l < 3) for (int i = slot; i < 16; i += S) diff_unit(p, l, i >> 1, hd, SEQ + (i & 1) * 128, SEQ, TB, negM, lam, lam_init, smem);
  } else {
    const int nun = l < 3 ? 2048 + 128 : 2048;
    for (int u = bid; u < nun; u += G) {
      if (u < 2048) { const int qb = u & 31, hd = (u >> 5) & 7, b = u >> 8; diff_unit(p, l, b, hd, qb * 128, 0, TB, negM, lam, lam_init, smem); }
      else { const int v = u - 2048, qb = v & 1, hd = (v >> 1) & 7, b = v >> 4; diff_unit(p, l, b, hd, SEQ + qb * 128, SEQ, TB, negM, lam, lam_init, smem); }
    }
  }
}

#define XB_TMO      128
#define XB_XCNT(j)  (256  + 64 * (j))
#define XB_XSUB(j)  (1280 + 64 * (j))
#define XB_XGEN(j)  (2304 + 64 * (j))
#define XB_TOP      3328
#define XB_TOPGEN   3392
#define XCD_BAR_WORDS 3456
#define XB_SPIN_CAP (1u << 18)
#ifndef LAS
#define LAS __attribute__((address_space(3)))
#endif

__device__ __forceinline__ unsigned xb_ld(unsigned* p)              { return __hip_atomic_load(p, __ATOMIC_RELAXED, __HIP_MEMORY_SCOPE_AGENT); }
__device__ __forceinline__ unsigned xb_add(unsigned* p, unsigned v) { return __hip_atomic_fetch_add(p, v, __ATOMIC_RELAXED, __HIP_MEMORY_SCOPE_AGENT); }
__device__ __forceinline__ unsigned xb_xcc_id() { return (unsigned)__builtin_amdgcn_s_getreg((3 << 11) | 20) & 0xFu; }
#define XB_SPIN(cond, bar) do { unsigned _sp = 0; while (cond) { __builtin_amdgcn_s_sleep(1); \
    if ((++_sp & 255u) == 0u) { if (xb_ld(&(bar)[XB_TMO])) break; if (_sp > XB_SPIN_CAP) { atomicAdd(&(bar)[XB_TMO], 1u); break; } } } } while (0)

struct XcdBarrier {
    unsigned* bar; unsigned x;
    volatile LAS unsigned* st;
};

__device__ __forceinline__ XcdBarrier xcd_barrier_post(unsigned* bar, volatile LAS unsigned* st) {
    XcdBarrier b; b.bar = bar; b.x = xb_xcc_id(); b.st = st;
    if (threadIdx.x == 0) (void)xb_add(&bar[XB_XCNT(b.x)], 1u);
    return b;
}
__device__ __forceinline__ void xcd_barrier_complete(unsigned* bar, unsigned x, unsigned& nloc, unsigned& nx) {
    const unsigned G = gridDim.x * gridDim.y * gridDim.z;
    unsigned sum, cnt, mine, sp = 0u;
    for (;;) {
        sum = 0u; cnt = 0u; mine = 0u;
#pragma unroll
        for (unsigned j = 0; j < 16; ++j) { const unsigned c = xb_ld(&bar[XB_XCNT(j)]); sum += c; cnt += (c > 0u) ? 1u : 0u; mine = (j == x) ? c : mine; }
        if (sum == G) break;
        __builtin_amdgcn_s_sleep(1);
        if ((++sp & 255u) == 0u) { if (xb_ld(&bar[XB_TMO])) break; if (sp > XB_SPIN_CAP) { atomicAdd(&bar[XB_TMO], 1u); break; } }
    }
    nloc = mine > 0u ? mine : 1u; nx = cnt > 0u ? cnt : 1u;
}

__device__ __forceinline__ void xcd_barrier(const XcdBarrier& b) {
    asm volatile("s_waitcnt vmcnt(0)" ::: "memory");
    __syncthreads();
    if (threadIdx.x == 0) {
        unsigned* bar = b.bar;
        __builtin_amdgcn_s_waitcnt(0);
        unsigned nloc = b.st[0], nx = b.st[1];
        if (nloc == 0u) { xcd_barrier_complete(bar, b.x, nloc, nx); b.st[0] = nloc; b.st[1] = nx; }
        const unsigned old = xb_add(&bar[XB_XSUB(b.x)], 1u);
        const unsigned gen = old / nloc;
        if (old + 1u == (gen + 1u) * nloc) {
            __builtin_amdgcn_fence(__ATOMIC_RELEASE, "agent");
            asm volatile("s_waitcnt vmcnt(0)" ::: "memory");
            const unsigned og = xb_add(&bar[XB_TOP], 1u);
            const unsigned tg = og / nx;
            if (og + 1u == (tg + 1u) * nx) xb_add(&bar[XB_TOPGEN], 1u);
            else XB_SPIN(xb_ld(&bar[XB_TOPGEN]) == tg, bar);
            __builtin_amdgcn_fence(__ATOMIC_ACQUIRE, "agent");
            xb_add(&bar[XB_XGEN(b.x)], 1u);
            asm volatile("s_waitcnt vmcnt(0)" ::: "memory");
        } else {
            XB_SPIN(xb_ld(&bar[XB_XGEN(b.x)]) == gen, bar);
            __builtin_amdgcn_fence(__ATOMIC_ACQUIRE, "agent");
            asm volatile("s_waitcnt vmcnt(0)" ::: "memory");
        }
    }
    __syncthreads();
}

typedef const Params __attribute__((address_space(4))) KParams;
DI void load_params(PW& q, KParams* k) { q.x = k->x; q.c = k->c; q.ctx = k->ctx; q.c_ctx = k->c_ctx; q.norm_g = k->norm_g; q.w_mod = k->w_mod; q.b_mod = k->b_mod; q.w_in = k->w_in; q.w_out = k->w_out; q.q_norm_g = k->q_norm_g; q.k_norm_g = k->k_norm_g; q.na_rpb = k->na_rpb; q.hy_conv_w = k->hy_conv_w; q.hy_conv_b = k->hy_conv_b; q.f_w1 = k->f_w1; q.f_b1 = k->f_b1; q.f_freq = k->f_freq; q.f_w2 = k->f_w2; q.f_b2 = k->f_b2; q.f_w3 = k->f_w3; q.f_b3 = k->f_b3; q.hy_skip = k->hy_skip; q.lq1 = k->lq1; q.lk1 = k->lk1; q.lq2 = k->lq2; q.lk2 = k->lk2; q.subln_g = k->subln_g; q.out = k->out; q.ws = k->ws; }
#define LAUNDER() do { ll = l; asm volatile("" : "+s"(ll)); KParams* k_ = kp; asm volatile("" : "+s"(k_)); load_params(q, k_); int w_ = wid0; asm volatile("" : "+s"(w_)); q.wid0 = w_; } while (0)
__global__ void __launch_bounds__(512) mega(Params p) {
  __shared__ __attribute__((aligned(16))) unsigned char smem[131072];
  __shared__ __attribute__((aligned(16))) unsigned xb_st[4];
  cg::grid_group grid = cg::this_grid();
  if (threadIdx.x < 4) xb_st[threadIdx.x] = 0u;
  __syncthreads();
  KParams* kp = (KParams*)__builtin_amdgcn_kernarg_segment_ptr();
  const int wid0 = __builtin_amdgcn_readfirstlane((int)(threadIdx.x >> 6));
  PW q; int ll = 0;
  { int l = 0; LAUNDER(); }
  if (blockIdx.x == 0) for (int i = threadIdx.x; i < 4096; i += 512) ((unsigned*)(q.ws + OFF_BAR))[i] = 0u;
  phase0(q, smem);
#if DUP & 8
  { int l = 0; LAUNDER(); phase0(q, smem); }
#endif
  grid.sync();
  const XcdBarrier xbar = xcd_barrier_post((unsigned*)(q.ws + OFF_BAR), (volatile LAS unsigned*)xb_st);
  for (int l = 0; l < 4; ++l) {
    LAUNDER();
    if (l == 0) finalize_filters(q);
    norm_phase(q, ll);
#if DUP & 16
    LAUNDER(); norm_phase(q, ll);
#endif
    xcd_barrier(xbar);
    LAUNDER();
    if (ll & 1) gemm_phase<1>(q, ll, smem); else gemm_phase<0>(q, ll, smem);
#if DUP & 1
    LAUNDER();
    if (ll & 1) gemm_phase<1>(q, ll, smem); else gemm_phase<0>(q, ll, smem);
#endif
    xcd_barrier(xbar);
    LAUNDER();
    if (ll & 1) mixer_odd(q, ll, smem); else mixer_even(q, ll, smem);
#if DUP & 2
    LAUNDER();
    if (!(ll & 1)) mixer_even(q, ll, smem);
#endif
#if DUP & 128
    LAUNDER();
    if (!(ll & 1)) mixer_even(q, ll, smem, 1);
#endif
#if DUP & 256
    LAUNDER();
    if (!(ll & 1)) mixer_even(q, ll, smem, 2);
#endif
#if DUP & 4
    LAUNDER();
    if (ll & 1) mixer_odd(q, ll, smem);
#endif
    xcd_barrier(xbar);
    LAUNDER();
    if (!(ll & 1)) { hy_transpose_phase(q, ll, smem); xcd_barrier(xbar); LAUNDER(); }
    gemm_phase<2>(q, ll, smem);
#if DUP & 32
    xcd_barrier(xbar); xcd_barrier(xbar); xcd_barrier(xbar); xcd_barrier(xbar);
#endif
#if DUP & 64
    if (l == 0) { LAUNDER(); gemm_phase<2>(q, ll, smem); }
#endif
    if (l < 3) xcd_barrier(xbar);
  }
}

extern "C" void kernel_launch(void* const* d_in, const int* in_sizes, int n_in, void* d_out, int out_size,
                              void* d_ws, size_t ws_size, hipStream_t stream) {
  static int grid_blocks = 0;
  if (!grid_blocks) {
    int dev = 0, cus = 0, per_cu = 0;
    (void)hipGetDevice(&dev);
    (void)hipDeviceGetAttribute(&cus, hipDeviceAttributeMultiprocessorCount, dev);
    (void)hipOccupancyMaxActiveBlocksPerMultiprocessor(&per_cu, mega, 512, 0);
    if (per_cu > 1) per_cu = 1;
    grid_blocks = cus * per_cu;
  }
  if (ws_size < WS_NEED) { fprintf(stderr, "workspace too small: %zu < %zu\n", ws_size, (size_t)WS_NEED); return; }
  Params p{};
  const float** pp = (const float**)&p;
  for (int i = 0; i < 27; ++i) pp[i] = (const float*)d_in[i];
  p.out = (float*)d_out; p.ws = (unsigned char*)d_ws;
  void* args[] = {&p};
  hipError_t e = hipLaunchCooperativeKernel((void*)mega, dim3(grid_blocks), dim3(512), args, 0, stream);
  if (e != hipSuccess) fprintf(stderr, "coop launch failed: %s (grid %d)\n", hipGetErrorString(e), grid_blocks);
}
```

```cpp
#ifndef DUP
#define DUP 0
#endif
#include <hip/hip_runtime.h>
#include <hip/hip_cooperative_groups.h>
#include <cstdio>
namespace cg = cooperative_groups;

typedef unsigned short bf16_t;
typedef short bf16x8 __attribute__((ext_vector_type(8)));
typedef float f32x16 __attribute__((ext_vector_type(16)));
typedef float f32x4 __attribute__((ext_vector_type(4)));
typedef unsigned u32x4 __attribute__((ext_vector_type(4)));
typedef unsigned u32x2 __attribute__((ext_vector_type(2)));
typedef __bf16 bf16v2 __attribute__((ext_vector_type(2)));
#define DI __device__ __forceinline__
#define MFMA32(a, b, c) __builtin_amdgcn_mfma_f32_32x32x16_bf16((a), (b), (c), 0, 0, 0)
#define UNR _Pragma("unroll")

constexpr int R = 34816, TB = 4352, SEQ = 4096, NCTX = 256;
constexpr float LOG2E = 1.4426950408889634f;
constexpr size_t SEG = (size_t)R * 512;
constexpr size_t OFF_WIN = 0;
constexpr size_t OFF_WOUT = OFF_WIN + 4ull * 4096 * 1024 * 2;
constexpr size_t OFF_MOD = OFF_WOUT + 4ull * 1024 * 1024 * 2;
constexpr size_t OFF_HN = OFF_MOD + 4ull * 9 * 3072 * 4;
constexpr size_t OFF_PB = OFF_HN + (size_t)R * 1024 * 2;
constexpr size_t OFF_Y = OFF_PB + (size_t)R * 4096 * 2;
constexpr size_t OFF_XC = OFF_Y + (size_t)R * 1024 * 2;
constexpr size_t OFF_GREV = OFF_XC + 8ull * 256 * 1024 * 4;
constexpr size_t OFF_GC = OFF_GREV + 2ull * 2 * 512 * 8192 * 2;
constexpr size_t OFF_MISC = OFF_GC + 2ull * 2 * 512 * 512 * 4;
constexpr size_t OFF_BAR = OFF_MISC + 4096;
constexpr size_t WS_NEED = OFF_BAR + 16384;
constexpr size_t OFF_HRAW = OFF_PB;
constexpr size_t OFF_HRAWC = OFF_HRAW + 2ull * 2 * 2 * 512 * 4096 * 4;
constexpr size_t OFF_SSP = OFF_HRAWC + 2ull * 2 * 2 * 512 * 256 * 4;

struct Params {
  const float *x, *c, *ctx, *c_ctx, *norm_g, *w_mod, *b_mod, *w_in, *w_out, *q_norm_g, *k_norm_g, *na_rpb, *hy_conv_w, *hy_conv_b,
      *f_w1, *f_b1, *f_freq, *f_w2, *f_b2, *f_w3, *f_b3, *hy_skip, *lq1, *lk1, *lq2, *lk2, *subln_g;
  float* out;
  unsigned char* ws;
};
struct PW : Params { int wid0; };

DI unsigned pk2(float a, float b) { bf16v2 v = {(__bf16)a, (__bf16)b}; return __builtin_bit_cast(unsigned, v); }
DI float bflo(unsigned u) { return __uint_as_float(u << 16); }
DI float bfhi(unsigned u) { return __uint_as_float(u & 0xffff0000u); }
DI float bf1(bf16_t u) { return __uint_as_float((unsigned)u << 16); }
DI int crow(int reg, int h) { return (reg & 3) + 8 * (reg >> 2) + 4 * h; }
DI float silu(float x) { return x / (1.f + __expf(-x)); }
DI int lane_l() { int l = __builtin_amdgcn_mbcnt_hi(~0u, __builtin_amdgcn_mbcnt_lo(~0u, 0u)); asm volatile("" : "+v"(l)); return l; }
DI float shx(float v, int o) { return __int_as_float(__builtin_amdgcn_ds_bpermute((lane_l() ^ o) << 2, __float_as_int(v))); }
DI float wave_sum(float v) { UNR for (int o = 32; o > 0; o >>= 1) v += shx(v, o); return v; }
DI float wave_max(float v) { UNR for (int o = 32; o > 0; o >>= 1) v = fmaxf(v, shx(v, o)); return v; }
DI f32x16 splat16(float v) { f32x16 r; UNR for (int i = 0; i < 16; ++i) r[i] = v; return r; }
DI bf16x8 pack8(const f32x16& s, int o) {
  u32x4 w; w[0] = pk2(s[o], s[o + 1]); w[1] = pk2(s[o + 2], s[o + 3]); w[2] = pk2(s[o + 4], s[o + 5]); w[3] = pk2(s[o + 6], s[o + 7]);
  return __builtin_bit_cast(bf16x8, w);
}

#define LTID(p) (((p).wid0 << 6) | lane_l())
DI int lbid() { int b = blockIdx.x; asm volatile("" : "+s"(b)); return b; }
DI void transpose_jobs(const PW& p, float* tile) {
  const int tid = LTID(p);
  constexpr int J_TIN = 4 * 16 * 64, J_ALL = J_TIN + 4 * 16 * 16;
  const int kk = tid >> 4, n4 = (tid & 15) * 4, n = tid >> 3, kc = tid & 7;
#define TJ_SRC(j, pass) ((j) < J_TIN ? p.w_in + (size_t)((j) >> 10) * 1024 * 4096 + (size_t)((((j) >> 6) & 15) * 64 + (pass) * 32 + kk) * 4096 + ((j) & 63) * 64 + n4 \
                                     : p.w_out + (size_t)(((j) - J_TIN) >> 8) * 1024 * 1024 + (size_t)(((((j) - J_TIN) >> 4) & 15) * 64 + (pass) * 32 + kk) * 1024 + (((j) - J_TIN) & 15) * 64 + n4)
  int j = lbid();
  f32x4 v0 = {0.f, 0.f, 0.f, 0.f}, v1 = v0;
  if (j < J_ALL) { v0 = *(const f32x4*)TJ_SRC(j, 0); v1 = *(const f32x4*)TJ_SRC(j, 1); }
  for (; j < J_ALL; j += gridDim.x) {
    UNR for (int e = 0; e < 4; ++e) { tile[kk * 65 + n4 + e] = v0[e]; tile[(32 + kk) * 65 + n4 + e] = v1[e]; }
    const int jn = j + gridDim.x;
    if (jn < J_ALL) { v0 = *(const f32x4*)TJ_SRC(jn, 0); v1 = *(const f32x4*)TJ_SRC(jn, 1); }
    __syncthreads();
    u32x4 w;
    UNR for (int q = 0; q < 4; ++q) w[q] = pk2(tile[(kc * 8 + 2 * q) * 65 + n], tile[(kc * 8 + 2 * q + 1) * 65 + n]);
    const bool isin = j < J_TIN; const int jj = isin ? j : j - J_TIN;
    const int l = isin ? jj >> 10 : jj >> 8, tk = isin ? (jj >> 6) & 15 : (jj >> 4) & 15, tn = isin ? jj & 63 : jj & 15;
    bf16_t* Wt = isin ? (bf16_t*)(p.ws + OFF_WIN) + (size_t)l * 4096 * 1024 : (bf16_t*)(p.ws + OFF_WOUT) + (size_t)l * 1024 * 1024;
    { const int cn = tn * 64 + n, c = cn & 255; const int pos = (cn & ~255) + 128 * ((c >> 5) & 1) + 32 * (c >> 6) + (c & 31);
      *(u32x4*)(Wt + (size_t)pos * 1024 + tk * 64 + kc * 8) = w; }
    __syncthreads();
  }
#undef TJ_SRC
}

DI void job_mod(const PW& p, int l, int cgp, float* sv, float* red) {
  const int tid = LTID(p);
  float* MOD = (float*)(p.ws + OFF_MOD);
  for (int i = tid; i < 9 * 1024; i += 512) { const int v = i >> 10, k = i & 1023; const float c = v < 8 ? p.c[v * 1024 + k] : p.c_ctx[k]; sv[i] = silu(c); }
  __syncthreads();
  const int kg = tid >> 6, cn = tid & 63, n = cgp * 64 + cn;
  float acc[9];
  UNR for (int v = 0; v < 9; ++v) acc[v] = 0.f;
  const float* W = p.w_mod + (size_t)l * 1024 * 3072 + n;
  for (int k = kg * 128; k < kg * 128 + 128; k += 16) {
    float w[16];
    UNR for (int u = 0; u < 16; ++u) w[u] = W[(size_t)(k + u) * 3072];
    UNR for (int v = 0; v < 9; ++v) UNR for (int u4 = 0; u4 < 4; ++u4) { const f32x4 s4 = *(const f32x4*)(sv + v * 1024 + k + u4 * 4); UNR for (int j = 0; j < 4; ++j) acc[v] += s4[j] * w[u4 * 4 + j]; }
  }
  UNR for (int v = 0; v < 9; ++v) red[(kg * 9 + v) * 64 + cn] = acc[v];
  __syncthreads();
  for (int i = tid; i < 9 * 64; i += 512) {
    const int v = i >> 6, c2 = i & 63; float s = 0.f;
    UNR for (int g = 0; g < 8; ++g) s += red[(g * 9 + v) * 64 + c2];
    MOD[(l * 9 + v) * 3072 + cgp * 64 + c2] = s + p.b_mod[l * 3072 + cgp * 64 + c2];
  }
  __syncthreads();
}

DI void job_filter(const PW& p, int e, int chunk, int cb, float* zs, float* h1, float* h2) {
  const int tid = LTID(p);
  const bool isc = chunk >= 256; const int L = isc ? 256 : 4096; const int t0 = (isc ? chunk - 256 : chunk) * 16;
  for (int i = tid; i < 16 * 33; i += 512) {
    const int tt = i / 33, f = i % 33, t = t0 + tt; float val;
    if (f == 0) val = (float)t / (float)(L - 1);
    else { const int k = (f - 1) & 15; const float fb = 1e-4f + (float)k * ((15.f - 1e-4f) / 15.f); float rev = fb * (float)t / (float)L; rev -= floorf(rev);
           val = f <= 16 ? __builtin_amdgcn_cosf(rev) : -__builtin_amdgcn_sinf(rev); }
    zs[i] = val;
  }
  __syncthreads();
  for (int i = tid; i < 1024; i += 512) {
    const int tt = i >> 6, j = i & 63; float a = p.f_b1[e * 64 + j];
    for (int f = 0; f < 33; ++f) a += zs[tt * 33 + f] * p.f_w1[(e * 33 + f) * 64 + j];
    h1[i] = __sinf(p.f_freq[e * 64 + j] * a);
  }
  __syncthreads();
  for (int i = tid; i < 1024; i += 512) {
    const int tt = i >> 6, j = i & 63; float a = p.f_b2[e * 64 + j];
    for (int k = 0; k < 64; ++k) a += h1[tt * 64 + k] * p.f_w2[(e * 64 + k) * 64 + j];
    h2[j * 16 + tt] = __sinf(p.f_freq[e * 64 + j] * a);
  }
  __syncthreads();
  const int n = cb * 512 + tid;
  float acc[16];
  { const float b3 = p.f_b3[e * 2048 + n]; UNR for (int tt = 0; tt < 16; ++tt) acc[tt] = b3; }
  _Pragma("unroll 4") for (int k = 0; k < 64; ++k) {
    const float w = p.f_w3[((size_t)e * 64 + k) * 2048 + n];
    UNR for (int q4 = 0; q4 < 4; ++q4) { const f32x4 hv = *(const f32x4*)(h2 + k * 16 + q4 * 4); UNR for (int j = 0; j < 4; ++j) acc[q4 * 4 + j] += hv[j] * w; }
  }
  const float mind = logf(1e-2f) / 1.5f, maxd = logf(1e-2f) / 0.3f;
  const float delta = fabsf(mind + (float)tid * ((maxd - mind) / 511.f));
  float ss = 0.f;
  UNR for (int tt = 0; tt < 16; ++tt) { const float tl = (float)(t0 + tt) / (float)(L - 1); acc[tt] *= __expf(-tl * delta); ss += acc[tt] * acc[tt]; }
  float* dst = isc ? (float*)(p.ws + OFF_HRAWC) + ((size_t)(e * 4 + cb) * 512 + tid) * 256 + t0 : (float*)(p.ws + OFF_HRAW) + ((size_t)(e * 4 + cb) * 512 + tid) * 4096 + t0;
  UNR for (int q = 0; q < 4; ++q) { f32x4 v = {acc[4 * q], acc[4 * q + 1], acc[4 * q + 2], acc[4 * q + 3]}; *(f32x4*)(dst + 4 * q) = v; }
  ((float*)(p.ws + OFF_SSP))[((size_t)e * 272 + chunk) * 2048 + n] = ss;
  __syncthreads();
}

DI void job_misc(const PW& p) {
  const int tid_ = LTID(p); const int wid = __builtin_amdgcn_readfirstlane(tid_ >> 6), lane = tid_ & 63;
  float* MISC = (float*)(p.ws + OFF_MISC);
  if (wid != 0) return;
  for (int l = 0; l < 4; ++l) {
    const float mq = wave_max(fabsf(p.q_norm_g[l * 64 + lane])), mk = wave_max(fabsf(p.k_norm_g[l * 64 + lane]));
    float bound = 8.f * mq * mk;
    if ((l & 1) == 0) { float mr = 0.f; const float* rp = p.na_rpb + (size_t)(l >> 1) * 8 * 15 * 31; for (int i = lane; i < 8 * 15 * 31; i += 64) mr = fmaxf(mr, fabsf(rp[i])); bound += wave_max(mr); }
    if (lane == 0) MISC[l] = -bound * LOG2E;
  }
  for (int o = 0; o < 2; ++o) {
    const float s1 = wave_sum(p.lq1[o * 64 + lane] * p.lk1[o * 64 + lane]), s2 = wave_sum(p.lq2[o * 64 + lane] * p.lk2[o * 64 + lane]);
    const float lam_init = 0.8f - 0.6f * expf(-0.3f * (float)(2 * o + 1));
    if (lane == 0) { MISC[4 + o] = expf(s1) - expf(s2) + lam_init; MISC[6 + o] = lam_init; }
  }
}

DI void phase0(const PW& p, unsigned char* smem) {
  float* fs = (float*)smem;
  transpose_jobs(p, fs);
  constexpr int J_MOD = 4 * 48, J_FIL = 2 * 272 * 4;
  constexpr int NJ = J_MOD + J_FIL + 1;
  for (int job = lbid(); job < NJ; job += gridDim.x) {
    int j = job;
    if (j < J_MOD) { job_mod(p, j / 48, j % 48, fs, fs + 9 * 1024); continue; }
    j -= J_MOD;
    if (j < J_FIL) { const int e = j / (272 * 4), chunk = (j / 4) % 272, cb = j % 4; job_filter(p, e, chunk, cb, fs, fs + 16 * 33, fs + 16 * 33 + 1024); continue; }
    job_misc(p);
  }
}

DI void finalize_filters(const PW& p) {
  const int tid_ = LTID(p); const int wid = __builtin_amdgcn_readfirstlane(tid_ >> 6), lane = tid_ & 63;
  const float* SSP = (const float*)(p.ws + OFF_SSP);
  for (int job = lbid() * 8 + wid; job < 2048; job += gridDim.x * 8) {
    const int e = job >> 10, o = (job >> 9) & 1, c = job & 511;
    float ss = 0.f;
    for (int i = lane; i < 512; i += 64) ss += SSP[((size_t)e * 272 + (i >> 1)) * 2048 + o * 1024 + (i & 1) * 512 + c];
    ss = wave_sum(ss);
    float ssc = 0.f;
    if (lane < 32) ssc = SSP[((size_t)e * 272 + 256 + (lane >> 1)) * 2048 + o * 1024 + (lane & 1) * 512 + c];
    ssc = wave_sum(ssc);
    const float rs = 1.0f / sqrtf(ss + 1e-6f), rsc = 1.0f / sqrtf(ssc + 1e-6f);
    const float skip = p.hy_skip[(e * 2 + o) * 512 + c];
    const float* hf = (const float*)(p.ws + OFF_HRAW) + ((size_t)((e * 2 + o) * 2 + 0) * 512 + c) * 4096;
    const float* hb = (const float*)(p.ws + OFF_HRAW) + ((size_t)((e * 2 + o) * 2 + 1) * 512 + c) * 4096;
    unsigned* dst = (unsigned*)((bf16_t*)(p.ws + OFF_GREV) + ((size_t)(e * 2 + o) * 512 + c) * 8192);
    const float diag = rs * (hf[0] + hb[0]) + skip;
    _Pragma("unroll 8") for (int pp = lane * 2; pp < 8192; pp += 128) {
      float v[2];
      UNR for (int u = 0; u < 2; ++u) { const int d = 4095 - (pp + u); v[u] = d > 0 ? rs * hf[d] : (d == 0 ? diag : (d > -4096 ? rs * hb[-d] : 0.f)); }
      dst[pp >> 1] = pk2(v[0], v[1]);
    }
    const float* hfc = (const float*)(p.ws + OFF_HRAWC) + ((size_t)((e * 2 + o) * 2 + 0) * 512 + c) * 256;
    const float* hbc = (const float*)(p.ws + OFF_HRAWC) + ((size_t)((e * 2 + o) * 2 + 1) * 512 + c) * 256;
    float* gc = (float*)(p.ws + OFF_GC) + ((size_t)(e * 2 + o) * 512 + c) * 512;
    for (int q = lane; q < 512; q += 64) {
      const int d = q - 256;
      gc[q] = q == 0 ? 0.f : (d > 0 ? rsc * hfc[d] : (d == 0 ? rsc * (hfc[0] + hbc[0]) + skip : rsc * hbc[-d]));
    }
  }
}

DI void norm_phase(const PW& p, int l) {
  const int tid_ = LTID(p); const int wid = __builtin_amdgcn_readfirstlane(tid_ >> 6), lane = tid_ & 63;
  const float* MOD = (const float*)(p.ws + OFF_MOD);
  bf16_t* HN = (bf16_t*)(p.ws + OFF_HN);
  const float* xc_in = l == 0 ? p.ctx : (const float*)(p.ws + OFF_XC);
  const float* x_in = l == 0 ? p.x : p.out;
  const int nw = gridDim.x * 8;
  for (int row = lbid() * 8 + wid; row < R; row += 2 * nw) {
    const float* src[2]; const float* mv[2]; int rr[2];
    UNR for (int q = 0; q < 2; ++q) {
      rr[q] = row + q * nw; const int rq = rr[q] < R ? rr[q] : row;
      const int b = rq / TB, t = rq % TB;
      src[q] = t < SEQ ? x_in + ((size_t)b * SEQ + t) * 1024 : xc_in + ((size_t)b * NCTX + (t - SEQ)) * 1024;
      mv[q] = MOD + (size_t)(l * 9 + (t < SEQ ? b : 8)) * 3072;
    }
    f32x4 v[2][4]; float ss[2] = {0.f, 0.f};
    UNR for (int q = 0; q < 2; ++q) UNR for (int i = 0; i < 4; ++i) v[q][i] = *(const f32x4*)(src[q] + i * 256 + lane * 4);
    UNR for (int q = 0; q < 2; ++q) UNR for (int i = 0; i < 4; ++i) ss[q] += v[q][i][0] * v[q][i][0] + v[q][i][1] * v[q][i][1] + v[q][i][2] * v[q][i][2] + v[q][i][3] * v[q][i][3];
    UNR for (int o = 32; o > 0; o >>= 1) { ss[0] += shx(ss[0], o); ss[1] += shx(ss[1], o); }
    UNR for (int q = 0; q < 2; ++q) {
      if (rr[q] >= R) continue;
      const float rstd = 1.0f / sqrtf(ss[q] * (1.f / 1024.f) + 1e-6f);
      UNR for (int i = 0; i < 4; ++i) {
        const int c0 = i * 256 + lane * 4;
        const f32x4 g = *(const f32x4*)(p.norm_g + l * 1024 + c0), sh = *(const f32x4*)(mv[q] + c0), sc = *(const f32x4*)(mv[q] + 1024 + c0);
        float o[4];
        UNR for (int j = 0; j < 4; ++j) o[j] = v[q][i][j] * rstd * g[j] * (1.f + sc[j]) + sh[j];
        u32x2 w = {pk2(o[0], o[1]), pk2(o[2], o[3])};
        *(u32x2*)(HN + (size_t)rr[q] * 1024 + c0) = w;
      }
    }
  }
}

namespace pg8 {
#define PG8_LAS __attribute__((address_space(3)))
typedef unsigned short bf16_t;
typedef short bf16x8 __attribute__((ext_vector_type(8)));
typedef float f32x4 __attribute__((ext_vector_type(4)));
typedef unsigned u32x4 __attribute__((ext_vector_type(4)));
constexpr int BM = 256, BK = 64, HALF = 128, HTB = HALF * BK * 2  , STAGE_BYTES = 8 * HTB, NXCD = 8, WGM = 8;

__host__ __device__ __forceinline__ int lds_byte(int r, int c) { const int st = (r >> 4) * 2 + (c >> 5), rr = r & 15, cc = c & 31, ob = rr * 64 + cc * 2; return st * 1024 + (ob ^ (((ob >> 9) & 1) << 5)); }
__host__ __device__ __forceinline__ void stage_rc(int b, int& R, int& C) { const int st = b / 1024, sb = b % 1024, swz = sb ^ (((sb >> 9) & 1) << 5); R = (st >> 1) * 16 + swz / 64; C = (st & 1) * 32 + (swz % 64) / 2; }
__host__ __device__ __forceinline__ int perm32(int rho) { const int n = rho >> 4, i = rho & 15; return 8 * (i >> 2) + 4 * n + (i & 3); }

struct Unit { int pm, pn; };
struct Gemm { const bf16_t* A; const bf16_t* Bt; int M, N, K; };

struct StaticOrder {
    int nM, nN, nwg, G, c;
    __host__ __device__ void init(int M, int N, int G_, int c_) { nM = M / BM; nN = N / BM; nwg = nM * nN; G = G_; c = c_; }
    __host__ __device__ bool next(int i, Unit& u) const {
        const long L = (long)i * G + c; if (L >= nwg) return false;
        int wgid = (int)L; { const int q = nwg / NXCD, r = nwg % NXCD, xcd = wgid % NXCD, off = wgid / NXCD; wgid = (xcd < r ? xcd * (q + 1) : r * (q + 1) + (xcd - r) * q) + off; }
        const int nig = WGM * nN, gid = wgid / nig, fm = gid * WGM, gsz = (nM - fm) < WGM ? (nM - fm) : WGM;
        u.pm = fm + ((wgid % nig) % gsz); u.pn = (wgid % nig) / gsz; return true;
    }
    __device__ __forceinline__ void a_ready(const Unit&) const {}
    __device__ __forceinline__ void done(const Unit&) const {}
};
template <class Epi, class Sched, bool ALIGN_EPI = false, bool SP2 = false>
__device__ __forceinline__ void gemm_phase(PG8_LAS unsigned char* lds, const Gemm g, const Sched& S, const Epi& E, const int tid0) {
    const int tid = tid0, wid = __builtin_amdgcn_readfirstlane(tid >> 6), lane = tid & 63, wr = wid >> 2, wc = wid & 3, fr = lane & 15, fq = lane >> 4;
    const int K = g.K, nt = K / BK;
    unsigned voffA[2], voffB[2];
#pragma unroll
    for (int i = 0; i < 2; ++i) { int R, C; stage_rc(tid * 16 + i * 8192, R, C); const int Rb = Epi::PERM ? ((R & ~31) + perm32(R & 31)) : R;
        voffA[i] = (unsigned)(R * K + C) * 2u; voffB[i] = (unsigned)(Rb * K + C) * 2u; }
    const size_t kstep = (size_t)(BK * 2);
    const size_t hstep = (size_t)HALF * K * 2;
    const size_t tstep = 2 * hstep;
    const unsigned ldsw = (unsigned)wid * 1024u;
    const int aoff = lds_byte(wr * 64 + fr, fq * 8), boff = lds_byte(wc * 32 + fr, fq * 8);
#define PG8_SA(b, h) (((b) * 2 + (h)) * HTB)
#define PG8_SB(b, h) ((4 + (b) * 2 + (h)) * HTB)
#define PG8_STAGE(bufoff, gbase, voff) do { _Pragma("unroll") for (int _i = 0; _i < 2; ++_i) \
        __builtin_amdgcn_global_load_lds((const unsigned*)((const char*)(gbase) + (voff)[_i]), (PG8_LAS unsigned*)(lds + (bufoff) + ldsw + _i * 8192), 16, 0, 0); } while (0)
#define PG8_LDA(dst, b, h) do { _Pragma("unroll") for (int m = 0; m < 4; ++m) _Pragma("unroll") for (int k = 0; k < 2; ++k) dst[m][k] = *(const PG8_LAS bf16x8*)(lds + PG8_SA(b, h) + aoff + m * 2048 + k * 1024); } while (0)
#define PG8_LDB(dst, b, h) do { _Pragma("unroll") for (int n = 0; n < 2; ++n) _Pragma("unroll") for (int k = 0; k < 2; ++k) dst[n][k] = *(const PG8_LAS bf16x8*)(lds + PG8_SB(b, h) + boff + n * 2048 + k * 1024); } while (0)
#define PG8_MMA(ai, bj, At, Bt) do { __builtin_amdgcn_s_setprio(1); _Pragma("unroll") for (int m = 0; m < 4; ++m) _Pragma("unroll") for (int n = 0; n < 2; ++n) _Pragma("unroll") for (int k = 0; k < 2; ++k) \
        acc[ai][bj][m][n] = __builtin_amdgcn_mfma_f32_16x16x32_bf16(Bt[n][k], At[m][k], acc[ai][bj][m][n], 0, 0, 0); __builtin_amdgcn_s_setprio(0); } while (0)
#define PG8_WAIT_V(n) asm volatile("s_waitcnt vmcnt(" #n ")" ::: "memory")
#define PG8_WAIT_L(n) asm volatile("s_waitcnt lgkmcnt(" #n ")" ::: "memory")
#define PG8_BAR __builtin_amdgcn_s_barrier()
#define PG8_SCHED __builtin_amdgcn_sched_barrier(0)
    Unit cur, nxt; int ui = 0;
    if (!S.next(0, cur)) return;
    f32x4 acc[2][2][4][2];
#pragma unroll
    for (int a = 0; a < 2; ++a)
#pragma unroll
        for (int b = 0; b < 2; ++b)
#pragma unroll
            for (int m = 0; m < 4; ++m)
#pragma unroll
                for (int n = 0; n < 2; ++n) acc[a][b][m][n] = (f32x4){0.f, 0.f, 0.f, 0.f};
    bf16x8 At[4][2], B0[2][2], B1[2][2];
    const char* cA = E.normal(cur) ? (const char*)g.Bt + (size_t)cur.pn * tstep : (const char*)g.A + (size_t)cur.pm * tstep; const char* cB = E.normal(cur) ? (const char*)g.A + (size_t)cur.pm * tstep : (const char*)g.Bt + (size_t)cur.pn * tstep;
    S.a_ready(cur);
    if constexpr (SP2) {
        PG8_STAGE(PG8_SB(0, 0), cB, voffB); PG8_STAGE(PG8_SB(0, 1), cB + hstep, voffB); PG8_STAGE(PG8_SA(0, 0), cA, voffA); PG8_STAGE(PG8_SA(0, 1), cA + hstep, voffA);
        if (wr == 1) PG8_BAR;
        PG8_WAIT_V(2); PG8_BAR;
        PG8_STAGE(PG8_SB(1, 0), cB + kstep, voffB); PG8_STAGE(PG8_SA(1, 0), cA + kstep, voffA); PG8_STAGE(PG8_SB(1, 1), cB + hstep + kstep, voffB);
        PG8_WAIT_V(6); PG8_BAR;
    } else {
        PG8_STAGE(PG8_SB(0, 0), cB, voffB); PG8_STAGE(PG8_SA(0, 0), cA, voffA); PG8_STAGE(PG8_SB(0, 1), cB + hstep, voffB); PG8_STAGE(PG8_SA(0, 1), cA + hstep, voffA);
        if (wr == 1) PG8_BAR;
        PG8_WAIT_V(4); PG8_BAR;
        PG8_STAGE(PG8_SB(1, 0), cB + kstep, voffB); PG8_STAGE(PG8_SA(1, 0), cA + kstep, voffA); PG8_STAGE(PG8_SB(1, 1), cB + hstep + kstep, voffB);
        PG8_WAIT_V(6); PG8_BAR;
    }
    for (;;) {
        const bool has_next = S.next(ui + 1, nxt);
        const bool nsw = has_next && E.normal(nxt); const char* nA = has_next ? (nsw ? (const char*)g.Bt + (size_t)nxt.pn * tstep : (const char*)g.A + (size_t)nxt.pm * tstep) : cA; const char* nB = has_next ? (nsw ? (const char*)g.A + (size_t)nxt.pm * tstep : (const char*)g.Bt + (size_t)nxt.pn * tstep) : cB;
        for (int t = 0; t < nt; t += 2) {
            const bool last = (t == nt - 2);
            const char* a1 = cA + (size_t)(t + 1) * kstep;
            const char* a2 = last ? nA : cA + (size_t)(t + 2) * kstep; const char* b2 = last ? nB : cB + (size_t)(t + 2) * kstep;
            const char* a3 = a2 + kstep; const char* b3 = b2 + kstep;
            if (last && has_next) S.a_ready(nxt);
            if constexpr (SP2) {
            PG8_LDB(B0, 0, 0); PG8_LDB(B1, 0, 1); PG8_SCHED; PG8_LDA(At, 0, 0); PG8_STAGE(PG8_SA(1, 1), a1 + hstep, voffA);
            PG8_WAIT_V(8); PG8_WAIT_L(0); PG8_BAR; PG8_MMA(0, 0, At, B0); PG8_MMA(0, 1, At, B1); PG8_BAR; PG8_SCHED;
            PG8_LDA(At, 0, 1); PG8_STAGE(PG8_SB(0, 0), b2, voffB); PG8_STAGE(PG8_SB(0, 1), b2 + hstep, voffB); PG8_STAGE(PG8_SA(0, 0), a2, voffA);
            PG8_WAIT_V(8); PG8_WAIT_L(0); PG8_BAR; PG8_MMA(1, 0, At, B0); PG8_MMA(1, 1, At, B1); PG8_BAR; PG8_SCHED;
            PG8_LDB(B0, 1, 0); PG8_LDB(B1, 1, 1); PG8_SCHED; PG8_LDA(At, 1, 0); PG8_STAGE(PG8_SA(0, 1), a2 + hstep, voffA);
            PG8_WAIT_V(8); PG8_WAIT_L(0); PG8_BAR; PG8_MMA(0, 0, At, B0); PG8_MMA(0, 1, At, B1); PG8_BAR; PG8_SCHED;
            PG8_LDA(At, 1, 1); PG8_STAGE(PG8_SB(1, 0), b3, voffB); PG8_STAGE(PG8_SB(1, 1), b3 + hstep, voffB); PG8_STAGE(PG8_SA(1, 0), a3, voffA);
            PG8_WAIT_V(8); PG8_WAIT_L(0); PG8_BAR; PG8_MMA(1, 0, At, B0); PG8_MMA(1, 1, At, B1); PG8_BAR; PG8_SCHED;
            } else {
            PG8_LDB(B0, 0, 0); PG8_SCHED; PG8_LDA(At, 0, 0); PG8_STAGE(PG8_SA(1, 1), a1 + hstep, voffA);
            PG8_WAIT_L(8); PG8_BAR; PG8_WAIT_L(0); PG8_MMA(0, 0, At, B0); PG8_BAR; PG8_SCHED;
            PG8_LDB(B1, 0, 1); PG8_STAGE(PG8_SB(0, 0), b2, voffB);
            PG8_BAR; PG8_WAIT_L(0); PG8_MMA(0, 1, At, B1); PG8_BAR;
            PG8_LDA(At, 0, 1); PG8_STAGE(PG8_SA(0, 0), a2, voffA);
            PG8_BAR; PG8_WAIT_L(0); PG8_MMA(1, 0, At, B0); PG8_BAR; PG8_SCHED;
            PG8_STAGE(PG8_SB(0, 1), b2 + hstep, voffB);
            PG8_WAIT_V(6); PG8_BAR; PG8_MMA(1, 1, At, B1); PG8_BAR;
            PG8_LDB(B0, 1, 0); PG8_SCHED; PG8_LDA(At, 1, 0); PG8_STAGE(PG8_SA(0, 1), a2 + hstep, voffA);
            PG8_WAIT_L(8); PG8_BAR; PG8_WAIT_L(0); PG8_MMA(0, 0, At, B0); PG8_BAR; PG8_SCHED;
            PG8_LDB(B1, 1, 1); PG8_STAGE(PG8_SB(1, 0), b3, voffB);
            PG8_BAR; PG8_WAIT_L(0); PG8_MMA(0, 1, At, B1); PG8_BAR;
            PG8_LDA(At, 1, 1); PG8_STAGE(PG8_SA(1, 0), a3, voffA);
            PG8_BAR; PG8_WAIT_L(0); PG8_MMA(1, 0, At, B0); PG8_BAR; PG8_SCHED;
            PG8_STAGE(PG8_SB(1, 1), b3 + hstep, voffB);
            PG8_WAIT_V(6); PG8_BAR; PG8_MMA(1, 1, At, B1); PG8_BAR;
            }
        }
        if constexpr (ALIGN_EPI) { if (wr == 0) PG8_BAR; }
        if constexpr (!Epi::AFTER_DRAIN) { E(acc, cur, wr, wc, fr, fq); S.done(cur); }
        if (!has_next) break;
#pragma unroll
        for (int a = 0; a < 2; ++a)
#pragma unroll
            for (int b = 0; b < 2; ++b)
#pragma unroll
                for (int m = 0; m < 4; ++m)
#pragma unroll
                    for (int n = 0; n < 2; ++n) acc[a][b][m][n] = (f32x4){0.f, 0.f, 0.f, 0.f};
        cur = nxt; cA = nA; cB = nB; ++ui;
        if constexpr (ALIGN_EPI) { if (wr == 1) PG8_BAR; }
    }
    PG8_WAIT_V(0);
    if constexpr (!ALIGN_EPI) { if (wr == 0) PG8_BAR; }
    PG8_BAR;
    if constexpr (Epi::AFTER_DRAIN) { E.fused(acc, cur, wr, wc, fr, fq, lds, wid, lane); S.done(cur); }
#undef PG8_SA
#undef PG8_SB
#undef PG8_STAGE
#undef PG8_LDA
#undef PG8_LDB
#undef PG8_MMA
#undef PG8_WAIT_V
#undef PG8_WAIT_L
#undef PG8_BAR
#undef PG8_SCHED
}
}

typedef const f32x4 (&AccRef)[2][2][4][2];
DI void epi2_qk(AccRef acc, bf16_t* dst, int pitch, const float* g, float scale, bool rope, int tq0, int fr, int fq) {
  f32x4 g0[2], g1[2];
  UNR for (int n = 0; n < 2; ++n) { g0[n] = *(const f32x4*)(g + 8 * fq + 4 * n); g1[n] = *(const f32x4*)(g + 32 + 8 * fq + 4 * n); }
  float inv[2][4];
  UNR for (int n = 0; n < 2; ++n) UNR for (int e = 0; e < 4; ++e) inv[n][e] = __builtin_amdgcn_exp2f(-(float)((8 * fq + 4 * n + e) & 15) * (13.287712379549449f / 16.f)) * 0.15915494309189535f;
  float ssq[2][4];
  UNR for (int ai = 0; ai < 2; ++ai) UNR for (int m = 0; m < 4; ++m) {
    float ss = 0.f;
    UNR for (int bj = 0; bj < 2; ++bj) UNR for (int n = 0; n < 2; ++n) UNR for (int e = 0; e < 4; ++e) ss += acc[ai][bj][m][n][e] * acc[ai][bj][m][n][e];
    ssq[ai][m] = ss;
  }
  UNR for (int ai = 0; ai < 2; ++ai) UNR for (int m = 0; m < 4; ++m) ssq[ai][m] += shx(ssq[ai][m], 16);
  UNR for (int ai = 0; ai < 2; ++ai) UNR for (int m = 0; m < 4; ++m) ssq[ai][m] += shx(ssq[ai][m], 32);
  UNR for (int ai = 0; ai < 2; ++ai) UNR for (int m = 0; m < 4; ++m) {
    const int t = tq0 + 128 * ai + 16 * m + fr;
    const float rstd = scale / sqrtf(ssq[ai][m] * (1.f / 64.f) + 1e-6f);
    const unsigned off = (unsigned)(t * pitch + 8 * fq);
    const int pos = fq < 2 ? (t >> 6) : (t & 63);
    f32x4 v0[2], v1[2];
    UNR for (int n = 0; n < 2; ++n) {
      v0[n] = acc[ai][0][m][n] * rstd * g0[n];
      v1[n] = acc[ai][1][m][n] * rstd * g1[n];
      if (rope) {
        UNR for (int e = 0; e < 4; ++e) {
          const float rev = (float)pos * inv[n][e];
          const float cs = __builtin_amdgcn_cosf(rev), sn = __builtin_amdgcn_sinf(rev);
          const float x1 = v0[n][e], x2 = v1[n][e];
          v0[n][e] = x1 * cs - x2 * sn; v1[n][e] = x1 * sn + x2 * cs;
        }
      }
    }
    u32x4 w0 = {pk2(v0[0][0], v0[0][1]), pk2(v0[0][2], v0[0][3]), pk2(v0[1][0], v0[1][1]), pk2(v0[1][2], v0[1][3])};
    u32x4 w1 = {pk2(v1[0][0], v1[0][1]), pk2(v1[0][2], v1[0][3]), pk2(v1[1][0], v1[1][1]), pk2(v1[1][2], v1[1][3])};
    *(u32x4*)(dst + off) = w0;
    *(u32x4*)(dst + off + 32) = w1;
    asm volatile("" ::: "memory");
  }
}
DI void epi2_gate_tok(AccRef acc, bf16_t* dst, int pitch, int fr, int fq) {
  UNR for (int ai = 0; ai < 2; ++ai) UNR for (int m = 0; m < 4; ++m) {
    const unsigned off = (unsigned)((128 * ai + 16 * m + fr) * pitch + 8 * fq);
    UNR for (int bj = 0; bj < 2; ++bj) {
      const f32x4 a = acc[ai][bj][m][0], c = acc[ai][bj][m][1];
      u32x4 w = {pk2(silu(a[0]), silu(a[1])), pk2(silu(a[2]), silu(a[3])), pk2(silu(c[0]), silu(c[1])), pk2(silu(c[2]), silu(c[3]))};
      *(u32x4*)(dst + off + 32 * bj) = w;
    }
    asm volatile("" ::: "memory");
  }
}
DI void epi2_S(AccRef acc, bf16_t* dst, unsigned chmul, bool dosilu, bool qperm, int wr, int wc, int fr, int fq) {
  UNR for (int ai = 0; ai < 2; ++ai) UNR for (int m = 0; m < 4; ++m) {
    const int ch = 64 * (2 * wr + (m >> 1)) + 32 * ai + 16 * (m & 1) + fr;
    const unsigned off = (unsigned)ch * chmul + (unsigned)(32 * wc);
    UNR for (int bj = 0; bj < 2; ++bj) {
      f32x4 a = acc[ai][bj][m][0], c = acc[ai][bj][m][1];
      if (dosilu) { UNR for (int e = 0; e < 4; ++e) { a[e] = silu(a[e]); c[e] = silu(c[e]); } }
      const u32x2 wa = {pk2(a[0], a[1]), pk2(a[2], a[3])}, wc2 = {pk2(c[0], c[1]), pk2(c[2], c[3])};
      if (qperm) {
        const unsigned g16 = 128 * bj + 16 * (fq >> 1);
        const int q0 = 2 * (fq & 1), q1 = q0 + 1;
        *(u32x2*)(dst + off + g16 + 4 * (((q0 & 1) << 1) | (q0 >> 1))) = wa;
        *(u32x2*)(dst + off + g16 + 4 * (((q1 & 1) << 1) | (q1 >> 1))) = wc2;
      } else {
        u32x4 w = {wa[0], wa[1], wc2[0], wc2[1]};
        *(u32x4*)(dst + off + 128 * bj + 8 * fq) = w;
      }
    }
    asm volatile("" ::: "memory");
  }
}
struct EpiIn {
  static constexpr bool PERM = true, AFTER_DRAIN = false;
  bf16_t* PB; const float* gq; const float* gk; int odd;
  DI bool normal(const pg8::Unit& u) const { const int n0 = u.pn * 256; return odd ? (n0 >= 2048 && n0 < 3072) : ((n0 >= 1024 && n0 < 3072) || n0 >= 3584); }
  DI void operator()(AccRef acc, const pg8::Unit& u, int wr, int wc, int fr_, int fq_) const {
    int fr = fr_, fq = fq_; asm volatile("" : "+v"(fr), "+v"(fq));
    const int n0 = u.pn * 256, cb = n0 + 64 * wc, b = u.pm / 17, tmi = u.pm % 17; const bool isctx = tmi == 16;
    const int tq0 = tmi * 256 + 64 * wr; const size_t row0 = (size_t)u.pm * 256 + 64 * wr;
    if (normal(u)) {
      const int t0 = tmi * 256; bf16_t* dst; unsigned chmul = (unsigned)(8 * TB); bool sl = false, qp = odd != 0;
      if (!odd) {
        if (n0 < 1536) { dst = PB + 2 * SEG + ((size_t)b * 512 + (n0 - 1024)) * TB + t0; chmul = (unsigned)TB; qp = true; }
        else if (n0 < 3072) dst = PB + 3 * SEG + ((size_t)(n0 - 1536) * 8 + b) * TB + t0;
        else { dst = PB + 7 * SEG + ((size_t)(n0 - 3584) * 8 + b) * TB + t0; sl = true; }
      } else { dst = PB + 4 * SEG + ((size_t)b * 1024 + (n0 - 2048)) * TB + t0; chmul = (unsigned)TB; }
      epi2_S(acc, dst, chmul, sl, qp, wr, wc, fr, fq);
      return;
    }
    if (n0 >= 3072) {
      const int pitch = odd ? 1024 : 512;
      epi2_gate_tok(acc, PB + 6 * SEG + row0 * pitch + (cb - 3072), pitch, fr, fq);
      return;
    }
    {
      bf16_t* dst; int pitch; const float* g; float scale; bool rope = false;
      if (!odd) {
        pitch = 64;
        if (cb < 512) { dst = PB + ((size_t)(b * 8 + (cb >> 6)) * TB) * 64; g = gq; scale = LOG2E * 0.125f; }
        else { dst = PB + SEG + ((size_t)(b * 8 + ((cb - 512) >> 6)) * TB) * 64; g = gk; scale = 1.f; }
      } else {
        pitch = 128; rope = !isctx;
        if (cb < 1024) { dst = PB + ((size_t)(b * 8 + (cb >> 7)) * TB) * 128 + ((cb >> 6) & 1) * 64; g = gq; scale = LOG2E * 0.125f; }
        else { const int c2 = cb - 1024; dst = PB + 2 * SEG + ((size_t)(b * 8 + (c2 >> 7)) * TB) * 128 + ((c2 >> 6) & 1) * 64; g = gk; scale = 1.f; }
      }
      epi2_qk(acc, dst, pitch, g, scale, rope, tq0, fr, fq);
    }
  }
};
struct EpiOut {
  static constexpr bool PERM = true, AFTER_DRAIN = false;
  const float* x_in; const float* xc_in; float* out; float* xc; const float* mod; int l;
  DI bool normal(const pg8::Unit&) const { return false; }
  DI void operator()(AccRef acc, const pg8::Unit& u, int wr, int wc, int fr, int fq) const {
    const int cb = u.pn * 256 + 64 * wc, b = u.pm / 17, tmi = u.pm % 17; const bool isctx = tmi == 16;
    if (isctx && l == 3) return;
    const float* gate = mod + (size_t)(l * 9 + (isctx ? 8 : b)) * 3072 + 2048;
    const float* src; float* dst;
    if (isctx) { src = xc_in + ((size_t)b * NCTX + 64 * wr) * 1024; dst = xc + ((size_t)b * NCTX + 64 * wr) * 1024; }
    else { const size_t o = ((size_t)b * SEQ + tmi * 256 + 64 * wr) * 1024; src = x_in + o; dst = out + o; }
    UNR for (int bj = 0; bj < 2; ++bj) {
      f32x4 xo[2][2][4], gg[2];
      UNR for (int n = 0; n < 2; ++n) {
        const int c = cb + 32 * bj + 8 * fq + 4 * n; gg[n] = *(const f32x4*)(gate + c);
        UNR for (int ai = 0; ai < 2; ++ai) UNR for (int m = 0; m < 4; ++m) xo[n][ai][m] = *(const f32x4*)(src + (size_t)(128 * ai + 16 * m + fr) * 1024 + c);
      }
      UNR for (int n = 0; n < 2; ++n) {
        const int c = cb + 32 * bj + 8 * fq + 4 * n;
        UNR for (int ai = 0; ai < 2; ++ai) UNR for (int m = 0; m < 4; ++m) *(f32x4*)(dst + (size_t)(128 * ai + 16 * m + fr) * 1024 + c) = xo[n][ai][m] + gg[n] * acc[ai][bj][m][n];
      }
      asm volatile("" ::: "memory");
    }
  }
};
struct LatentOrder : pg8::StaticOrder {
  __device__ bool next(int i, pg8::Unit& u) const { if (!pg8::StaticOrder::next(i, u)) return false; u.pm += u.pm >> 4; return true; }
};
template <int MODE>
DI void gemm_phase(const PW& p, int l, unsigned char* smem) {
  pg8::Gemm g; g.M = R; g.K = 1024;
  pg8::StaticOrder S;
  PG8_LAS unsigned char* lds = (PG8_LAS unsigned char*)smem;
  if (MODE == 2) {
    g.A = (const bf16_t*)(p.ws + OFF_Y); g.Bt = (const bf16_t*)(p.ws + OFF_WOUT) + (size_t)l * 1024 * 1024; g.N = 1024;
    S.init(R, 1024, gridDim.x, lbid());
    EpiOut E; E.x_in = l == 0 ? p.x : p.out; E.xc_in = l == 0 ? p.ctx : (const float*)(p.ws + OFF_XC); E.out = p.out; E.xc = (float*)(p.ws + OFF_XC); E.mod = (const float*)(p.ws + OFF_MOD); E.l = l;
    if (l == 3) { LatentOrder S3; S3.init(128 * 256, 1024, gridDim.x, lbid()); pg8::gemm_phase<EpiOut, LatentOrder, true, true>(lds, g, S3, E, LTID(p)); }
    else pg8::gemm_phase<EpiOut, pg8::StaticOrder, true, true>(lds, g, S, E, LTID(p));
  } else {
    g.A = (const bf16_t*)(p.ws + OFF_HN); g.Bt = (const bf16_t*)(p.ws + OFF_WIN) + (size_t)l * 4096 * 1024; g.N = 4096;
    S.init(R, 4096, gridDim.x, lbid());
    EpiIn E; E.PB = (bf16_t*)(p.ws + OFF_PB); E.gq = p.q_norm_g + l * 64; E.gk = p.k_norm_g + l * 64; E.odd = MODE;
    pg8::gemm_phase<EpiIn, pg8::StaticOrder, true, true>(lds, g, S, E, LTID(p));
  }
  __syncthreads();
}

DI void na_unit(const PW& p, int e, int b, int hd, int tq0, bool ctxq, float negM, int r, int h) {
  const bf16_t* PB = (const bf16_t*)(p.ws + OFF_PB);
  const bf16_t* Q = PB + ((size_t)(b * 8 + hd) * TB) * 64;
  const bf16_t* K = PB + SEG + ((size_t)(b * 8 + hd) * TB) * 64;
  const bf16_t* VT = PB + 2 * SEG + ((size_t)(b * 8 + hd) * 64) * TB;
  const int tq = tq0 + r;
  f32x16 O[2]; O[0] = splat16(0.f); O[1] = splat16(0.f);
  float lsum = 0.f;
  const int qrow = tq0 >> 6, qcol = tq & 63;
  const int rs = min(max(qrow - 4, 0), 56), cs = min(max(qcol - 8, 0), 48);
  const float* rpb = p.na_rpb + (size_t)(e * 8 + hd) * 15 * 31;
  constexpr int NB = 2; const int ngrp = ctxq ? 8 / NB : 24 / NB;
  _Pragma("unroll 1") for (int g = 0; g < ngrp; ++g) {
    const bool local = !ctxq && g < 16 / NB;
    bf16x8 kf[NB][4], vf[NB][4], qf[4];
    UNR for (int ks = 0; ks < 4; ++ks) qf[ks] = *(const bf16x8*)(Q + (size_t)tq * 64 + ks * 16 + h * 8);
    UNR for (int u = 0; u < NB; ++u) {
      const int it = g * NB + u;
      const int kb = local ? (rs + (it >> 1)) * 64 + (it & 1) * 32 : SEQ + (ctxq ? it : it - 16) * 32;
      UNR for (int ks = 0; ks < 4; ++ks) kf[u][ks] = *(const bf16x8*)(K + (size_t)(kb + r) * 64 + ks * 16 + h * 8);
      UNR for (int dvt = 0; dvt < 2; ++dvt) UNR for (int s2 = 0; s2 < 2; ++s2) vf[u][dvt * 2 + s2] = *(const bf16x8*)(VT + (size_t)(dvt * 32 + r) * TB + kb + s2 * 16 + 8 * h);
    }
    asm volatile("" ::: "memory");
    UNR for (int u = 0; u < NB; ++u) {
      const int it = g * NB + u;
      const int krow = rs + (it >> 1), ct = it & 1;
      f32x16 s = splat16(negM);
      UNR for (int ks = 0; ks < 4; ++ks) s = MFMA32(kf[u][ks], qf[ks], s);
      if (local) {
        const float* rp = rpb + (krow - qrow + 7) * 31;
        UNR for (int i = 0; i < 16; ++i) {
          const int kcol = ct * 32 + crow(i, h); const bool valid = kcol >= cs && kcol < cs + 16;
          const int dc = min(max(kcol - qcol + 15, 0), 30);
          const float pv = __builtin_amdgcn_exp2f(s[i] + rp[dc] * LOG2E);
          s[i] = valid ? pv : 0.f;
        }
      } else {
        UNR for (int i = 0; i < 16; ++i) s[i] = __builtin_amdgcn_exp2f(s[i]);
      }
      UNR for (int i = 0; i < 16; ++i) lsum += s[i];
      bf16x8 pf[2]; pf[0] = pack8(s, 0); pf[1] = pack8(s, 8);
      UNR for (int dvt = 0; dvt < 2; ++dvt) UNR for (int s2 = 0; s2 < 2; ++s2) O[dvt] = MFMA32(vf[u][dvt * 2 + s2], pf[s2], O[dvt]);
      asm volatile("" ::: "memory");
    }
  }
  lsum += shx(lsum, 32);
  const float inv = 1.f / lsum;
  const size_t row = (size_t)b * TB + tq;
  const bf16_t* G = PB + 6 * SEG + row * 512 + hd * 64;
  bf16_t* Y = (bf16_t*)(p.ws + OFF_Y) + row * 1024 + hd * 64;
  UNR for (int dvt = 0; dvt < 2; ++dvt) UNR for (int gq = 0; gq < 4; ++gq) {
    const int dv = dvt * 32 + 8 * gq + 4 * h;
    const u32x2 gg = *(const u32x2*)(G + dv);
    u32x2 w = {pk2(O[dvt][4 * gq] * inv * bflo(gg[0]), O[dvt][4 * gq + 1] * inv * bfhi(gg[0])), pk2(O[dvt][4 * gq + 2] * inv * bflo(gg[1]), O[dvt][4 * gq + 3] * inv * bfhi(gg[1]))};
    *(u32x2*)(Y + dv) = w;
  }
}

DI void na_block(const PW& p, int e, int b, int hd, int r0, bool ctxq, float negM, unsigned char* smem) {
  const int tid = LTID(p), wid = __builtin_amdgcn_readfirstlane(tid >> 6), lane = tid & 63, r = lane & 31, h = lane >> 5;
  const bf16_t* PB = (const bf16_t*)(p.ws + OFF_PB);
  const bf16_t* Q = PB + ((size_t)(b * 8 + hd) * TB) * 64;
  const bf16_t* K = PB + SEG + ((size_t)(b * 8 + hd) * TB) * 64;
  const bf16_t* VT = PB + 2 * SEG + ((size_t)(b * 8 + hd) * 64) * TB;
  PG8_LAS unsigned char* lds = (PG8_LAS unsigned char*)smem;
  const int qrow = ctxq ? 0 : r0 + (wid >> 1);
  const int tq0 = ctxq ? SEQ + wid * 32 : qrow * 64 + (wid & 1) * 32;
  const int tq = tq0 + r, qcol = tq & 63;
  const int rsw = min(max(qrow - 4, 0), 56), cs = min(max(qcol - 8, 0), 48);
  const int kr_lo = min(max(r0 - 4, 0), 56), kr_hi = min(max(r0 - 1, 0), 56) + 7;
  const int nloc = ctxq ? 0 : (kr_hi - kr_lo + 2) >> 1, nch = nloc + 2;
  bf16x8 qf[4];
  UNR for (int ks = 0; ks < 4; ++ks) qf[ks] = *(const bf16x8*)(Q + (size_t)tq * 64 + ks * 16 + h * 8);
  f32x16 O[2]; O[0] = splat16(0.f); O[1] = splat16(0.f);
  float lsum = 0.f;
  const float* rpb = p.na_rpb + (size_t)(e * 8 + hd) * 15 * 31;
  unsigned offK[2], offV[2];
  UNR for (int j = 0; j < 2; ++j) {
    const int s = (wid * 2 + j) * 64 + lane;
    { const int row = s >> 3, c = (s & 7) ^ ((row >> 1) & 7); offK[j] = (unsigned)(row * 64 + c * 8) * 2u; }
    { const int row = s >> 4, c = (s & 15) ^ (row & 15); offV[j] = (unsigned)(row * TB + c * 8) * 2u; }
  }
#define NA_KB(ci) ((ci) < nloc ? (kr_lo + 2 * (ci)) * 64 : SEQ + ((ci) - nloc) * 128)
#define NA_STAGE(st, ci) do { const int kb_ = NA_KB(ci); const char* kp_ = (const char*)(K + (size_t)kb_ * 64); const char* vp_ = (const char*)(VT + kb_); \
    UNR for (int j = 0; j < 2; ++j) { __builtin_amdgcn_global_load_lds((const unsigned*)(kp_ + offK[j]), (PG8_LAS unsigned*)(lds + (st) * 32768 + (wid * 2 + j) * 1024), 16, 0, 0); \
                                      __builtin_amdgcn_global_load_lds((const unsigned*)(vp_ + offV[j]), (PG8_LAS unsigned*)(lds + (st) * 32768 + 16384 + (wid * 2 + j) * 1024), 16, 0, 0); } } while (0)
  float* btab = (float*)(smem + 65536);
  __syncthreads();
  if (!ctxq && tid < 465) btab[tid] = rpb[tid] * LOG2E;
  NA_STAGE(0, 0);
  asm volatile("s_waitcnt vmcnt(0)" ::: "memory");
  __syncthreads();
  for (int ci = 0; ci < nch; ++ci) {
    if (ci + 1 < nch) NA_STAGE((ci + 1) & 1, ci + 1);
    const unsigned char* Kl = smem + (ci & 1) * 32768; const unsigned char* Vl = Kl + 16384;
    const bool local = ci < nloc;
    _Pragma("unroll 2") for (int sub = 0; sub < 4; ++sub) {
      const int krow = kr_lo + 2 * ci + (sub >> 1), ct = sub & 1;
      if (local && (krow < rsw || krow >= rsw + 8)) continue;
      f32x16 s = splat16(negM);
      const int kr_ = sub * 32 + r;
      UNR for (int ks = 0; ks < 4; ++ks) { const bf16x8 kf = *(const bf16x8*)(Kl + kr_ * 128 + (((ks * 2 + h) ^ ((kr_ >> 1) & 7)) << 4)); s = MFMA32(kf, qf[ks], s); }
      if (local) {
        const float* rp = btab + (krow - qrow + 7) * 31;
        UNR for (int i = 0; i < 16; ++i) {
          const int kcol = ct * 32 + crow(i, h); const bool valid = kcol >= cs && kcol < cs + 16;
          const int dc = min(max(kcol - qcol + 15, 0), 30);
          const float pv = __builtin_amdgcn_exp2f(s[i] + rp[dc]);
          s[i] = valid ? pv : 0.f;
        }
      } else {
        UNR for (int i = 0; i < 16; ++i) s[i] = __builtin_amdgcn_exp2f(s[i]);
      }
      UNR for (int i = 0; i < 16; ++i) lsum += s[i];
      bf16x8 pf[2]; pf[0] = pack8(s, 0); pf[1] = pack8(s, 8);
      UNR for (int dvt = 0; dvt < 2; ++dvt) UNR for (int s2 = 0; s2 < 2; ++s2) {
        const int vrow = dvt * 32 + r;
        const bf16x8 vf = *(const bf16x8*)(Vl + vrow * 256 + (((sub * 4 + s2 * 2 + h) ^ (vrow & 15)) << 4));
        O[dvt] = MFMA32(vf, pf[s2], O[dvt]);
      }
    }
    asm volatile("s_waitcnt vmcnt(0)" ::: "memory");
    __syncthreads();
  }
#undef NA_STAGE
#undef NA_KB
  lsum += shx(lsum, 32);
  const float inv = 1.f / lsum;
  const size_t row = (size_t)b * TB + tq;
  const bf16_t* G = PB + 6 * SEG + row * 512 + hd * 64;
  bf16_t* Y = (bf16_t*)(p.ws + OFF_Y) + row * 1024 + hd * 64;
  UNR for (int dvt = 0; dvt < 2; ++dvt) UNR for (int gq = 0; gq < 4; ++gq) {
    const int dv = dvt * 32 + 8 * gq + 4 * h;
    const u32x2 gg = *(const u32x2*)(G + dv);
    u32x2 w = {pk2(O[dvt][4 * gq] * inv * bflo(gg[0]), O[dvt][4 * gq + 1] * inv * bfhi(gg[0])), pk2(O[dvt][4 * gq + 2] * inv * bflo(gg[1]), O[dvt][4 * gq + 3] * inv * bfhi(gg[1]))};
    *(u32x2*)(Y + dv) = w;
  }
}

#ifndef HY_FENCE
#define HY_FENCE do { } while (0)
#endif
DI float sconv3(float um, float u0, float up, float w0, float w1, float w2, float cb) { return cb + w0 * um + w1 * u0 + w2 * up; }

DI void conv4(const bf16_t* rowp, int seq0, int len, int t0, float w0, float w1, float w2, float cb, float (&o)[4]) {
  const u32x2 m = *(const u32x2*)(rowp + seq0 + t0);
  const float um = t0 > 0 ? bf1(rowp[seq0 + t0 - 1]) : 0.f, up = t0 + 4 < len ? bf1(rowp[seq0 + t0 + 4]) : 0.f;
  const float u0 = bflo(m[0]), u1 = bfhi(m[0]), u2 = bflo(m[1]), u3 = bfhi(m[1]);
  o[0] = sconv3(um, u0, u1, w0, w1, w2, cb); o[1] = sconv3(u0, u1, u2, w0, w1, w2, cb); o[2] = sconv3(u1, u2, u3, w0, w1, w2, cb); o[3] = sconv3(u2, u3, up, w0, w1, w2, cb);
}

DI void hy_load_filter(const PW& p, int e, int o, int c, unsigned char* C0, unsigned char* C1) {
  const int tid = LTID(p);
  const bf16_t* grev = (const bf16_t*)(p.ws + OFF_GREV) + ((size_t)(e * 2 + o) * 512 + c) * 8192;
  UNR for (int i = 0; i < 2; ++i) { const int q = tid + i * 512; *(u32x4*)(C0 + q * 16) = *(const u32x4*)(grev + q * 8); }
  __syncthreads();
  const unsigned* c0d = (const unsigned*)C0; unsigned* c1d = (unsigned*)C1;
  UNR for (int i = 0; i < 8; ++i) { const int w = tid + i * 512; const unsigned a = c0d[w], bnx = w + 1 < 4096 ? c0d[w + 1] : 0u; c1d[w] = (a >> 16) | (bnx << 16); }
  __syncthreads();
}

DI u32x4 hy_loadA(const unsigned char* C0, const unsigned char* C1, int d, int off, int r, int h) {
  const int P0 = 4095 - 64 * d - off - r + 8 * h;
  const int odd = P0 & 1;
  const unsigned* ap = (const unsigned*)((odd ? C1 : C0) + (P0 - odd) * 2);
  u32x4 w = {ap[0], ap[1], ap[2], ap[3]};
  return w;
}
DI void hy_conv(f32x16 (&acc)[2][2], const unsigned char* Z, const unsigned char* ZR, const unsigned char* C0, const unsigned char* C1, int wid, int r, int h) {
  UNR for (int i = 0; i < 2; ++i) UNR for (int j = 0; j < 2; ++j) acc[i][j] = splat16(0.f);
  const int abase = wid * 8;
  const int bb = r & 7, ar = r >> 3;
  u32x4 F[6];
  int d = abase - 63;
  UNR for (int k = 0; k < 6; ++k) F[k] = hy_loadA(C0, C1, d, 32 - 16 * k, r, h);
  for (;;) {
    UNR for (int nt = 0; nt < 2; ++nt) {
      const int ap_ = abase + 4 * nt - d + ar; const bool valid = (unsigned)ap_ < 64u;
      const unsigned char* zp = valid ? Z + (ap_ * 8 + bb) * 144 + h * 16 : ZR + h * 16;
      UNR for (int ks = 0; ks < 4; ++ks) {
        const bf16x8 zf = *(const bf16x8*)(zp + ks * 32);
        acc[0][nt] = MFMA32(__builtin_bit_cast(bf16x8, F[2 + ks]), zf, acc[0][nt]);
        acc[1][nt] = MFMA32(__builtin_bit_cast(bf16x8, F[ks]), zf, acc[1][nt]);
      }
    }
    if (d == abase + 7) break;
    ++d;
    F[4] = F[0]; F[5] = F[1];
    UNR for (int k = 0; k < 4; ++k) F[k] = hy_loadA(C0, C1, d, 32 - 16 * k, r, h);
  }
}

DI void hyena_unit(const PW& p, int e, int c, unsigned char* smem) {
  const int tid = LTID(p), wid = __builtin_amdgcn_readfirstlane(tid >> 6), lane = tid & 63, r = lane & 31, h = lane >> 5;
  unsigned char* Z = smem; unsigned char* C0 = smem + 73728; unsigned char* C1 = C0 + 16384 + 64; unsigned char* ZR = smem + 106624;
  if (tid < 32) ((unsigned*)ZR)[tid] = 0u;
  const bf16_t* PB = (const bf16_t*)(p.ws + OFF_PB);
  const bf16_t* UT = PB + 3 * SEG;
  const bf16_t* GHT = PB + 7 * SEG;
  bf16_t* Y = (bf16_t*)(p.ws + OFF_Y);
  float cw[3][3], cbias[3];
  UNR for (int s = 0; s < 3; ++s) { UNR for (int j = 0; j < 3; ++j) cw[s][j] = p.hy_conv_w[(e * 3 + j) * 1536 + s * 512 + c]; cbias[s] = p.hy_conv_b[e * 1536 + s * 512 + c]; }
  __syncthreads();
  hy_load_filter(p, e, 0, c, C0, C1);
  _Pragma("unroll 4") for (int i = 0; i < 8; ++i) {
    const int cid = tid + i * 512, b = cid >> 9, t0 = (cid & 511) * 8;
    const bf16_t* rowp = UT + ((size_t)c * 8 + b) * TB;
    float o0[4], o1[4];
    conv4(rowp, 0, SEQ, t0, cw[0][0], cw[0][1], cw[0][2], cbias[0], o0);
    conv4(rowp, 0, SEQ, t0 + 4, cw[0][0], cw[0][1], cw[0][2], cbias[0], o1);
    u32x4 w = {pk2(o0[0], o0[1]), pk2(o0[2], o0[3]), pk2(o1[0], o1[1]), pk2(o1[2], o1[3])};
    *(u32x4*)(Z + ((t0 >> 6) * 8 + b) * 144 + (t0 & 63) * 2) = w;
  }
  __syncthreads();
  f32x16 acc[2][2];
#if DUP & 512
  hy_conv(acc, Z, ZR, C0, C1, wid, r, h);
  UNR for (int i_ = 0; i_ < 2; ++i_) UNR for (int j_ = 0; j_ < 2; ++j_) asm volatile("" :: "v"(acc[i_][j_]));
#endif
  hy_conv(acc, Z, ZR, C0, C1, wid, r, h);
  __syncthreads();
  {
    const int bb = r & 7;
    UNR for (int nt = 0; nt < 2; ++nt) {
      const int a = wid * 8 + 4 * nt + (r >> 3);
      const bf16_t* rowp = UT + ((size_t)(512 + c) * 8 + bb) * TB;
      UNR for (int mt = 0; mt < 2; ++mt) UNR for (int gq = 0; gq < 4; ++gq) {
        const int i0 = 32 * mt + 8 * gq + 4 * h; float x1[4];
        conv4(rowp, 0, SEQ, 64 * a + i0, cw[1][0], cw[1][1], cw[1][2], cbias[1], x1);
        u32x2 w = {pk2(x1[0] * acc[mt][nt][4 * gq], x1[1] * acc[mt][nt][4 * gq + 1]), pk2(x1[2] * acc[mt][nt][4 * gq + 2], x1[3] * acc[mt][nt][4 * gq + 3])};
        *(u32x2*)(Z + (a * 8 + bb) * 144 + i0 * 2) = w;
        HY_FENCE;
      }
    }
  }
  hy_load_filter(p, e, 1, c, C0, C1);
#if DUP & 512
  hy_conv(acc, Z, ZR, C0, C1, wid, r, h);
  UNR for (int i_ = 0; i_ < 2; ++i_) UNR for (int j_ = 0; j_ < 2; ++j_) asm volatile("" :: "v"(acc[i_][j_]));
#endif
  hy_conv(acc, Z, ZR, C0, C1, wid, r, h);
  __syncthreads();
  {
    const int bb = r & 7;
    UNR for (int nt = 0; nt < 2; ++nt) {
      const int a = wid * 8 + 4 * nt + (r >> 3);
      const bf16_t* rowp = UT + ((size_t)(1024 + c) * 8 + bb) * TB;
      const bf16_t* gp = GHT + ((size_t)c * 8 + bb) * TB;
      UNR for (int mt = 0; mt < 2; ++mt) UNR for (int gq = 0; gq < 4; ++gq) {
        const int i0 = 32 * mt + 8 * gq + 4 * h; float x2[4];
        conv4(rowp, 0, SEQ, 64 * a + i0, cw[2][0], cw[2][1], cw[2][2], cbias[2], x2);
        const u32x2 gg = *(const u32x2*)(gp + 64 * a + i0);
        u32x2 w = {pk2(x2[0] * acc[mt][nt][4 * gq] * bflo(gg[0]), x2[1] * acc[mt][nt][4 * gq + 1] * bfhi(gg[0])),
                   pk2(x2[2] * acc[mt][nt][4 * gq + 2] * bflo(gg[1]), x2[3] * acc[mt][nt][4 * gq + 3] * bfhi(gg[1]))};
        *(u32x2*)(Z + (a * 8 + bb) * 144 + i0 * 2) = w;
        HY_FENCE;
      }
    }
  }
  __syncthreads();
  {
    bf16_t* OT = (bf16_t*)(p.ws + OFF_HN);
    _Pragma("unroll 2") for (int i = 0; i < 8; ++i) {
      const int cid = tid + i * 512, b = cid >> 9, t0 = (cid & 511) * 8;
      *(u32x4*)(OT + ((size_t)c * 8 + b) * TB + t0) = *(const u32x4*)(Z + ((t0 >> 6) * 8 + b) * 144 + (t0 & 63) * 2);
    }
  }
  __syncthreads();
  {
    float* zc = (float*)smem;
    float* gl = zc + 2048;
    const int bb = tid >> 6, tq = tid & 63, t0 = 4 * tq;
    const bf16_t* r0 = UT + ((size_t)c * 8 + bb) * TB;
    const bf16_t* r1 = UT + ((size_t)(512 + c) * 8 + bb) * TB;
    const bf16_t* r2 = UT + ((size_t)(1024 + c) * 8 + bb) * TB;
    const bf16_t* gp = GHT + ((size_t)c * 8 + bb) * TB + SEQ;
    bf16_t* OTc = (bf16_t*)(p.ws + OFF_HN) + ((size_t)c * 8 + bb) * TB + SEQ;
    { float v4[4]; conv4(r0, SEQ, NCTX, t0, cw[0][0], cw[0][1], cw[0][2], cbias[0], v4);
      f32x4 vv = {v4[0], v4[1], v4[2], v4[3]}; *(f32x4*)(zc + bb * 256 + t0) = vv; }
    for (int o = 0; o < 2; ++o) {
      const float* gc = (const float*)(p.ws + OFF_GC) + ((size_t)(e * 2 + o) * 512 + c) * 512;
      gl[tid] = gc[tid];
      __syncthreads();
      f32x4 a4 = {0.f, 0.f, 0.f, 0.f};
      for (int s0 = 0; s0 < 256; s0 += 4) {
        const f32x4 zv = *(const f32x4*)(zc + bb * 256 + s0);
        const int base4 = 256 + t0 - s0;
        const f32x4 glo = *(const f32x4*)(gl + base4 - 4), ghi = *(const f32x4*)(gl + base4);
        const float G[8] = {glo[0], glo[1], glo[2], glo[3], ghi[0], ghi[1], ghi[2], ghi[3]};
        UNR for (int j = 0; j < 4; ++j) UNR for (int k = 0; k < 4; ++k) a4[j] += G[4 + j - k] * zv[k];
      }
      __syncthreads();
      float xv[4];
      conv4(o == 0 ? r1 : r2, SEQ, NCTX, t0, cw[1 + o][0], cw[1 + o][1], cw[1 + o][2], cbias[1 + o], xv);
      if (o == 0) { f32x4 zn = {xv[0] * a4[0], xv[1] * a4[1], xv[2] * a4[2], xv[3] * a4[3]}; *(f32x4*)(zc + bb * 256 + t0) = zn; }
      else {
        const u32x2 gg = *(const u32x2*)(gp + t0);
        u32x2 w = {pk2(xv[0] * a4[0] * bflo(gg[0]), xv[1] * a4[1] * bfhi(gg[0])), pk2(xv[2] * a4[2] * bflo(gg[1]), xv[3] * a4[3] * bfhi(gg[1]))};
        *(u32x2*)(OTc + t0) = w;
      }
      __syncthreads();
    }
  }
}

DI void hy_transpose_phase(const PW& p, int l, unsigned char* smem) {
  const int tid = LTID(p);
  const bf16_t* OT = (const bf16_t*)(p.ws + OFF_HN);
  bf16_t* Y = (bf16_t*)(p.ws + OFF_Y);
  unsigned* T = (unsigned*)smem;
  const int tb_per_b = l == 3 ? 64 : 68;
  const int ntile = 8 * tb_per_b * 8;
  const int cl = tid >> 3, part = tid & 7;
#define HT_SRC(tile) (OT + ((size_t)(((tile) & 7) * 64 + cl) * 8 + ((tile) >> 3) / tb_per_b) * TB + (((tile) >> 3) % tb_per_b) * 64 + part * 8)
  int tile = lbid();
  u32x4 v = {0u, 0u, 0u, 0u};
  if (tile < ntile) v = *(const u32x4*)HT_SRC(tile);
  for (; tile < ntile; tile += gridDim.x) {
    const int cbk = tile & 7, tb = tile >> 3, b = tb / tb_per_b, t0 = (tb % tb_per_b) * 64;
    UNR for (int j = 0; j < 4; ++j) T[cl * 33 + part * 4 + j] = v[j];
    const int nxt = tile + gridDim.x;
    if (nxt < ntile) v = *(const u32x4*)HT_SRC(nxt);
    __syncthreads();
    { const int tl = tid >> 3;
      const bf16_t* Tb = (const bf16_t*)T;
      unsigned short e[8];
      UNR for (int j = 0; j < 8; ++j) e[j] = Tb[(part * 8 + j) * 66 + tl];
      u32x4 w = {(unsigned)e[0] | ((unsigned)e[1] << 16), (unsigned)e[2] | ((unsigned)e[3] << 16), (unsigned)e[4] | ((unsigned)e[5] << 16), (unsigned)e[6] | ((unsigned)e[7] << 16)};
      *(u32x4*)(Y + ((size_t)b * TB + t0 + tl) * 1024 + 512 + cbk * 64 + part * 8) = w; }
    __syncthreads();
  }
#undef HT_SRC
}

DI void mixer_even(const PW& p, int l, unsigned char* smem, int what = 3) {
  const int e = l >> 1;
  if (what & 1) for (int c = lbid(); c < 512; c += gridDim.x) hyena_unit(p, e, c, smem);
  if (!(what & 2)) return;
  const float negM = ((const float*)(p.ws + OFF_MISC))[l];
  const int G = gridDim.x, bid = lbid();
  if ((G & 7) == 0) {
    const int hd = bid & 7, slot = bid >> 3, S = G >> 3;
    for (int i = slot; i < 128; i += S) na_block(p, e, i >> 4, hd, (i & 15) * 4, false, negM, smem);
    for (int i = slot; i < 8; i += S) na_block(p, e, i, hd, 0, true, negM, smem);
  } else {
    for (int u = bid; u < 1024 + 64; u += G) {
      if (u < 1024) { const int rg = u & 15, hd = (u >> 4) & 7, b = u >> 7; na_block(p, e, b, hd, rg * 4, false, negM, smem); }
      else { const int v = u - 1024, hd = v & 7, b = v >> 3; na_block(p, e, b, hd, 0, true, negM, smem); }
    }
  }
}

DI void diff_unit(const PW& p, int l, int b, int hd, int q0, int kbeg, int kend, float negM, float lam, float lam_init, unsigned char* smem) {
  const int tid = LTID(p), wid = __builtin_amdgcn_readfirstlane(tid >> 6), lane = tid & 63, r = lane & 31, h = lane >> 5, m = wid & 1, qg = wid >> 1;
  const bf16_t* PB = (const bf16_t*)(p.ws + OFF_PB);
  const bf16_t* Q = PB + ((size_t)(b * 8 + hd) * TB) * 128;
  const bf16_t* K = PB + 2 * SEG + ((size_t)(b * 8 + hd) * TB) * 128;
  const bf16_t* VT = PB + 4 * SEG + ((size_t)(b * 8 + hd) * 128) * TB;
  const int tq = q0 + qg * 32 + r;
  bf16x8 qf[4];
  UNR for (int ks = 0; ks < 4; ++ks) qf[ks] = *(const bf16x8*)(Q + (size_t)tq * 128 + m * 64 + ks * 16 + h * 8);
  f32x16 O[4];
  UNR for (int d = 0; d < 4; ++d) O[d] = splat16(0.f);
  float lsum = 0.f;
  const int kkey0 = tid >> 4, kpart = tid & 15;
  const int vdv0 = tid >> 3, vpart = tid & 7;
  u32x4 rk[2], rv[2];
  const int nt = (kend - kbeg) >> 6;
  UNR for (int i = 0; i < 2; ++i) { rk[i] = *(const u32x4*)(K + (size_t)(kbeg + kkey0 + 32 * i) * 128 + kpart * 8); rv[i] = *(const u32x4*)(VT + (size_t)(vdv0 + 64 * i) * TB + kbeg + vpart * 8); }
  UNR for (int i = 0; i < 2; ++i) { *(u32x4*)(smem + (kkey0 + 32 * i) * 272 + kpart * 16) = rk[i]; *(u32x4*)(smem + 17408 + (vdv0 + 64 * i) * 144 + vpart * 16) = rv[i]; }
  __syncthreads();
  for (int it = 0; it < nt; ++it) {
    const unsigned char* Kl = smem + (it & 1) * 35840; const unsigned char* Vl = Kl + 17408;
    if (it + 1 < nt) {
      const int k0 = kbeg + (it + 1) * 64;
      UNR for (int i = 0; i < 2; ++i) { rk[i] = *(const u32x4*)(K + (size_t)(k0 + kkey0 + 32 * i) * 128 + kpart * 8); rv[i] = *(const u32x4*)(VT + (size_t)(vdv0 + 64 * i) * TB + k0 + vpart * 8); }
    }
    {
      f32x16 s0 = splat16(negM), s1 = splat16(negM);
      __builtin_amdgcn_s_setprio(1);
      UNR for (int ks = 0; ks < 4; ++ks) { const bf16x8 kf = *(const bf16x8*)(Kl + r * 272 + m * 128 + ks * 32 + h * 16); s0 = MFMA32(kf, qf[ks], s0); }
      UNR for (int ks = 0; ks < 4; ++ks) { const bf16x8 kf = *(const bf16x8*)(Kl + (32 + r) * 272 + m * 128 + ks * 32 + h * 16); s1 = MFMA32(kf, qf[ks], s1); }
      __builtin_amdgcn_s_setprio(0);
      UNR for (int i = 0; i < 16; ++i) { s0[i] = __builtin_amdgcn_exp2f(s0[i]); lsum += s0[i]; }
      bf16x8 pf0[2]; pf0[0] = pack8(s0, 0); pf0[1] = pack8(s0, 8);
      __builtin_amdgcn_sched_barrier(0);
      UNR for (int dvt = 0; dvt < 4; ++dvt) UNR for (int s2 = 0; s2 < 2; ++s2) {
        const bf16x8 vf = *(const bf16x8*)(Vl + (dvt * 32 + r) * 144 + (s2 * 16 + 8 * h) * 2);
        O[dvt] = MFMA32(vf, pf0[s2], O[dvt]);
      }
      UNR for (int i = 0; i < 16; ++i) { s1[i] = __builtin_amdgcn_exp2f(s1[i]); lsum += s1[i]; }
      bf16x8 pf1[2]; pf1[0] = pack8(s1, 0); pf1[1] = pack8(s1, 8);
      UNR for (int g = 0; g < 8; ++g) { __builtin_amdgcn_sched_group_barrier(0x008, 1, 0); __builtin_amdgcn_sched_group_barrier(0x002, 5, 0); }
      __builtin_amdgcn_sched_barrier(0);
      UNR for (int dvt = 0; dvt < 4; ++dvt) UNR for (int s2 = 0; s2 < 2; ++s2) {
        const bf16x8 vf = *(const bf16x8*)(Vl + (dvt * 32 + r) * 144 + (32 + s2 * 16 + 8 * h) * 2);
        O[dvt] = MFMA32(vf, pf1[s2], O[dvt]);
      }
    }
    if (it + 1 < nt) {
      unsigned char* nx = smem + ((it + 1) & 1) * 35840;
      UNR for (int i = 0; i < 2; ++i) { *(u32x4*)(nx + (kkey0 + 32 * i) * 272 + kpart * 16) = rk[i]; *(u32x4*)(nx + 17408 + (vdv0 + 64 * i) * 144 + vpart * 16) = rv[i]; }
    }
    __syncthreads();
  }
  lsum += shx(lsum, 32);
  float* X = (float*)smem + qg * 4096;
  if (m == 1) {
    const float sc = lam / lsum;
    UNR for (int d = 0; d < 4; ++d) UNR for (int i = 0; i < 16; ++i) X[(d * 16 + i) * 64 + lane] = O[d][i] * sc;
  }
  __syncthreads();
  if (m == 0) {
    const float i0 = 1.f / lsum;
    float ss = 0.f;
    UNR for (int d = 0; d < 4; ++d) UNR for (int i = 0; i < 16; ++i) { const float o = O[d][i] * i0 - X[(d * 16 + i) * 64 + lane]; O[d][i] = o; ss += o * o; }
    ss += shx(ss, 32);
    const float rstd = (1.0f / sqrtf(ss * (1.f / 128.f) + 1e-6f)) * (1.f - lam_init);
    const size_t row = (size_t)b * TB + tq;
    const bf16_t* G = PB + 6 * SEG + row * 1024 + hd * 128;
    bf16_t* Y = (bf16_t*)(p.ws + OFF_Y) + row * 1024 + hd * 128;
    const float* sg = p.subln_g + (l >> 1) * 128;
    UNR for (int d = 0; d < 4; ++d) UNR for (int gq = 0; gq < 4; ++gq) {
      const int dv = d * 32 + 8 * gq + 4 * h;
      const u32x2 gg = *(const u32x2*)(G + dv); const f32x4 s4 = *(const f32x4*)(sg + dv);
      u32x2 w = {pk2(O[d][4 * gq] * rstd * s4[0] * bflo(gg[0]), O[d][4 * gq + 1] * rstd * s4[1] * bfhi(gg[0])),
                 pk2(O[d][4 * gq + 2] * rstd * s4[2] * bflo(gg[1]), O[d][4 * gq + 3] * rstd * s4[3] * bfhi(gg[1]))};
      *(u32x2*)(Y + dv) = w;
    }
  }
  __syncthreads();
}

DI void mixer_odd(const PW& p, int l, unsigned char* smem) {
  const float* MISC = (const float*)(p.ws + OFF_MISC);
  const float negM = MISC[l], lam = MISC[4 + (l >> 1)], lam_init = MISC[6 + (l >> 1)];
  const int G = gridDim.x, bid = lbid();
  if ((G & 7) == 0) {
    const int hd = bid & 7, slot = bid >> 3, S = G >> 3;
    for (int i = slot; i < 256; i += S) diff_unit(p, l, i >> 5, hd, (i & 31) * 128, 0, TB, negM, lam, lam_init, smem);
    if (l < 3) for (int i = slot; i < 16; i += S) diff_unit(p, l, i >> 1, hd, SEQ + (i & 1) * 128, SEQ, TB, negM, lam, lam_init, smem);
  } else {
    const int nun = l < 3 ? 2048 + 128 : 2048;
    for (int u = bid; u < nun; u += G) {
      if (u < 2048) { const int qb = u & 31, hd = (u >> 5) & 7, b = u >> 8; diff_unit(p, l, b, hd, qb * 128, 0, TB, negM, lam, lam_init, smem); }
      else { const int v = u - 2048, qb = v & 1, hd = (v >> 1) & 7, b = v >> 4; diff_unit(p, l, b, hd, SEQ + qb * 128, SEQ, TB, negM, lam, lam_init, smem); }
    }
  }
}

#define XB_TMO      128
#define XB_XCNT(j)  (256  + 64 * (j))
#define XB_XSUB(j)  (1280 + 64 * (j))
#define XB_XGEN(j)  (2304 + 64 * (j))
#define XB_TOP      3328
#define XB_TOPGEN   3392
#define XCD_BAR_WORDS 3456
#define XB_SPIN_CAP (1u << 18)
#ifndef LAS
#define LAS __attribute__((address_space(3)))
#endif

__device__ __forceinline__ unsigned xb_ld(unsigned* p)              { return __hip_atomic_load(p, __ATOMIC_RELAXED, __HIP_MEMORY_SCOPE_AGENT); }
__device__ __forceinline__ unsigned xb_add(unsigned* p, unsigned v) { return __hip_atomic_fetch_add(p, v, __ATOMIC_RELAXED, __HIP_MEMORY_SCOPE_AGENT); }
__device__ __forceinline__ unsigned xb_xcc_id() { return (unsigned)__builtin_amdgcn_s_getreg((3 << 11) | 20) & 0xFu; }
#define XB_SPIN(cond, bar) do { unsigned _sp = 0; while (cond) { __builtin_amdgcn_s_sleep(1); \
    if ((++_sp & 255u) == 0u) { if (xb_ld(&(bar)[XB_TMO])) break; if (_sp > XB_SPIN_CAP) { atomicAdd(&(bar)[XB_TMO], 1u); break; } } } } while (0)

struct XcdBarrier {
    unsigned* bar; unsigned x;
    volatile LAS unsigned* st;
};

__device__ __forceinline__ XcdBarrier xcd_barrier_post(unsigned* bar, volatile LAS unsigned* st) {
    XcdBarrier b; b.bar = bar; b.x = xb_xcc_id(); b.st = st;
    if (threadIdx.x == 0) (void)xb_add(&bar[XB_XCNT(b.x)], 1u);
    return b;
}
__device__ __forceinline__ void xcd_barrier_complete(unsigned* bar, unsigned x, unsigned& nloc, unsigned& nx) {
    const unsigned G = gridDim.x * gridDim.y * gridDim.z;
    unsigned sum, cnt, mine, sp = 0u;
    for (;;) {
        sum = 0u; cnt = 0u; mine = 0u;
#pragma unroll
        for (unsigned j = 0; j < 16; ++j) { const unsigned c = xb_ld(&bar[XB_XCNT(j)]); sum += c; cnt += (c > 0u) ? 1u : 0u; mine = (j == x) ? c : mine; }
        if (sum == G) break;
        __builtin_amdgcn_s_sleep(1);
        if ((++sp & 255u) == 0u) { if (xb_ld(&bar[XB_TMO])) break; if (sp > XB_SPIN_CAP) { atomicAdd(&bar[XB_TMO], 1u); break; } }
    }
    nloc = mine > 0u ? mine : 1u; nx = cnt > 0u ? cnt : 1u;
}

__device__ __forceinline__ void xcd_barrier(const XcdBarrier& b) {
    asm volatile("s_waitcnt vmcnt(0)" ::: "memory");
    __syncthreads();
    if (threadIdx.x == 0) {
        unsigned* bar = b.bar;
        __builtin_amdgcn_s_waitcnt(0);
        unsigned nloc = b.st[0], nx = b.st[1];
        if (nloc == 0u) { xcd_barrier_complete(bar, b.x, nloc, nx); b.st[0] = nloc; b.st[1] = nx; }
        const unsigned old = xb_add(&bar[XB_XSUB(b.x)], 1u);
        const unsigned gen = old / nloc;
        if (old + 1u == (gen + 1u) * nloc) {
            __builtin_amdgcn_fence(__ATOMIC_RELEASE, "agent");
            asm volatile("s_waitcnt vmcnt(0)" ::: "memory");
            const unsigned og = xb_add(&bar[XB_TOP], 1u);
            const unsigned tg = og / nx;
            if (og + 1u == (tg + 1u) * nx) xb_add(&bar[XB_TOPGEN], 1u);
            else XB_SPIN(xb_ld(&bar[XB_TOPGEN]) == tg, bar);
            __builtin_amdgcn_fence(__ATOMIC_ACQUIRE, "agent");
            xb_add(&bar[XB_XGEN(b.x)], 1u);
            asm volatile("s_waitcnt vmcnt(0)" ::: "memory");
        } else {
            XB_SPIN(xb_ld(&bar[XB_XGEN(b.x)]) == gen, bar);
            __builtin_amdgcn_fence(__ATOMIC_ACQUIRE, "agent");
            asm volatile("s_waitcnt vmcnt(0)" ::: "memory");
        }
    }
    __syncthreads();
}

typedef const Params __attribute__((address_space(4))) KParams;
DI void load_params(PW& q, KParams* k) { q.x = k->x; q.c = k->c; q.ctx = k->ctx; q.c_ctx = k->c_ctx; q.norm_g = k->norm_g; q.w_mod = k->w_mod; q.b_mod = k->b_mod; q.w_in = k->w_in; q.w_out = k->w_out; q.q_norm_g = k->q_norm_g; q.k_norm_g = k->k_norm_g; q.na_rpb = k->na_rpb; q.hy_conv_w = k->hy_conv_w; q.hy_conv_b = k->hy_conv_b; q.f_w1 = k->f_w1; q.f_b1 = k->f_b1; q.f_freq = k->f_freq; q.f_w2 = k->f_w2; q.f_b2 = k->f_b2; q.f_w3 = k->f_w3; q.f_b3 = k->f_b3; q.hy_skip = k->hy_skip; q.lq1 = k->lq1; q.lk1 = k->lk1; q.lq2 = k->lq2; q.lk2 = k->lk2; q.subln_g = k->subln_g; q.out = k->out; q.ws = k->ws; }
#define LAUNDER() do { ll = l; asm volatile("" : "+s"(ll)); KParams* k_ = kp; asm volatile("" : "+s"(k_)); load_params(q, k_); int w_ = wid0; asm volatile("" : "+s"(w_)); q.wid0 = w_; } while (0)
__global__ void __launch_bounds__(512) mega(Params p) {
  __shared__ __attribute__((aligned(16))) unsigned char smem[131072];
  __shared__ __attribute__((aligned(16))) unsigned xb_st[4];
  cg::grid_group grid = cg::this_grid();
  if (threadIdx.x < 4) xb_st[threadIdx.x] = 0u;
  __syncthreads();
  KParams* kp = (KParams*)__builtin_amdgcn_kernarg_segment_ptr();
  const int wid0 = __builtin_amdgcn_readfirstlane((int)(threadIdx.x >> 6));
  PW q; int ll = 0;
  { int l = 0; LAUNDER(); }
  if (blockIdx.x == 0) for (int i = threadIdx.x; i < 4096; i += 512) ((unsigned*)(q.ws + OFF_BAR))[i] = 0u;
  phase0(q, smem);
#if DUP & 8
  { int l = 0; LAUNDER(); phase0(q, smem); }
#endif
  grid.sync();
  const XcdBarrier xbar = xcd_barrier_post((unsigned*)(q.ws + OFF_BAR), (volatile LAS unsigned*)xb_st);
  for (int l = 0; l < 4; ++l) {
    LAUNDER();
    if (l == 0) finalize_filters(q);
    norm_phase(q, ll);
#if DUP & 16
    LAUNDER(); norm_phase(q, ll);
#endif
    xcd_barrier(xbar);
    LAUNDER();
    if (ll & 1) gemm_phase<1>(q, ll, smem); else gemm_phase<0>(q, ll, smem);
#if DUP & 1
    LAUNDER();
    if (ll & 1) gemm_phase<1>(q, ll, smem); else gemm_phase<0>(q, ll, smem);
#endif
    xcd_barrier(xbar);
    LAUNDER();
    if (ll & 1) mixer_odd(q, ll, smem); else mixer_even(q, ll, smem);
#if DUP & 2
    LAUNDER();
    if (!(ll & 1)) mixer_even(q, ll, smem);
#endif
#if DUP & 128
    LAUNDER();
    if (!(ll & 1)) mixer_even(q, ll, smem, 1);
#endif
#if DUP & 256
    LAUNDER();
    if (!(ll & 1)) mixer_even(q, ll, smem, 2);
#endif
#if DUP & 4
    LAUNDER();
    if (ll & 1) mixer_odd(q, ll, smem);
#endif
    xcd_barrier(xbar);
    LAUNDER();
    if (!(ll & 1)) { hy_transpose_phase(q, ll, smem); xcd_barrier(xbar); LAUNDER(); }
    gemm_phase<2>(q, ll, smem);
#if DUP & 32
    xcd_barrier(xbar); xcd_barrier(xbar); xcd_barrier(xbar); xcd_barrier(xbar);
#endif
#if DUP & 64
    if (l == 0) { LAUNDER(); gemm_phase<2>(q, ll, smem); }
#endif
    if (l < 3) xcd_barrier(xbar);
  }
}

extern "C" void kernel_launch(void* const* d_in, const int* in_sizes, int n_in, void* d_out, int out_size,
                              void* d_ws, size_t ws_size, hipStream_t stream) {
  static int grid_blocks = 0;
  if (!grid_blocks) {
    int dev = 0, cus = 0, per_cu = 0;
    (void)hipGetDevice(&dev);
    (void)hipDeviceGetAttribute(&cus, hipDeviceAttributeMultiprocessorCount, dev);
    (void)hipOccupancyMaxActiveBlocksPerMultiprocessor(&per_cu, mega, 512, 0);
    if (per_cu > 1) per_cu = 1;
    grid_blocks = cus * per_cu;
  }
  if (ws_size < WS_NEED) { fprintf(stderr, "workspace too small: %zu < %zu\n", ws_size, (size_t)WS_NEED); return; }
  Params p{};
  const float** pp = (const float**)&p;
  for (int i = 0; i < 27; ++i) pp[i] = (const float*)d_in[i];
  p.out = (float*)d_out; p.ws = (unsigned char*)d_ws;
  void* args[] = {&p};
  hipError_t e = hipLaunchCooperativeKernel((void*)mega, dim3(grid_blocks), dim3(512), args, 0, stream);
  if (e != hipSuccess) fprintf(stderr, "coop launch failed: %s (grid %d)\n", hipGetErrorString(e), grid_blocks);
}
```

```cpp
#ifndef DUP
#define DUP 0
#endif
#include <hip/hip_runtime.h>
#include <hip/hip_cooperative_groups.h>
#include <cstdio>
namespace cg = cooperative_groups;

typedef unsigned short bf16_t;
typedef short bf16x8 __attribute__((ext_vector_type(8)));
typedef float f32x16 __attribute__((ext_vector_type(16)));
typedef float f32x4 __attribute__((ext_vector_type(4)));
typedef unsigned u32x4 __attribute__((ext_vector_type(4)));
typedef unsigned u32x2 __attribute__((ext_vector_type(2)));
typedef __bf16 bf16v2 __attribute__((ext_vector_type(2)));
#define DI __device__ __forceinline__
#define MFMA32(a, b, c) __builtin_amdgcn_mfma_f32_32x32x16_bf16((a), (b), (c), 0, 0, 0)
#define UNR _Pragma("unroll")

constexpr int R = 34816, TB = 4352, SEQ = 4096, NCTX = 256;
constexpr float LOG2E = 1.4426950408889634f;
constexpr size_t SEG = (size_t)R * 512;
constexpr size_t OFF_WIN = 0;
constexpr size_t OFF_WOUT = OFF_WIN + 4ull * 4096 * 1024 * 2;
constexpr size_t OFF_MOD = OFF_WOUT + 4ull * 1024 * 1024 * 2;
constexpr size_t OFF_HN = OFF_MOD + 4ull * 9 * 3072 * 4;
constexpr size_t OFF_PB = OFF_HN + (size_t)R * 1024 * 2;
constexpr size_t OFF_Y = OFF_PB + (size_t)R * 4096 * 2;
constexpr size_t OFF_XC = OFF_Y + (size_t)R * 1024 * 2;
constexpr size_t OFF_GREV = OFF_XC + 8ull * 256 * 1024 * 4;
constexpr size_t OFF_GC = OFF_GREV + 2ull * 2 * 512 * 8192 * 2;
constexpr size_t OFF_MISC = OFF_GC + 2ull * 2 * 512 * 512 * 4;
constexpr size_t OFF_BAR = OFF_MISC + 4096;
constexpr size_t WS_NEED = OFF_BAR + 16384;
constexpr size_t OFF_HRAW = OFF_PB;
constexpr size_t OFF_HRAWC = OFF_HRAW + 2ull * 2 * 2 * 512 * 4096 * 4;
constexpr size_t OFF_SSP = OFF_HRAWC + 2ull * 2 * 2 * 512 * 256 * 4;

struct Params {
  const float *x, *c, *ctx, *c_ctx, *norm_g, *w_mod, *b_mod, *w_in, *w_out, *q_norm_g, *k_norm_g, *na_rpb, *hy_conv_w, *hy_conv_b,
      *f_w1, *f_b1, *f_freq, *f_w2, *f_b2, *f_w3, *f_b3, *hy_skip, *lq1, *lk1, *lq2, *lk2, *subln_g;
  float* out;
  unsigned char* ws;
};
struct PW : Params { int wid0; };

DI unsigned pk2(float a, float b) { bf16v2 v = {(__bf16)a, (__bf16)b}; return __builtin_bit_cast(unsigned, v); }
DI float bflo(unsigned u) { return __uint_as_float(u << 16); }
DI float bfhi(unsigned u) { return __uint_as_float(u & 0xffff0000u); }
DI float bf1(bf16_t u) { return __uint_as_float((unsigned)u << 16); }
DI int crow(int reg, int h) { return (reg & 3) + 8 * (reg >> 2) + 4 * h; }
DI float silu(float x) { return x / (1.f + __expf(-x)); }
DI int lane_l() { int l = __builtin_amdgcn_mbcnt_hi(~0u, __builtin_amdgcn_mbcnt_lo(~0u, 0u)); asm volatile("" : "+v"(l)); return l; }
DI float shx(float v, int o) { return __int_as_float(__builtin_amdgcn_ds_bpermute((lane_l() ^ o) << 2, __float_as_int(v))); }
DI float wave_sum(float v) { UNR for (int o = 32; o > 0; o >>= 1) v += shx(v, o); return v; }
DI float wave_max(float v) { UNR for (int o = 32; o > 0; o >>= 1) v = fmaxf(v, shx(v, o)); return v; }
DI f32x16 splat16(float v) { f32x16 r; UNR for (int i = 0; i < 16; ++i) r[i] = v; return r; }
DI bf16x8 pack8(const f32x16& s, int o) {
  u32x4 w; w[0] = pk2(s[o], s[o + 1]); w[1] = pk2(s[o + 2], s[o + 3]); w[2] = pk2(s[o + 4], s[o + 5]); w[3] = pk2(s[o + 6], s[o + 7]);
  return __builtin_bit_cast(bf16x8, w);
}

#define LTID(p) (((p).wid0 << 6) | lane_l())
DI int lbid() { int b = blockIdx.x; asm volatile("" : "+s"(b)); return b; }
DI void transpose_jobs(const PW& p, float* tile) {
  const int tid = LTID(p);
  constexpr int J_TIN = 4 * 16 * 64, J_ALL = J_TIN + 4 * 16 * 16;
  const int kk = tid >> 4, n4 = (tid & 15) * 4, n = tid >> 3, kc = tid & 7;
#define TJ_SRC(j, pass) ((j) < J_TIN ? p.w_in + (size_t)((j) >> 10) * 1024 * 4096 + (size_t)((((j) >> 6) & 15) * 64 + (pass) * 32 + kk) * 4096 + ((j) & 63) * 64 + n4 \
                                     : p.w_out + (size_t)(((j) - J_TIN) >> 8) * 1024 * 1024 + (size_t)(((((j) - J_TIN) >> 4) & 15) * 64 + (pass) * 32 + kk) * 1024 + (((j) - J_TIN) & 15) * 64 + n4)
  int j = lbid();
  f32x4 v0 = {0.f, 0.f, 0.f, 0.f}, v1 = v0;
  if (j < J_ALL) { v0 = *(const f32x4*)TJ_SRC(j, 0); v1 = *(const f32x4*)TJ_SRC(j, 1); }
  for (; j < J_ALL; j += gridDim.x) {
    UNR for (int e = 0; e < 4; ++e) { tile[kk * 65 + n4 + e] = v0[e]; tile[(32 + kk) * 65 + n4 + e] = v1[e]; }
    const int jn = j + gridDim.x;
    if (jn < J_ALL) { v0 = *(const f32x4*)TJ_SRC(jn, 0); v1 = *(const f32x4*)TJ_SRC(jn, 1); }
    __syncthreads();
    u32x4 w;
    UNR for (int q = 0; q < 4; ++q) w[q] = pk2(tile[(kc * 8 + 2 * q) * 65 + n], tile[(kc * 8 + 2 * q + 1) * 65 + n]);
    const bool isin = j < J_TIN; const int jj = isin ? j : j - J_TIN;
    const int l = isin ? jj >> 10 : jj >> 8, tk = isin ? (jj >> 6) & 15 : (jj >> 4) & 15, tn = isin ? jj & 63 : jj & 15;
    bf16_t* Wt = isin ? (bf16_t*)(p.ws + OFF_WIN) + (size_t)l * 4096 * 1024 : (bf16_t*)(p.ws + OFF_WOUT) + (size_t)l * 1024 * 1024;
    { const int cn = tn * 64 + n, c = cn & 255; const int pos = (cn & ~255) + 128 * ((c >> 5) & 1) + 32 * (c >> 6) + (c & 31);
      *(u32x4*)(Wt + (size_t)pos * 1024 + tk * 64 + kc * 8) = w; }
    __syncthreads();
  }
#undef TJ_SRC
}

DI void job_mod(const PW& p, int l, int cgp, float* sv, float* red) {
  const int tid = LTID(p);
  float* MOD = (float*)(p.ws + OFF_MOD);
  for (int i = tid; i < 9 * 1024; i += 512) { const int v = i >> 10, k = i & 1023; const float c = v < 8 ? p.c[v * 1024 + k] : p.c_ctx[k]; sv[i] = silu(c); }
  __syncthreads();
  const int kg = tid >> 6, cn = tid & 63, n = cgp * 64 + cn;
  float acc[9];
  UNR for (int v = 0; v < 9; ++v) acc[v] = 0.f;
  const float* W = p.w_mod + (size_t)l * 1024 * 3072 + n;
  for (int k = kg * 128; k < kg * 128 + 128; k += 16) {
    float w[16];
    UNR for (int u = 0; u < 16; ++u) w[u] = W[(size_t)(k + u) * 3072];
    UNR for (int v = 0; v < 9; ++v) UNR for (int u4 = 0; u4 < 4; ++u4) { const f32x4 s4 = *(const f32x4*)(sv + v * 1024 + k + u4 * 4); UNR for (int j = 0; j < 4; ++j) acc[v] += s4[j] * w[u4 * 4 + j]; }
  }
  UNR for (int v = 0; v < 9; ++v) red[(kg * 9 + v) * 64 + cn] = acc[v];
  __syncthreads();
  for (int i = tid; i < 9 * 64; i += 512) {
    const int v = i >> 6, c2 = i & 63; float s = 0.f;
    UNR for (int g = 0; g < 8; ++g) s += red[(g * 9 + v) * 64 + c2];
    MOD[(l * 9 + v) * 3072 + cgp * 64 + c2] = s + p.b_mod[l * 3072 + cgp * 64 + c2];
  }
  __syncthreads();
}

DI void job_filter(const PW& p, int e, int chunk, int cb, float* zs, float* h1, float* h2) {
  const int tid = LTID(p);
  const bool isc = chunk >= 256; const int L = isc ? 256 : 4096; const int t0 = (isc ? chunk - 256 : chunk) * 16;
  for (int i = tid; i < 16 * 33; i += 512) {
    const int tt = i / 33, f = i % 33, t = t0 + tt; float val;
    if (f == 0) val = (float)t / (float)(L - 1);
    else { const int k = (f - 1) & 15; const float fb = 1e-4f + (float)k * ((15.f - 1e-4f) / 15.f); float rev = fb * (float)t / (float)L; rev -= floorf(rev);
           val = f <= 16 ? __builtin_amdgcn_cosf(rev) : -__builtin_amdgcn_sinf(rev); }
    zs[i] = val;
  }
  __syncthreads();
  for (int i = tid; i < 1024; i += 512) {
    const int tt = i >> 6, j = i & 63; float a = p.f_b1[e * 64 + j];
    for (int f = 0; f < 33; ++f) a += zs[tt * 33 + f] * p.f_w1[(e * 33 + f) * 64 + j];
    h1[i] = __sinf(p.f_freq[e * 64 + j] * a);
  }
  __syncthreads();
  for (int i = tid; i < 1024; i += 512) {
    const int tt = i >> 6, j = i & 63; float a = p.f_b2[e * 64 + j];
    for (int k = 0; k < 64; ++k) a += h1[tt * 64 + k] * p.f_w2[(e * 64 + k) * 64 + j];
    h2[j * 16 + tt] = __sinf(p.f_freq[e * 64 + j] * a);
  }
  __syncthreads();
  const int n = cb * 512 + tid;
  float acc[16];
  { const float b3 = p.f_b3[e * 2048 + n]; UNR for (int tt = 0; tt < 16; ++tt) acc[tt] = b3; }
  _Pragma("unroll 4") for (int k = 0; k < 64; ++k) {
    const float w = p.f_w3[((size_t)e * 64 + k) * 2048 + n];
    UNR for (int q4 = 0; q4 < 4; ++q4) { const f32x4 hv = *(const f32x4*)(h2 + k * 16 + q4 * 4); UNR for (int j = 0; j < 4; ++j) acc[q4 * 4 + j] += hv[j] * w; }
  }
  const float mind = logf(1e-2f) / 1.5f, maxd = logf(1e-2f) / 0.3f;
  const float delta = fabsf(mind + (float)tid * ((maxd - mind) / 511.f));
  float ss = 0.f;
  UNR for (int tt = 0; tt < 16; ++tt) { const float tl = (float)(t0 + tt) / (float)(L - 1); acc[tt] *= __expf(-tl * delta); ss += acc[tt] * acc[tt]; }
  float* dst = isc ? (float*)(p.ws + OFF_HRAWC) + ((size_t)(e * 4 + cb) * 512 + tid) * 256 + t0 : (float*)(p.ws + OFF_HRAW) + ((size_t)(e * 4 + cb) * 512 + tid) * 4096 + t0;
  UNR for (int q = 0; q < 4; ++q) { f32x4 v = {acc[4 * q], acc[4 * q + 1], acc[4 * q + 2], acc[4 * q + 3]}; *(f32x4*)(dst + 4 * q) = v; }
  ((float*)(p.ws + OFF_SSP))[((size_t)e * 272 + chunk) * 2048 + n] = ss;
  __syncthreads();
}

DI void job_misc(const PW& p) {
  const int tid_ = LTID(p); const int wid = __builtin_amdgcn_readfirstlane(tid_ >> 6), lane = tid_ & 63;
  float* MISC = (float*)(p.ws + OFF_MISC);
  if (wid != 0) return;
  for (int l = 0; l < 4; ++l) {
    const float mq = wave_max(fabsf(p.q_norm_g[l * 64 + lane])), mk = wave_max(fabsf(p.k_norm_g[l * 64 + lane]));
    float bound = 8.f * mq * mk;
    if ((l & 1) == 0) { float mr = 0.f; const float* rp = p.na_rpb + (size_t)(l >> 1) * 8 * 15 * 31; for (int i = lane; i < 8 * 15 * 31; i += 64) mr = fmaxf(mr, fabsf(rp[i])); bound += wave_max(mr); }
    if (lane == 0) MISC[l] = -bound * LOG2E;
  }
  for (int o = 0; o < 2; ++o) {
    const float s1 = wave_sum(p.lq1[o * 64 + lane] * p.lk1[o * 64 + lane]), s2 = wave_sum(p.lq2[o * 64 + lane] * p.lk2[o * 64 + lane]);
    const float lam_init = 0.8f - 0.6f * expf(-0.3f * (float)(2 * o + 1));
    if (lane == 0) { MISC[4 + o] = expf(s1) - expf(s2) + lam_init; MISC[6 + o] = lam_init; }
  }
}

DI void phase0(const PW& p, unsigned char* smem) {
  float* fs = (float*)smem;
  transpose_jobs(p, fs);
  constexpr int J_MOD = 4 * 48, J_FIL = 2 * 272 * 4;
  constexpr int NJ = J_MOD + J_FIL + 1;
  for (int job = lbid(); job < NJ; job += gridDim.x) {
    int j = job;
    if (j < J_MOD) { job_mod(p, j / 48, j % 48, fs, fs + 9 * 1024); continue; }
    j -= J_MOD;
    if (j < J_FIL) { const int e = j / (272 * 4), chunk = (j / 4) % 272, cb = j % 4; job_filter(p, e, chunk, cb, fs, fs + 16 * 33, fs + 16 * 33 + 1024); continue; }
    job_misc(p);
  }
}

DI void finalize_filters(const PW& p) {
  const int tid_ = LTID(p); const int wid = __builtin_amdgcn_readfirstlane(tid_ >> 6), lane = tid_ & 63;
  const float* SSP = (const float*)(p.ws + OFF_SSP);
  for (int job = lbid() * 8 + wid; job < 2048; job += gridDim.x * 8) {
    const int e = job >> 10, o = (job >> 9) & 1, c = job & 511;
    float ss = 0.f;
    for (int i = lane; i < 512; i += 64) ss += SSP[((size_t)e * 272 + (i >> 1)) * 2048 + o * 1024 + (i & 1) * 512 + c];
    ss = wave_sum(ss);
    float ssc = 0.f;
    if (lane < 32) ssc = SSP[((size_t)e * 272 + 256 + (lane >> 1)) * 2048 + o * 1024 + (lane & 1) * 512 + c];
    ssc = wave_sum(ssc);
    const float rs = 1.0f / sqrtf(ss + 1e-6f), rsc = 1.0f / sqrtf(ssc + 1e-6f);
    const float skip = p.hy_skip[(e * 2 + o) * 512 + c];
    const float* hf = (const float*)(p.ws + OFF_HRAW) + ((size_t)((e * 2 + o) * 2 + 0) * 512 + c) * 4096;
    const float* hb = (const float*)(p.ws + OFF_HRAW) + ((size_t)((e * 2 + o) * 2 + 1) * 512 + c) * 4096;
    unsigned* dst = (unsigned*)((bf16_t*)(p.ws + OFF_GREV) + ((size_t)(e * 2 + o) * 512 + c) * 8192);
    const float diag = rs * (hf[0] + hb[0]) + skip;
    _Pragma("unroll 8") for (int pp = lane * 2; pp < 8192; pp += 128) {
      float v[2];
      UNR for (int u = 0; u < 2; ++u) { const int d = 4095 - (pp + u); v[u] = d > 0 ? rs * hf[d] : (d == 0 ? diag : (d > -4096 ? rs * hb[-d] : 0.f)); }
      dst[pp >> 1] = pk2(v[0], v[1]);
    }
    const float* hfc = (const float*)(p.ws + OFF_HRAWC) + ((size_t)((e * 2 + o) * 2 + 0) * 512 + c) * 256;
    const float* hbc = (const float*)(p.ws + OFF_HRAWC) + ((size_t)((e * 2 + o) * 2 + 1) * 512 + c) * 256;
    float* gc = (float*)(p.ws + OFF_GC) + ((size_t)(e * 2 + o) * 512 + c) * 512;
    for (int q = lane; q < 512; q += 64) {
      const int d = q - 256;
      gc[q] = q == 0 ? 0.f : (d > 0 ? rsc * hfc[d] : (d == 0 ? rsc * (hfc[0] + hbc[0]) + skip : rsc * hbc[-d]));
    }
  }
}

DI void norm_phase(const PW& p, int l) {
  const int tid_ = LTID(p); const int wid = __builtin_amdgcn_readfirstlane(tid_ >> 6), lane = tid_ & 63;
  const float* MOD = (const float*)(p.ws + OFF_MOD);
  bf16_t* HN = (bf16_t*)(p.ws + OFF_HN);
  const float* xc_in = l == 0 ? p.ctx : (const float*)(p.ws + OFF_XC);
  const float* x_in = l == 0 ? p.x : p.out;
  const int nw = gridDim.x * 8;
  for (int row = lbid() * 8 + wid; row < R; row += 2 * nw) {
    const float* src[2]; const float* mv[2]; int rr[2];
    UNR for (int q = 0; q < 2; ++q) {
      rr[q] = row + q * nw; const int rq = rr[q] < R ? rr[q] : row;
      const int b = rq / TB, t = rq % TB;
      src[q] = t < SEQ ? x_in + ((size_t)b * SEQ + t) * 1024 : xc_in + ((size_t)b * NCTX + (t - SEQ)) * 1024;
      mv[q] = MOD + (size_t)(l * 9 + (t < SEQ ? b : 8)) * 3072;
    }
    f32x4 v[2][4]; float ss[2] = {0.f, 0.f};
    UNR for (int q = 0; q < 2; ++q) UNR for (int i = 0; i < 4; ++i) v[q][i] = *(const f32x4*)(src[q] + i * 256 + lane * 4);
    UNR for (int q = 0; q < 2; ++q) UNR for (int i = 0; i < 4; ++i) ss[q] += v[q][i][0] * v[q][i][0] + v[q][i][1] * v[q][i][1] + v[q][i][2] * v[q][i][2] + v[q][i][3] * v[q][i][3];
    UNR for (int o = 32; o > 0; o >>= 1) { ss[0] += shx(ss[0], o); ss[1] += shx(ss[1], o); }
    UNR for (int q = 0; q < 2; ++q) {
      if (rr[q] >= R) continue;
      const float rstd = 1.0f / sqrtf(ss[q] * (1.f / 1024.f) + 1e-6f);
      UNR for (int i = 0; i < 4; ++i) {
        const int c0 = i * 256 + lane * 4;
        const f32x4 g = *(const f32x4*)(p.norm_g + l * 1024 + c0), sh = *(const f32x4*)(mv[q] + c0), sc = *(const f32x4*)(mv[q] + 1024 + c0);
        float o[4];
        UNR for (int j = 0; j < 4; ++j) o[j] = v[q][i][j] * rstd * g[j] * (1.f + sc[j]) + sh[j];
        u32x2 w = {pk2(o[0], o[1]), pk2(o[2], o[3])};
        *(u32x2*)(HN + (size_t)rr[q] * 1024 + c0) = w;
      }
    }
  }
}

namespace pg8 {
#define PG8_LAS __attribute__((address_space(3)))
typedef unsigned short bf16_t;
typedef short bf16x8 __attribute__((ext_vector_type(8)));
typedef float f32x4 __attribute__((ext_vector_type(4)));
typedef unsigned u32x4 __attribute__((ext_vector_type(4)));
constexpr int BM = 256, BK = 64, HALF = 128, HTB = HALF * BK * 2  , STAGE_BYTES = 8 * HTB, NXCD = 8, WGM = 8;

__host__ __device__ __forceinline__ int lds_byte(int r, int c) { const int st = (r >> 4) * 2 + (c >> 5), rr = r & 15, cc = c & 31, ob = rr * 64 + cc * 2; return st * 1024 + (ob ^ (((ob >> 9) & 1) << 5)); }
__host__ __device__ __forceinline__ void stage_rc(int b, int& R, int& C) { const int st = b / 1024, sb = b % 1024, swz = sb ^ (((sb >> 9) & 1) << 5); R = (st >> 1) * 16 + swz / 64; C = (st & 1) * 32 + (swz % 64) / 2; }
__host__ __device__ __forceinline__ int perm32(int rho) { const int n = rho >> 4, i = rho & 15; return 8 * (i >> 2) + 4 * n + (i & 3); }

struct Unit { int pm, pn; };
struct Gemm { const bf16_t* A; const bf16_t* Bt; int M, N, K; };

struct StaticOrder {
    int nM, nN, nwg, G, c;
    __host__ __device__ void init(int M, int N, int G_, int c_) { nM = M / BM; nN = N / BM; nwg = nM * nN; G = G_; c = c_; }
    __host__ __device__ bool next(int i, Unit& u) const {
        const long L = (long)i * G + c; if (L >= nwg) return false;
        int wgid = (int)L; { const int q = nwg / NXCD, r = nwg % NXCD, xcd = wgid % NXCD, off = wgid / NXCD; wgid = (xcd < r ? xcd * (q + 1) : r * (q + 1) + (xcd - r) * q) + off; }
        const int nig = WGM * nN, gid = wgid / nig, fm = gid * WGM, gsz = (nM - fm) < WGM ? (nM - fm) : WGM;
        u.pm = fm + ((wgid % nig) % gsz); u.pn = (wgid % nig) / gsz; return true;
    }
    __device__ __forceinline__ void a_ready(const Unit&) const {}
    __device__ __forceinline__ void done(const Unit&) const {}
};
template <class Epi, class Sched, bool ALIGN_EPI = false, bool SP2 = false>
__device__ __forceinline__ void gemm_phase(PG8_LAS unsigned char* lds, const Gemm g, const Sched& S, const Epi& E, const int tid0) {
    const int tid = tid0, wid = __builtin_amdgcn_readfirstlane(tid >> 6), lane = tid & 63, wr = wid >> 2, wc = wid & 3, fr = lane & 15, fq = lane >> 4;
    const int K = g.K, nt = K / BK;
    unsigned voffA[2], voffB[2];
#pragma unroll
    for (int i = 0; i < 2; ++i) { int R, C; stage_rc(tid * 16 + i * 8192, R, C); const int Rb = Epi::PERM ? ((R & ~31) + perm32(R & 31)) : R;
        voffA[i] = (unsigned)(R * K + C) * 2u; voffB[i] = (unsigned)(Rb * K + C) * 2u; }
    const size_t kstep = (size_t)(BK * 2);
    const size_t hstep = (size_t)HALF * K * 2;
    const size_t tstep = 2 * hstep;
    const unsigned ldsw = (unsigned)wid * 1024u;
    const int aoff = lds_byte(wr * 64 + fr, fq * 8), boff = lds_byte(wc * 32 + fr, fq * 8);
#define PG8_SA(b, h) (((b) * 2 + (h)) * HTB)
#define PG8_SB(b, h) ((4 + (b) * 2 + (h)) * HTB)
#define PG8_STAGE(bufoff, gbase, voff) do { _Pragma("unroll") for (int _i = 0; _i < 2; ++_i) \
        __builtin_amdgcn_global_load_lds((const unsigned*)((const char*)(gbase) + (voff)[_i]), (PG8_LAS unsigned*)(lds + (bufoff) + ldsw + _i * 8192), 16, 0, 0); } while (0)
#define PG8_LDA(dst, b, h) do { _Pragma("unroll") for (int m = 0; m < 4; ++m) _Pragma("unroll") for (int k = 0; k < 2; ++k) dst[m][k] = *(const PG8_LAS bf16x8*)(lds + PG8_SA(b, h) + aoff + m * 2048 + k * 1024); } while (0)
#define PG8_LDB(dst, b, h) do { _Pragma("unroll") for (int n = 0; n < 2; ++n) _Pragma("unroll") for (int k = 0; k < 2; ++k) dst[n][k] = *(const PG8_LAS bf16x8*)(lds + PG8_SB(b, h) + boff + n * 2048 + k * 1024); } while (0)
#define PG8_MMA(ai, bj, At, Bt) do { __builtin_amdgcn_s_setprio(1); _Pragma("unroll") for (int m = 0; m < 4; ++m) _Pragma("unroll") for (int n = 0; n < 2; ++n) _Pragma("unroll") for (int k = 0; k < 2; ++k) \
        acc[ai][bj][m][n] = __builtin_amdgcn_mfma_f32_16x16x32_bf16(Bt[n][k], At[m][k], acc[ai][bj][m][n], 0, 0, 0); __builtin_amdgcn_s_setprio(0); } while (0)
#define PG8_WAIT_V(n) asm volatile("s_waitcnt vmcnt(" #n ")" ::: "memory")
#define PG8_WAIT_L(n) asm volatile("s_waitcnt lgkmcnt(" #n ")" ::: "memory")
#define PG8_BAR __builtin_amdgcn_s_barrier()
#define PG8_SCHED __builtin_amdgcn_sched_barrier(0)
    Unit cur, nxt; int ui = 0;
    if (!S.next(0, cur)) return;
    f32x4 acc[2][2][4][2];
#pragma unroll
    for (int a = 0; a < 2; ++a)
#pragma unroll
        for (int b = 0; b < 2; ++b)
#pragma unroll
            for (int m = 0; m < 4; ++m)
#pragma unroll
                for (int n = 0; n < 2; ++n) acc[a][b][m][n] = (f32x4){0.f, 0.f, 0.f, 0.f};
    bf16x8 At[4][2], B0[2][2], B1[2][2];
    const char* cA = E.normal(cur) ? (const char*)g.Bt + (size_t)cur.pn * tstep : (const char*)g.A + (size_t)cur.pm * tstep; const char* cB = E.normal(cur) ? (const char*)g.A + (size_t)cur.pm * tstep : (const char*)g.Bt + (size_t)cur.pn * tstep;
    S.a_ready(cur);
    if constexpr (SP2) {
        PG8_STAGE(PG8_SB(0, 0), cB, voffB); PG8_STAGE(PG8_SB(0, 1), cB + hstep, voffB); PG8_STAGE(PG8_SA(0, 0), cA, voffA); PG8_STAGE(PG8_SA(0, 1), cA + hstep, voffA);
        if (wr == 1) PG8_BAR;
        PG8_WAIT_V(2); PG8_BAR;
        PG8_STAGE(PG8_SB(1, 0), cB + kstep, voffB); PG8_STAGE(PG8_SA(1, 0), cA + kstep, voffA); PG8_STAGE(PG8_SB(1, 1), cB + hstep + kstep, voffB);
        PG8_WAIT_V(6); PG8_BAR;
    } else {
        PG8_STAGE(PG8_SB(0, 0), cB, voffB); PG8_STAGE(PG8_SA(0, 0), cA, voffA); PG8_STAGE(PG8_SB(0, 1), cB + hstep, voffB); PG8_STAGE(PG8_SA(0, 1), cA + hstep, voffA);
        if (wr == 1) PG8_BAR;
        PG8_WAIT_V(4); PG8_BAR;
        PG8_STAGE(PG8_SB(1, 0), cB + kstep, voffB); PG8_STAGE(PG8_SA(1, 0), cA + kstep, voffA); PG8_STAGE(PG8_SB(1, 1), cB + hstep + kstep, voffB);
        PG8_WAIT_V(6); PG8_BAR;
    }
    for (;;) {
        const bool has_next = S.next(ui + 1, nxt);
        const bool nsw = has_next && E.normal(nxt); const char* nA = has_next ? (nsw ? (const char*)g.Bt + (size_t)nxt.pn * tstep : (const char*)g.A + (size_t)nxt.pm * tstep) : cA; const char* nB = has_next ? (nsw ? (const char*)g.A + (size_t)nxt.pm * tstep : (const char*)g.Bt + (size_t)nxt.pn * tstep) : cB;
        for (int t = 0; t < nt; t += 2) {
            const bool last = (t == nt - 2);
            const char* a1 = cA + (size_t)(t + 1) * kstep;
            const char* a2 = last ? nA : cA + (size_t)(t + 2) * kstep; const char* b2 = last ? nB : cB + (size_t)(t + 2) * kstep;
            const char* a3 = a2 + kstep; const char* b3 = b2 + kstep;
            if (last && has_next) S.a_ready(nxt);
            if constexpr (SP2) {
            PG8_LDB(B0, 0, 0); PG8_LDB(B1, 0, 1); PG8_SCHED; PG8_LDA(At, 0, 0); PG8_STAGE(PG8_SA(1, 1), a1 + hstep, voffA);
            PG8_WAIT_V(8); PG8_WAIT_L(0); PG8_BAR; PG8_MMA(0, 0, At, B0); PG8_MMA(0, 1, At, B1); PG8_BAR; PG8_SCHED;
            PG8_LDA(At, 0, 1); PG8_STAGE(PG8_SB(0, 0), b2, voffB); PG8_STAGE(PG8_SB(0, 1), b2 + hstep, voffB); PG8_STAGE(PG8_SA(0, 0), a2, voffA);
            PG8_WAIT_V(8); PG8_WAIT_L(0); PG8_BAR; PG8_MMA(1, 0, At, B0); PG8_MMA(1, 1, At, B1); PG8_BAR; PG8_SCHED;
            PG8_LDB(B0, 1, 0); PG8_LDB(B1, 1, 1); PG8_SCHED; PG8_LDA(At, 1, 0); PG8_STAGE(PG8_SA(0, 1), a2 + hstep, voffA);
            PG8_WAIT_V(8); PG8_WAIT_L(0); PG8_BAR; PG8_MMA(0, 0, At, B0); PG8_MMA(0, 1, At, B1); PG8_BAR; PG8_SCHED;
            PG8_LDA(At, 1, 1); PG8_STAGE(PG8_SB(1, 0), b3, voffB); PG8_STAGE(PG8_SB(1, 1), b3 + hstep, voffB); PG8_STAGE(PG8_SA(1, 0), a3, voffA);
            PG8_WAIT_V(8); PG8_WAIT_L(0); PG8_BAR; PG8_MMA(1, 0, At, B0); PG8_MMA(1, 1, At, B1); PG8_BAR; PG8_SCHED;
            } else {
            PG8_LDB(B0, 0, 0); PG8_SCHED; PG8_LDA(At, 0, 0); PG8_STAGE(PG8_SA(1, 1), a1 + hstep, voffA);
            PG8_WAIT_L(8); PG8_BAR; PG8_WAIT_L(0); PG8_MMA(0, 0, At, B0); PG8_BAR; PG8_SCHED;
            PG8_LDB(B1, 0, 1); PG8_STAGE(PG8_SB(0, 0), b2, voffB);
            PG8_BAR; PG8_WAIT_L(0); PG8_MMA(0, 1, At, B1); PG8_BAR;
            PG8_LDA(At, 0, 1); PG8_STAGE(PG8_SA(0, 0), a2, voffA);
            PG8_BAR; PG8_WAIT_L(0); PG8_MMA(1, 0, At, B0); PG8_BAR; PG8_SCHED;
            PG8_STAGE(PG8_SB(0, 1), b2 + hstep, voffB);
            PG8_WAIT_V(6); PG8_BAR; PG8_MMA(1, 1, At, B1); PG8_BAR;
            PG8_LDB(B0, 1, 0); PG8_SCHED; PG8_LDA(At, 1, 0); PG8_STAGE(PG8_SA(0, 1), a2 + hstep, voffA);
            PG8_WAIT_L(8); PG8_BAR; PG8_WAIT_L(0); PG8_MMA(0, 0, At, B0); PG8_BAR; PG8_SCHED;
            PG8_LDB(B1, 1, 1); PG8_STAGE(PG8_SB(1, 0), b3, voffB);
            PG8_BAR; PG8_WAIT_L(0); PG8_MMA(0, 1, At, B1); PG8_BAR;
            PG8_LDA(At, 1, 1); PG8_STAGE(PG8_SA(1, 0), a3, voffA);
            PG8_BAR; PG8_WAIT_L(0); PG8_MMA(1, 0, At, B0); PG8_BAR; PG8_SCHED;
            PG8_STAGE(PG8_SB(1, 1), b3 + hstep, voffB);
            PG8_WAIT_V(6); PG8_BAR; PG8_MMA(1, 1, At, B1); PG8_BAR;
            }
        }
        if constexpr (ALIGN_EPI) { if (wr == 0) PG8_BAR; }
        if constexpr (!Epi::AFTER_DRAIN) { E(acc, cur, wr, wc, fr, fq); S.done(cur); }
        if (!has_next) break;
#pragma unroll
        for (int a = 0; a < 2; ++a)
#pragma unroll
            for (int b = 0; b < 2; ++b)
#pragma unroll
                for (int m = 0; m < 4; ++m)
#pragma unroll
                    for (int n = 0; n < 2; ++n) acc[a][b][m][n] = (f32x4){0.f, 0.f, 0.f, 0.f};
        cur = nxt; cA = nA; cB = nB; ++ui;
        if constexpr (ALIGN_EPI) { if (wr == 1) PG8_BAR; }
    }
    PG8_WAIT_V(0);
    if constexpr (!ALIGN_EPI) { if (wr == 0) PG8_BAR; }
    PG8_BAR;
    if constexpr (Epi::AFTER_DRAIN) { E.fused(acc, cur, wr, wc, fr, fq, lds, wid, lane); S.done(cur); }
#undef PG8_SA
#undef PG8_SB
#undef PG8_STAGE
#undef PG8_LDA
#undef PG8_LDB
#undef PG8_MMA
#undef PG8_WAIT_V
#undef PG8_WAIT_L
#undef PG8_BAR
#undef PG8_SCHED
}
}

typedef const f32x4 (&AccRef)[2][2][4][2];
DI void epi2_qk(AccRef acc, bf16_t* dst, int pitch, const float* g, float scale, bool rope, int tq0, int fr, int fq) {
  f32x4 g0[2], g1[2];
  UNR for (int n = 0; n < 2; ++n) { g0[n] = *(const f32x4*)(g + 8 * fq + 4 * n); g1[n] = *(const f32x4*)(g + 32 + 8 * fq + 4 * n); }
  float inv[2][4];
  UNR for (int n = 0; n < 2; ++n) UNR for (int e = 0; e < 4; ++e) inv[n][e] = __builtin_amdgcn_exp2f(-(float)((8 * fq + 4 * n + e) & 15) * (13.287712379549449f / 16.f)) * 0.15915494309189535f;
  float ssq[2][4];
  UNR for (int ai = 0; ai < 2; ++ai) UNR for (int m = 0; m < 4; ++m) {
    float ss = 0.f;
    UNR for (int bj = 0; bj < 2; ++bj) UNR for (int n = 0; n < 2; ++n) UNR for (int e = 0; e < 4; ++e) ss += acc[ai][bj][m][n][e] * acc[ai][bj][m][n][e];
    ssq[ai][m] = ss;
  }
  UNR for (int ai = 0; ai < 2; ++ai) UNR for (int m = 0; m < 4; ++m) ssq[ai][m] += shx(ssq[ai][m], 16);
  UNR for (int ai = 0; ai < 2; ++ai) UNR for (int m = 0; m < 4; ++m) ssq[ai][m] += shx(ssq[ai][m], 32);
  UNR for (int ai = 0; ai < 2; ++ai) UNR for (int m = 0; m < 4; ++m) {
    const int t = tq0 + 128 * ai + 16 * m + fr;
    const float rstd = scale / sqrtf(ssq[ai][m] * (1.f / 64.f) + 1e-6f);
    const unsigned off = (unsigned)(t * pitch + 8 * fq);
    const int pos = fq < 2 ? (t >> 6) : (t & 63);
    f32x4 v0[2], v1[2];
    UNR for (int n = 0; n < 2; ++n) {
      v0[n] = acc[ai][0][m][n] * rstd * g0[n];
      v1[n] = acc[ai][1][m][n] * rstd * g1[n];
      if (rope) {
        UNR for (int e = 0; e < 4; ++e) {
          const float rev = (float)pos * inv[n][e];
          const float cs = __builtin_amdgcn_cosf(rev), sn = __builtin_amdgcn_sinf(rev);
          const float x1 = v0[n][e], x2 = v1[n][e];
          v0[n][e] = x1 * cs - x2 * sn; v1[n][e] = x1 * sn + x2 * cs;
        }
      }
    }
    u32x4 w0 = {pk2(v0[0][0], v0[0][1]), pk2(v0[0][2], v0[0][3]), pk2(v0[1][0], v0[1][1]), pk2(v0[1][2], v0[1][3])};
    u32x4 w1 = {pk2(v1[0][0], v1[0][1]), pk2(v1[0][2], v1[0][3]), pk2(v1[1][0], v1[1][1]), pk2(v1[1][2], v1[1][3])};
    *(u32x4*)(dst + off) = w0;
    *(u32x4*)(dst + off + 32) = w1;
    asm volatile("" ::: "memory");
  }
}
DI void epi2_gate_tok(AccRef acc, bf16_t* dst, int pitch, int fr, int fq) {
  UNR for (int ai = 0; ai < 2; ++ai) UNR for (int m = 0; m < 4; ++m) {
    const unsigned off = (unsigned)((128 * ai + 16 * m + fr) * pitch + 8 * fq);
    UNR for (int bj = 0; bj < 2; ++bj) {
      const f32x4 a = acc[ai][bj][m][0], c = acc[ai][bj][m][1];
      u32x4 w = {pk2(silu(a[0]), silu(a[1])), pk2(silu(a[2]), silu(a[3])), pk2(silu(c[0]), silu(c[1])), pk2(silu(c[2]), silu(c[3]))};
      *(u32x4*)(dst + off + 32 * bj) = w;
    }
    asm volatile("" ::: "memory");
  }
}
DI void epi2_S(AccRef acc, bf16_t* dst, unsigned chmul, bool dosilu, bool qperm, int wr, int wc, int fr, int fq) {
  UNR for (int ai = 0; ai < 2; ++ai) UNR for (int m = 0; m < 4; ++m) {
    const int ch = 64 * (2 * wr + (m >> 1)) + 32 * ai + 16 * (m & 1) + fr;
    const unsigned off = (unsigned)ch * chmul + (unsigned)(32 * wc);
    UNR for (int bj = 0; bj < 2; ++bj) {
      f32x4 a = acc[ai][bj][m][0], c = acc[ai][bj][m][1];
      if (dosilu) { UNR for (int e = 0; e < 4; ++e) { a[e] = silu(a[e]); c[e] = silu(c[e]); } }
      const u32x2 wa = {pk2(a[0], a[1]), pk2(a[2], a[3])}, wc2 = {pk2(c[0], c[1]), pk2(c[2], c[3])};
      if (qperm) {
        const unsigned g16 = 128 * bj + 16 * (fq >> 1);
        const int q0 = 2 * (fq & 1), q1 = q0 + 1;
        *(u32x2*)(dst + off + g16 + 4 * (((q0 & 1) << 1) | (q0 >> 1))) = wa;
        *(u32x2*)(dst + off + g16 + 4 * (((q1 & 1) << 1) | (q1 >> 1))) = wc2;
      } else {
        u32x4 w = {wa[0], wa[1], wc2[0], wc2[1]};
        *(u32x4*)(dst + off + 128 * bj + 8 * fq) = w;
      }
    }
    asm volatile("" ::: "memory");
  }
}
struct EpiIn {
  static constexpr bool PERM = true, AFTER_DRAIN = false;
  bf16_t* PB; const float* gq; const float* gk; int odd;
  DI bool normal(const pg8::Unit& u) const { const int n0 = u.pn * 256; return odd ? (n0 >= 2048 && n0 < 3072) : ((n0 >= 1024 && n0 < 3072) || n0 >= 3584); }
  DI void operator()(AccRef acc, const pg8::Unit& u, int wr, int wc, int fr_, int fq_) const {
    int fr = fr_, fq = fq_; asm volatile("" : "+v"(fr), "+v"(fq));
    const int n0 = u.pn * 256, cb = n0 + 64 * wc, b = u.pm / 17, tmi = u.pm % 17; const bool isctx = tmi == 16;
    const int tq0 = tmi * 256 + 64 * wr; const size_t row0 = (size_t)u.pm * 256 + 64 * wr;
    if (normal(u)) {
      const int t0 = tmi * 256; bf16_t* dst; unsigned chmul = (unsigned)(8 * TB); bool sl = false, qp = odd != 0;
      if (!odd) {
        if (n0 < 1536) { dst = PB + 2 * SEG + ((size_t)b * 512 + (n0 - 1024)) * TB + t0; chmul = (unsigned)TB; qp = true; }
        else if (n0 < 3072) dst = PB + 3 * SEG + ((size_t)(n0 - 1536) * 8 + b) * TB + t0;
        else { dst = PB + 7 * SEG + ((size_t)(n0 - 3584) * 8 + b) * TB + t0; sl = true; }
      } else { dst = PB + 4 * SEG + ((size_t)b * 1024 + (n0 - 2048)) * TB + t0; chmul = (unsigned)TB; }
      epi2_S(acc, dst, chmul, sl, qp, wr, wc, fr, fq);
      return;
    }
    if (n0 >= 3072) {
      const int pitch = odd ? 1024 : 512;
      epi2_gate_tok(acc, PB + 6 * SEG + row0 * pitch + (cb - 3072), pitch, fr, fq);
      return;
    }
    {
      bf16_t* dst; int pitch; const float* g; float scale; bool rope = false;
      if (!odd) {
        pitch = 64;
        if (cb < 512) { dst = PB + ((size_t)(b * 8 + (cb >> 6)) * TB) * 64; g = gq; scale = LOG2E * 0.125f; }
        else { dst = PB + SEG + ((size_t)(b * 8 + ((cb - 512) >> 6)) * TB) * 64; g = gk; scale = 1.f; }
      } else {
        pitch = 128; rope = !isctx;
        if (cb < 1024) { dst = PB + ((size_t)(b * 8 + (cb >> 7)) * TB) * 128 + ((cb >> 6) & 1) * 64; g = gq; scale = LOG2E * 0.125f; }
        else { const int c2 = cb - 1024; dst = PB + 2 * SEG + ((size_t)(b * 8 + (c2 >> 7)) * TB) * 128 + ((c2 >> 6) & 1) * 64; g = gk; scale = 1.f; }
      }
      epi2_qk(acc, dst, pitch, g, scale, rope, tq0, fr, fq);
    }
  }
};
struct EpiOut {
  static constexpr bool PERM = true, AFTER_DRAIN = false;
  const float* x_in; const float* xc_in; float* out; float* xc; const float* mod; int l;
  DI bool normal(const pg8::Unit&) const { return false; }
  DI void operator()(AccRef acc, const pg8::Unit& u, int wr, int wc, int fr, int fq) const {
    const int cb = u.pn * 256 + 64 * wc, b = u.pm / 17, tmi = u.pm % 17; const bool isctx = tmi == 16;
    if (isctx && l == 3) return;
    const float* gate = mod + (size_t)(l * 9 + (isctx ? 8 : b)) * 3072 + 2048;
    const float* src; float* dst;
    if (isctx) { src = xc_in + ((size_t)b * NCTX + 64 * wr) * 1024; dst = xc + ((size_t)b * NCTX + 64 * wr) * 1024; }
    else { const size_t o = ((size_t)b * SEQ + tmi * 256 + 64 * wr) * 1024; src = x_in + o; dst = out + o; }
    UNR for (int bj = 0; bj < 2; ++bj) {
      f32x4 xo[2][2][4], gg[2];
      UNR for (int n = 0; n < 2; ++n) {
        const int c = cb + 32 * bj + 8 * fq + 4 * n; gg[n] = *(const f32x4*)(gate + c);
        UNR for (int ai = 0; ai < 2; ++ai) UNR for (int m = 0; m < 4; ++m) xo[n][ai][m] = *(const f32x4*)(src + (size_t)(128 * ai + 16 * m + fr) * 1024 + c);
      }
      UNR for (int n = 0; n < 2; ++n) {
        const int c = cb + 32 * bj + 8 * fq + 4 * n;
        UNR for (int ai = 0; ai < 2; ++ai) UNR for (int m = 0; m < 4; ++m) *(f32x4*)(dst + (size_t)(128 * ai + 16 * m + fr) * 1024 + c) = xo[n][ai][m] + gg[n] * acc[ai][bj][m][n];
      }
      asm volatile("" ::: "memory");
    }
  }
};
struct LatentOrder : pg8::StaticOrder {
  __device__ bool next(int i, pg8::Unit& u) const { if (!pg8::StaticOrder::next(i, u)) return false; u.pm += u.pm >> 4; return true; }
};
template <int MODE>
DI void gemm_phase(const PW& p, int l, unsigned char* smem) {
  pg8::Gemm g; g.M = R; g.K = 1024;
  pg8::StaticOrder S;
  PG8_LAS unsigned char* lds = (PG8_LAS unsigned char*)smem;
  if (MODE == 2) {
    g.A = (const bf16_t*)(p.ws + OFF_Y); g.Bt = (const bf16_t*)(p.ws + OFF_WOUT) + (size_t)l * 1024 * 1024; g.N = 1024;
    S.init(R, 1024, gridDim.x, lbid());
    EpiOut E; E.x_in = l == 0 ? p.x : p.out; E.xc_in = l == 0 ? p.ctx : (const float*)(p.ws + OFF_XC); E.out = p.out; E.xc = (float*)(p.ws + OFF_XC); E.mod = (const float*)(p.ws + OFF_MOD); E.l = l;
    if (l == 3) { LatentOrder S3; S3.init(128 * 256, 1024, gridDim.x, lbid()); pg8::gemm_phase<EpiOut, LatentOrder, true, true>(lds, g, S3, E, LTID(p)); }
    else pg8::gemm_phase<EpiOut, pg8::StaticOrder, true, true>(lds, g, S, E, LTID(p));
  } else {
    g.A = (const bf16_t*)(p.ws + OFF_HN); g.Bt = (const bf16_t*)(p.ws + OFF_WIN) + (size_t)l * 4096 * 1024; g.N = 4096;
    S.init(R, 4096, gridDim.x, lbid());
    EpiIn E; E.PB = (bf16_t*)(p.ws + OFF_PB); E.gq = p.q_norm_g + l * 64; E.gk = p.k_norm_g + l * 64; E.odd = MODE;
    pg8::gemm_phase<EpiIn, pg8::StaticOrder, true, true>(lds, g, S, E, LTID(p));
  }
  __syncthreads();
}

DI void na_unit(const PW& p, int e, int b, int hd, int tq0, bool ctxq, float negM, int r, int h) {
  const bf16_t* PB = (const bf16_t*)(p.ws + OFF_PB);
  const bf16_t* Q = PB + ((size_t)(b * 8 + hd) * TB) * 64;
  const bf16_t* K = PB + SEG + ((size_t)(b * 8 + hd) * TB) * 64;
  const bf16_t* VT = PB + 2 * SEG + ((size_t)(b * 8 + hd) * 64) * TB;
  const int tq = tq0 + r;
  f32x16 O[2]; O[0] = splat16(0.f); O[1] = splat16(0.f);
  float lsum = 0.f;
  const int qrow = tq0 >> 6, qcol = tq & 63;
  const int rs = min(max(qrow - 4, 0), 56), cs = min(max(qcol - 8, 0), 48);
  const float* rpb = p.na_rpb + (size_t)(e * 8 + hd) * 15 * 31;
  constexpr int NB = 2; const int ngrp = ctxq ? 8 / NB : 24 / NB;
  _Pragma("unroll 1") for (int g = 0; g < ngrp; ++g) {
    const bool local = !ctxq && g < 16 / NB;
    bf16x8 kf[NB][4], vf[NB][4], qf[4];
    UNR for (int ks = 0; ks < 4; ++ks) qf[ks] = *(const bf16x8*)(Q + (size_t)tq * 64 + ks * 16 + h * 8);
    UNR for (int u = 0; u < NB; ++u) {
      const int it = g * NB + u;
      const int kb = local ? (rs + (it >> 1)) * 64 + (it & 1) * 32 : SEQ + (ctxq ? it : it - 16) * 32;
      UNR for (int ks = 0; ks < 4; ++ks) kf[u][ks] = *(const bf16x8*)(K + (size_t)(kb + r) * 64 + ks * 16 + h * 8);
      UNR for (int dvt = 0; dvt < 2; ++dvt) UNR for (int s2 = 0; s2 < 2; ++s2) vf[u][dvt * 2 + s2] = *(const bf16x8*)(VT + (size_t)(dvt * 32 + r) * TB + kb + s2 * 16 + 8 * h);
    }
    asm volatile("" ::: "memory");
    UNR for (int u = 0; u < NB; ++u) {
      const int it = g * NB + u;
      const int krow = rs + (it >> 1), ct = it & 1;
      f32x16 s = splat16(negM);
      UNR for (int ks = 0; ks < 4; ++ks) s = MFMA32(kf[u][ks], qf[ks], s);
      if (local) {
        const float* rp = rpb + (krow - qrow + 7) * 31;
        UNR for (int i = 0; i < 16; ++i) {
          const int kcol = ct * 32 + crow(i, h); const bool valid = kcol >= cs && kcol < cs + 16;
          const int dc = min(max(kcol - qcol + 15, 0), 30);
          const float pv = __builtin_amdgcn_exp2f(s[i] + rp[dc] * LOG2E);
          s[i] = valid ? pv : 0.f;
        }
      } else {
        UNR for (int i = 0; i < 16; ++i) s[i] = __builtin_amdgcn_exp2f(s[i]);
      }
      UNR for (int i = 0; i < 16; ++i) lsum += s[i];
      bf16x8 pf[2]; pf[0] = pack8(s, 0); pf[1] = pack8(s, 8);
      UNR for (int dvt = 0; dvt < 2; ++dvt) UNR for (int s2 = 0; s2 < 2; ++s2) O[dvt] = MFMA32(vf[u][dvt * 2 + s2], pf[s2], O[dvt]);
      asm volatile("" ::: "memory");
    }
  }
  lsum += shx(lsum, 32);
  const float inv = 1.f / lsum;
  const size_t row = (size_t)b * TB + tq;
  const bf16_t* G = PB + 6 * SEG + row * 512 + hd * 64;
  bf16_t* Y = (bf16_t*)(p.ws + OFF_Y) + row * 1024 + hd * 64;
  UNR for (int dvt = 0; dvt < 2; ++dvt) UNR for (int gq = 0; gq < 4; ++gq) {
    const int dv = dvt * 32 + 8 * gq + 4 * h;
    const u32x2 gg = *(const u32x2*)(G + dv);
    u32x2 w = {pk2(O[dvt][4 * gq] * inv * bflo(gg[0]), O[dvt][4 * gq + 1] * inv * bfhi(gg[0])), pk2(O[dvt][4 * gq + 2] * inv * bflo(gg[1]), O[dvt][4 * gq + 3] * inv * bfhi(gg[1]))};
    *(u32x2*)(Y + dv) = w;
  }
}

DI void na_block(const PW& p, int e, int b, int hd, int r0, bool ctxq, float negM, unsigned char* smem) {
  const int tid = LTID(p), wid = __builtin_amdgcn_readfirstlane(tid >> 6), lane = tid & 63, r = lane & 31, h = lane >> 5;
  const bf16_t* PB = (const bf16_t*)(p.ws + OFF_PB);
  const bf16_t* Q = PB + ((size_t)(b * 8 + hd) * TB) * 64;
  const bf16_t* K = PB + SEG + ((size_t)(b * 8 + hd) * TB) * 64;
  const bf16_t* VT = PB + 2 * SEG + ((size_t)(b * 8 + hd) * 64) * TB;
  PG8_LAS unsigned char* lds = (PG8_LAS unsigned char*)smem;
  const int qrow = ctxq ? 0 : r0 + (wid >> 1);
  const int tq0 = ctxq ? SEQ + wid * 32 : qrow * 64 + (wid & 1) * 32;
  const int tq = tq0 + r, qcol = tq & 63;
  const int rsw = min(max(qrow - 4, 0), 56), cs = min(max(qcol - 8, 0), 48);
  const int kr_lo = min(max(r0 - 4, 0), 56), kr_hi = min(max(r0 - 1, 0), 56) + 7;
  const int nloc = ctxq ? 0 : (kr_hi - kr_lo + 2) >> 1, nch = nloc + 2;
  bf16x8 qf[4];
  UNR for (int ks = 0; ks < 4; ++ks) qf[ks] = *(const bf16x8*)(Q + (size_t)tq * 64 + ks * 16 + h * 8);
  f32x16 O[2]; O[0] = splat16(0.f); O[1] = splat16(0.f);
  float lsum = 0.f;
  const float* rpb = p.na_rpb + (size_t)(e * 8 + hd) * 15 * 31;
  unsigned offK[2], offV[2];
  UNR for (int j = 0; j < 2; ++j) {
    const int s = (wid * 2 + j) * 64 + lane;
    { const int row = s >> 3, c = (s & 7) ^ ((row >> 1) & 7); offK[j] = (unsigned)(row * 64 + c * 8) * 2u; }
    { const int row = s >> 4, c = (s & 15) ^ (row & 15); offV[j] = (unsigned)(row * TB + c * 8) * 2u; }
  }
#define NA_KB(ci) ((ci) < nloc ? (kr_lo + 2 * (ci)) * 64 : SEQ + ((ci) - nloc) * 128)
#define NA_STAGE(st, ci) do { const int kb_ = NA_KB(ci); const char* kp_ = (const char*)(K + (size_t)kb_ * 64); const char* vp_ = (const char*)(VT + kb_); \
    UNR for (int j = 0; j < 2; ++j) { __builtin_amdgcn_global_load_lds((const unsigned*)(kp_ + offK[j]), (PG8_LAS unsigned*)(lds + (st) * 32768 + (wid * 2 + j) * 1024), 16, 0, 0); \
                                      __builtin_amdgcn_global_load_lds((const unsigned*)(vp_ + offV[j]), (PG8_LAS unsigned*)(lds + (st) * 32768 + 16384 + (wid * 2 + j) * 1024), 16, 0, 0); } } while (0)
  float* btab = (float*)(smem + 65536);
  __syncthreads();
  if (!ctxq && tid < 465) btab[tid] = rpb[tid] * LOG2E;
  NA_STAGE(0, 0);
  asm volatile("s_waitcnt vmcnt(0)" ::: "memory");
  __syncthreads();
  for (int ci = 0; ci < nch; ++ci) {
    if (ci + 1 < nch) NA_STAGE((ci + 1) & 1, ci + 1);
    const unsigned char* Kl = smem + (ci & 1) * 32768; const unsigned char* Vl = Kl + 16384;
    const bool local = ci < nloc;
    _Pragma("unroll 2") for (int sub = 0; sub < 4; ++sub) {
      const int krow = kr_lo + 2 * ci + (sub >> 1), ct = sub & 1;
      if (local && (krow < rsw || krow >= rsw + 8)) continue;
      f32x16 s = splat16(negM);
      const int kr_ = sub * 32 + r;
      UNR for (int ks = 0; ks < 4; ++ks) { const bf16x8 kf = *(const bf16x8*)(Kl + kr_ * 128 + (((ks * 2 + h) ^ ((kr_ >> 1) & 7)) << 4)); s = MFMA32(kf, qf[ks], s); }
      if (local) {
        const float* rp = btab + (krow - qrow + 7) * 31;
        UNR for (int i = 0; i < 16; ++i) {
          const int kcol = ct * 32 + crow(i, h); const bool valid = kcol >= cs && kcol < cs + 16;
          const int dc = min(max(kcol - qcol + 15, 0), 30);
          const float pv = __builtin_amdgcn_exp2f(s[i] + rp[dc]);
          s[i] = valid ? pv : 0.f;
        }
      } else {
        UNR for (int i = 0; i < 16; ++i) s[i] = __builtin_amdgcn_exp2f(s[i]);
      }
      UNR for (int i = 0; i < 16; ++i) lsum += s[i];
      bf16x8 pf[2]; pf[0] = pack8(s, 0); pf[1] = pack8(s, 8);
      UNR for (int dvt = 0; dvt < 2; ++dvt) UNR for (int s2 = 0; s2 < 2; ++s2) {
        const int vrow = dvt * 32 + r;
        const bf16x8 vf = *(const bf16x8*)(Vl + vrow * 256 + (((sub * 4 + s2 * 2 + h) ^ (vrow & 15)) << 4));
        O[dvt] = MFMA32(vf, pf[s2], O[dvt]);
      }
    }
    asm volatile("s_waitcnt vmcnt(0)" ::: "memory");
    __syncthreads();
  }
#undef NA_STAGE
#undef NA_KB
  lsum += shx(lsum, 32);
  const float inv = 1.f / lsum;
  const size_t row = (size_t)b * TB + tq;
  const bf16_t* G = PB + 6 * SEG + row * 512 + hd * 64;
  bf16_t* Y = (bf16_t*)(p.ws + OFF_Y) + row * 1024 + hd * 64;
  UNR for (int dvt = 0; dvt < 2; ++dvt) UNR for (int gq = 0; gq < 4; ++gq) {
    const int dv = dvt * 32 + 8 * gq + 4 * h;
    const u32x2 gg = *(const u32x2*)(G + dv);
    u32x2 w = {pk2(O[dvt][4 * gq] * inv * bflo(gg[0]), O[dvt][4 * gq + 1] * inv * bfhi(gg[0])), pk2(O[dvt][4 * gq + 2] * inv * bflo(gg[1]), O[dvt][4 * gq + 3] * inv * bfhi(gg[1]))};
    *(u32x2*)(Y + dv) = w;
  }
}

#ifndef HY_FENCE
#define HY_FENCE do { } while (0)
#endif
DI float sconv3(float um, float u0, float up, float w0, float w1, float w2, float cb) { return cb + w0 * um + w1 * u0 + w2 * up; }

DI void conv4(const bf16_t* rowp, int seq0, int len, int t0, float w0, float w1, float w2, float cb, float (&o)[4]) {
  const u32x2 m = *(const u32x2*)(rowp + seq0 + t0);
  const float um = t0 > 0 ? bf1(rowp[seq0 + t0 - 1]) : 0.f, up = t0 + 4 < len ? bf1(rowp[seq0 + t0 + 4]) : 0.f;
  const float u0 = bflo(m[0]), u1 = bfhi(m[0]), u2 = bflo(m[1]), u3 = bfhi(m[1]);
  o[0] = sconv3(um, u0, u1, w0, w1, w2, cb); o[1] = sconv3(u0, u1, u2, w0, w1, w2, cb); o[2] = sconv3(u1, u2, u3, w0, w1, w2, cb); o[3] = sconv3(u2, u3, up, w0, w1, w2, cb);
}

DI void hy_load_filter(const PW& p, int e, int o, int c, unsigned char* C0, unsigned char* C1) {
  const int tid = LTID(p);
  const bf16_t* grev = (const bf16_t*)(p.ws + OFF_GREV) + ((size_t)(e * 2 + o) * 512 + c) * 8192;
  UNR for (int i = 0; i < 2; ++i) { const int q = tid + i * 512; *(u32x4*)(C0 + q * 16) = *(const u32x4*)(grev + q * 8); }
  __syncthreads();
  const unsigned* c0d = (const unsigned*)C0; unsigned* c1d = (unsigned*)C1;
  UNR for (int i = 0; i < 8; ++i) { const int w = tid + i * 512; const unsigned a = c0d[w], bnx = w + 1 < 4096 ? c0d[w + 1] : 0u; c1d[w] = (a >> 16) | (bnx << 16); }
  __syncthreads();
}

DI u32x4 hy_loadA(const unsigned char* C0, const unsigned char* C1, int d, int off, int r, int h) {
  const int P0 = 4095 - 64 * d - off - r + 8 * h;
  const int odd = P0 & 1;
  const unsigned* ap = (const unsigned*)((odd ? C1 : C0) + (P0 - odd) * 2);
  u32x4 w = {ap[0], ap[1], ap[2], ap[3]};
  return w;
}
DI void hy_conv(f32x16 (&acc)[2][2], const unsigned char* Z, const unsigned char* ZR, const unsigned char* C0, const unsigned char* C1, int wid, int r, int h) {
  UNR for (int i = 0; i < 2; ++i) UNR for (int j = 0; j < 2; ++j) acc[i][j] = splat16(0.f);
  const int abase = wid * 8;
  const int bb = r & 7, ar = r >> 3;
  u32x4 F[6];
  int d = abase - 63;
  UNR for (int k = 0; k < 6; ++k) F[k] = hy_loadA(C0, C1, d, 32 - 16 * k, r, h);
  for (;;) {
    UNR for (int nt = 0; nt < 2; ++nt) {
      const int ap_ = abase + 4 * nt - d + ar; const bool valid = (unsigned)ap_ < 64u;
      const unsigned char* zp = valid ? Z + (ap_ * 8 + bb) * 144 + h * 16 : ZR + h * 16;
      UNR for (int ks = 0; ks < 4; ++ks) {
        const bf16x8 zf = *(const bf16x8*)(zp + ks * 32);
        acc[0][nt] = MFMA32(__builtin_bit_cast(bf16x8, F[2 + ks]), zf, acc[0][nt]);
        acc[1][nt] = MFMA32(__builtin_bit_cast(bf16x8, F[ks]), zf, acc[1][nt]);
      }
    }
    if (d == abase + 7) break;
    ++d;
    F[4] = F[0]; F[5] = F[1];
    UNR for (int k = 0; k < 4; ++k) F[k] = hy_loadA(C0, C1, d, 32 - 16 * k, r, h);
  }
}

DI void hyena_unit(const PW& p, int e, int c, unsigned char* smem) {
  const int tid = LTID(p), wid = __builtin_amdgcn_readfirstlane(tid >> 6), lane = tid & 63, r = lane & 31, h = lane >> 5;
  unsigned char* Z = smem; unsigned char* C0 = smem + 73728; unsigned char* C1 = C0 + 16384 + 64; unsigned char* ZR = smem + 106624;
  if (tid < 32) ((unsigned*)ZR)[tid] = 0u;
  const bf16_t* PB = (const bf16_t*)(p.ws + OFF_PB);
  const bf16_t* UT = PB + 3 * SEG;
  const bf16_t* GHT = PB + 7 * SEG;
  bf16_t* Y = (bf16_t*)(p.ws + OFF_Y);
  float cw[3][3], cbias[3];
  UNR for (int s = 0; s < 3; ++s) { UNR for (int j = 0; j < 3; ++j) cw[s][j] = p.hy_conv_w[(e * 3 + j) * 1536 + s * 512 + c]; cbias[s] = p.hy_conv_b[e * 1536 + s * 512 + c]; }
  __syncthreads();
  hy_load_filter(p, e, 0, c, C0, C1);
  _Pragma("unroll 4") for (int i = 0; i < 8; ++i) {
    const int cid = tid + i * 512, b = cid >> 9, t0 = (cid & 511) * 8;
    const bf16_t* rowp = UT + ((size_t)c * 8 + b) * TB;
    float o0[4], o1[4];
    conv4(rowp, 0, SEQ, t0, cw[0][0], cw[0][1], cw[0][2], cbias[0], o0);
    conv4(rowp, 0, SEQ, t0 + 4, cw[0][0], cw[0][1], cw[0][2], cbias[0], o1);
    u32x4 w = {pk2(o0[0], o0[1]), pk2(o0[2], o0[3]), pk2(o1[0], o1[1]), pk2(o1[2], o1[3])};
    *(u32x4*)(Z + ((t0 >> 6) * 8 + b) * 144 + (t0 & 63) * 2) = w;
  }
  __syncthreads();
  f32x16 acc[2][2];
#if DUP & 512
  hy_conv(acc, Z, ZR, C0, C1, wid, r, h);
  UNR for (int i_ = 0; i_ < 2; ++i_) UNR for (int j_ = 0; j_ < 2; ++j_) asm volatile("" :: "v"(acc[i_][j_]));
#endif
  hy_conv(acc, Z, ZR, C0, C1, wid, r, h);
  __syncthreads();
  {
    const int bb = r & 7;
    UNR for (int nt = 0; nt < 2; ++nt) {
      const int a = wid * 8 + 4 * nt + (r >> 3);
      const bf16_t* rowp = UT + ((size_t)(512 + c) * 8 + bb) * TB;
      UNR for (int mt = 0; mt < 2; ++mt) UNR for (int gq = 0; gq < 4; ++gq) {
        const int i0 = 32 * mt + 8 * gq + 4 * h; float x1[4];
        conv4(rowp, 0, SEQ, 64 * a + i0, cw[1][0], cw[1][1], cw[1][2], cbias[1], x1);
        u32x2 w = {pk2(x1[0] * acc[mt][nt][4 * gq], x1[1] * acc[mt][nt][4 * gq + 1]), pk2(x1[2] * acc[mt][nt][4 * gq + 2], x1[3] * acc[mt][nt][4 * gq + 3])};
        *(u32x2*)(Z + (a * 8 + bb) * 144 + i0 * 2) = w;
        HY_FENCE;
      }
    }
  }
  hy_load_filter(p, e, 1, c, C0, C1);
#if DUP & 512
  hy_conv(acc, Z, ZR, C0, C1, wid, r, h);
  UNR for (int i_ = 0; i_ < 2; ++i_) UNR for (int j_ = 0; j_ < 2; ++j_) asm volatile("" :: "v"(acc[i_][j_]));
#endif
  hy_conv(acc, Z, ZR, C0, C1, wid, r, h);
  __syncthreads();
  {
    const int bb = r & 7;
    UNR for (int nt = 0; nt < 2; ++nt) {
      const int a = wid * 8 + 4 * nt + (r >> 3);
      const bf16_t* rowp = UT + ((size_t)(1024 + c) * 8 + bb) * TB;
      const bf16_t* gp = GHT + ((size_t)c * 8 + bb) * TB;
      UNR for (int mt = 0; mt < 2; ++mt) UNR for (int gq = 0; gq < 4; ++gq) {
        const int i0 = 32 * mt + 8 * gq + 4 * h; float x2[4];
        conv4(rowp, 0, SEQ, 64 * a + i0, cw[2][0], cw[2][1], cw[2][2], cbias[2], x2);
        const u32x2 gg = *(const u32x2*)(gp + 64 * a + i0);
        u32x2 w = {pk2(x2[0] * acc[mt][nt][4 * gq] * bflo(gg[0]), x2[1] * acc[mt][nt][4 * gq + 1] * bfhi(gg[0])),
                   pk2(x2[2] * acc[mt][nt][4 * gq + 2] * bflo(gg[1]), x2[3] * acc[mt][nt][4 * gq + 3] * bfhi(gg[1]))};
        *(u32x2*)(Z + (a * 8 + bb) * 144 + i0 * 2) = w;
        HY_FENCE;
      }
    }
  }
  __syncthreads();
  {
    bf16_t* OT = (bf16_t*)(p.ws + OFF_HN);
    _Pragma("unroll 2") for (int i = 0; i < 8; ++i) {
      const int cid = tid + i * 512, b = cid >> 9, t0 = (cid & 511) * 8;
      *(u32x4*)(OT + ((size_t)c * 8 + b) * TB + t0) = *(const u32x4*)(Z + ((t0 >> 6) * 8 + b) * 144 + (t0 & 63) * 2);
    }
  }
  __syncthreads();
  {
    float* zc = (float*)smem;
    float* gl = zc + 2048;
    const int bb = tid >> 6, tq = tid & 63, t0 = 4 * tq;
    const bf16_t* r0 = UT + ((size_t)c * 8 + bb) * TB;
    const bf16_t* r1 = UT + ((size_t)(512 + c) * 8 + bb) * TB;
    const bf16_t* r2 = UT + ((size_t)(1024 + c) * 8 + bb) * TB;
    const bf16_t* gp = GHT + ((size_t)c * 8 + bb) * TB + SEQ;
    bf16_t* OTc = (bf16_t*)(p.ws + OFF_HN) + ((size_t)c * 8 + bb) * TB + SEQ;
    { float v4[4]; conv4(r0, SEQ, NCTX, t0, cw[0][0], cw[0][1], cw[0][2], cbias[0], v4);
      f32x4 vv = {v4[0], v4[1], v4[2], v4[3]}; *(f32x4*)(zc + bb * 256 + t0) = vv; }
    for (int o = 0; o < 2; ++o) {
      const float* gc = (const float*)(p.ws + OFF_GC) + ((size_t)(e * 2 + o) * 512 + c) * 512;
      gl[tid] = gc[tid];
      __syncthreads();
      f32x4 a4 = {0.f, 0.f, 0.f, 0.f};
      for (int s0 = 0; s0 < 256; s0 += 4) {
        const f32x4 zv = *(const f32x4*)(zc + bb * 256 + s0);
        const int base4 = 256 + t0 - s0;
        const f32x4 glo = *(const f32x4*)(gl + base4 - 4), ghi = *(const f32x4*)(gl + base4);
        const float G[8] = {glo[0], glo[1], glo[2], glo[3], ghi[0], ghi[1], ghi[2], ghi[3]};
        UNR for (int j = 0; j < 4; ++j) UNR for (int k = 0; k < 4; ++k) a4[j] += G[4 + j - k] * zv[k];
      }
      __syncthreads();
      float xv[4];
      conv4(o == 0 ? r1 : r2, SEQ, NCTX, t0, cw[1 + o][0], cw[1 + o][1], cw[1 + o][2], cbias[1 + o], xv);
      if (o == 0) { f32x4 zn = {xv[0] * a4[0], xv[1] * a4[1], xv[2] * a4[2], xv[3] * a4[3]}; *(f32x4*)(zc + bb * 256 + t0) = zn; }
      else {
        const u32x2 gg = *(const u32x2*)(gp + t0);
        u32x2 w = {pk2(xv[0] * a4[0] * bflo(gg[0]), xv[1] * a4[1] * bfhi(gg[0])), pk2(xv[2] * a4[2] * bflo(gg[1]), xv[3] * a4[3] * bfhi(gg[1]))};
        *(u32x2*)(OTc + t0) = w;
      }
      __syncthreads();
    }
  }
}

DI void hy_transpose_phase(const PW& p, int l, unsigned char* smem) {
  const int tid = LTID(p);
  const bf16_t* OT = (const bf16_t*)(p.ws + OFF_HN);
  bf16_t* Y = (bf16_t*)(p.ws + OFF_Y);
  unsigned* T = (unsigned*)smem;
  const int tb_per_b = l == 3 ? 64 : 68;
  const int ntile = 8 * tb_per_b * 8;
  const int cl = tid >> 3, part = tid & 7;
#define HT_SRC(tile) (OT + ((size_t)(((tile) & 7) * 64 + cl) * 8 + ((tile) >> 3) / tb_per_b) * TB + (((tile) >> 3) % tb_per_b) * 64 + part * 8)
  int tile = lbid();
  u32x4 v = {0u, 0u, 0u, 0u};
  if (tile < ntile) v = *(const u32x4*)HT_SRC(tile);
  for (; tile < ntile; tile += gridDim.x) {
    const int cbk = tile & 7, tb = tile >> 3, b = tb / tb_per_b, t0 = (tb % tb_per_b) * 64;
    UNR for (int j = 0; j < 4; ++j) T[cl * 33 + part * 4 + j] = v[j];
    const int nxt = tile + gridDim.x;
    if (nxt < ntile) v = *(const u32x4*)HT_SRC(nxt);
    __syncthreads();
    { const int tl = tid >> 3;
      const bf16_t* Tb = (const bf16_t*)T;
      unsigned short e[8];
      UNR for (int j = 0; j < 8; ++j) e[j] = Tb[(part * 8 + j) * 66 + tl];
      u32x4 w = {(unsigned)e[0] | ((unsigned)e[1] << 16), (unsigned)e[2] | ((unsigned)e[3] << 16), (unsigned)e[4] | ((unsigned)e[5] << 16), (unsigned)e[6] | ((unsigned)e[7] << 16)};
      *(u32x4*)(Y + ((size_t)b * TB + t0 + tl) * 1024 + 512 + cbk * 64 + part * 8) = w; }
    __syncthreads();
  }
#undef HT_SRC
}

DI void mixer_even(const PW& p, int l, unsigned char* smem, int what = 3) {
  const int e = l >> 1;
  if (what & 1) for (int c = lbid(); c < 512; c += gridDim.x) hyena_unit(p, e, c, smem);
  if (!(what & 2)) return;
  const float negM = ((const float*)(p.ws + OFF_MISC))[l];
  const int G = gridDim.x, bid = lbid();
  if ((G & 7) == 0) {
    const int hd = bid & 7, slot = bid >> 3, S = G >> 3;
    for (int i = slot; i < 128; i += S) na_block(p, e, i >> 4, hd, (i & 15) * 4, false, negM, smem);
    for (int i = slot; i < 8; i += S) na_block(p, e, i, hd, 0, true, negM, smem);
  } else {
    for (int u = bid; u < 1024 + 64; u += G) {
      if (u < 1024) { const int rg = u & 15, hd = (u >> 4) & 7, b = u >> 7; na_block(p, e, b, hd, rg * 4, false, negM, smem); }
      else { const int v = u - 1024, hd = v & 7, b = v >> 3; na_block(p, e, b, hd, 0, true, negM, smem); }
    }
  }
}

DI void diff_unit(const PW& p, int l, int b, int hd, int q0, int kbeg, int kend, float negM, float lam, float lam_init, unsigned char* smem,
                  u32x4 (&rk)[2], u32x4 (&rv)[2], bool pre, bool has_next, int nb, int nkbeg) {
  const int tid = LTID(p), wid = __builtin_amdgcn_readfirstlane(tid >> 6), lane = tid & 63, r = lane & 31, h = lane >> 5, m = wid & 1, qg = wid >> 1;
  const bf16_t* PB = (const bf16_t*)(p.ws + OFF_PB);
  const bf16_t* Q = PB + ((size_t)(b * 8 + hd) * TB) * 128;
  const bf16_t* K = PB + 2 * SEG + ((size_t)(b * 8 + hd) * TB) * 128;
  const bf16_t* VT = PB + 4 * SEG + ((size_t)(b * 8 + hd) * 128) * TB;
  const int tq = q0 + qg * 32 + r;
  bf16x8 qf[4];
  UNR for (int ks = 0; ks < 4; ++ks) qf[ks] = *(const bf16x8*)(Q + (size_t)tq * 128 + m * 64 + ks * 16 + h * 8);
  f32x16 O[4];
  UNR for (int d = 0; d < 4; ++d) O[d] = splat16(0.f);
  float lsum = 0.f;
  const int kkey0 = tid >> 4, kpart = tid & 15;
  const int vdv0 = tid >> 3, vpart = tid & 7;
  const int nt = (kend - kbeg) >> 6;
  if (!pre) { UNR for (int i = 0; i < 2; ++i) { rk[i] = *(const u32x4*)(K + (size_t)(kbeg + kkey0 + 32 * i) * 128 + kpart * 8); rv[i] = *(const u32x4*)(VT + (size_t)(vdv0 + 64 * i) * TB + kbeg + vpart * 8); } }
  UNR for (int i = 0; i < 2; ++i) { *(u32x4*)(smem + (kkey0 + 32 * i) * 272 + kpart * 16) = rk[i]; *(u32x4*)(smem + 17408 + (vdv0 + 64 * i) * 144 + vpart * 16) = rv[i]; }
  __syncthreads();
  for (int it = 0; it < nt; ++it) {
    const unsigned char* Kl = smem + (it & 1) * 35840; const unsigned char* Vl = Kl + 17408;
    if (it + 1 < nt) {
      const int k0 = kbeg + (it + 1) * 64;
      UNR for (int i = 0; i < 2; ++i) { rk[i] = *(const u32x4*)(K + (size_t)(k0 + kkey0 + 32 * i) * 128 + kpart * 8); rv[i] = *(const u32x4*)(VT + (size_t)(vdv0 + 64 * i) * TB + k0 + vpart * 8); }
    } else if (has_next) {
      const bf16_t* Kn = PB + 2 * SEG + ((size_t)(nb * 8 + hd) * TB) * 128; const bf16_t* VTn = PB + 4 * SEG + ((size_t)(nb * 8 + hd) * 128) * TB;
      UNR for (int i = 0; i < 2; ++i) { rk[i] = *(const u32x4*)(Kn + (size_t)(nkbeg + kkey0 + 32 * i) * 128 + kpart * 8); rv[i] = *(const u32x4*)(VTn + (size_t)(vdv0 + 64 * i) * TB + nkbeg + vpart * 8); }
    }
    {
      f32x16 s0 = splat16(negM), s1 = splat16(negM);
      __builtin_amdgcn_s_setprio(1);
      UNR for (int ks = 0; ks < 4; ++ks) { const bf16x8 kf = *(const bf16x8*)(Kl + r * 272 + m * 128 + ks * 32 + h * 16); s0 = MFMA32(kf, qf[ks], s0); }
      UNR for (int ks = 0; ks < 4; ++ks) { const bf16x8 kf = *(const bf16x8*)(Kl + (32 + r) * 272 + m * 128 + ks * 32 + h * 16); s1 = MFMA32(kf, qf[ks], s1); }
      __builtin_amdgcn_s_setprio(0);
      UNR for (int i = 0; i < 16; ++i) { s0[i] = __builtin_amdgcn_exp2f(s0[i]); lsum += s0[i]; }
      bf16x8 pf0[2]; pf0[0] = pack8(s0, 0); pf0[1] = pack8(s0, 8);
      __builtin_amdgcn_sched_barrier(0);
      UNR for (int dvt = 0; dvt < 4; ++dvt) UNR for (int s2 = 0; s2 < 2; ++s2) {
        const bf16x8 vf = *(const bf16x8*)(Vl + (dvt * 32 + r) * 144 + (s2 * 16 + 8 * h) * 2);
        O[dvt] = MFMA32(vf, pf0[s2], O[dvt]);
      }
      UNR for (int i = 0; i < 16; ++i) { s1[i] = __builtin_amdgcn_exp2f(s1[i]); lsum += s1[i]; }
      bf16x8 pf1[2]; pf1[0] = pack8(s1, 0); pf1[1] = pack8(s1, 8);
      UNR for (int g = 0; g < 8; ++g) { __builtin_amdgcn_sched_group_barrier(0x008, 1, 0); __builtin_amdgcn_sched_group_barrier(0x002, 5, 0); }
      __builtin_amdgcn_sched_barrier(0);
      UNR for (int dvt = 0; dvt < 4; ++dvt) UNR for (int s2 = 0; s2 < 2; ++s2) {
        const bf16x8 vf = *(const bf16x8*)(Vl + (dvt * 32 + r) * 144 + (32 + s2 * 16 + 8 * h) * 2);
        O[dvt] = MFMA32(vf, pf1[s2], O[dvt]);
      }
    }
    if (it + 1 < nt) {
      unsigned char* nx = smem + ((it + 1) & 1) * 35840;
      UNR for (int i = 0; i < 2; ++i) { *(u32x4*)(nx + (kkey0 + 32 * i) * 272 + kpart * 16) = rk[i]; *(u32x4*)(nx + 17408 + (vdv0 + 64 * i) * 144 + vpart * 16) = rv[i]; }
    }
    __syncthreads();
  }
  lsum += shx(lsum, 32);
  float* X = (float*)smem + qg * 4096;
  if (m == 1) {
    const float sc = lam / lsum;
    UNR for (int d = 0; d < 4; ++d) UNR for (int i = 0; i < 16; ++i) X[(d * 16 + i) * 64 + lane] = O[d][i] * sc;
  }
  __syncthreads();
  if (m == 0) {
    const float i0 = 1.f / lsum;
    float ss = 0.f;
    UNR for (int d = 0; d < 4; ++d) UNR for (int i = 0; i < 16; ++i) { const float o = O[d][i] * i0 - X[(d * 16 + i) * 64 + lane]; O[d][i] = o; ss += o * o; }
    ss += shx(ss, 32);
    const float rstd = (1.0f / sqrtf(ss * (1.f / 128.f) + 1e-6f)) * (1.f - lam_init);
    const size_t row = (size_t)b * TB + tq;
    const bf16_t* G = PB + 6 * SEG + row * 1024 + hd * 128;
    bf16_t* Y = (bf16_t*)(p.ws + OFF_Y) + row * 1024 + hd * 128;
    const float* sg = p.subln_g + (l >> 1) * 128;
    UNR for (int d = 0; d < 4; ++d) UNR for (int gq = 0; gq < 4; ++gq) {
      const int dv = d * 32 + 8 * gq + 4 * h;
      const u32x2 gg = *(const u32x2*)(G + dv); const f32x4 s4 = *(const f32x4*)(sg + dv);
      u32x2 w = {pk2(O[d][4 * gq] * rstd * s4[0] * bflo(gg[0]), O[d][4 * gq + 1] * rstd * s4[1] * bfhi(gg[0])),
                 pk2(O[d][4 * gq + 2] * rstd * s4[2] * bflo(gg[1]), O[d][4 * gq + 3] * rstd * s4[3] * bfhi(gg[1]))};
      *(u32x2*)(Y + dv) = w;
    }
  }
  __syncthreads();
}

DI void mixer_odd(const PW& p, int l, unsigned char* smem) {
  const float* MISC = (const float*)(p.ws + OFF_MISC);
  const float negM = MISC[l], lam = MISC[4 + (l >> 1)], lam_init = MISC[6 + (l >> 1)];
  const int G = gridDim.x, bid = lbid();
  u32x4 rk[2], rv[2];
  UNR for (int i = 0; i < 2; ++i) { rk[i] = (u32x4){0u, 0u, 0u, 0u}; rv[i] = rk[i]; }
  if ((G & 7) == 0) {
    const int hd = bid & 7, slot = bid >> 3, S = G >> 3;
    const int n_lat = slot < 256 ? (256 - slot + S - 1) / S : 0;
    const int n_ctx = (l < 3 && slot < 16) ? (16 - slot + S - 1) / S : 0;
    const int n_all = n_lat + n_ctx;
    bool pre = false;
    for (int j = 0; j < n_all; ++j) {
      int ub, uq0, ukb;
      if (j < n_lat) { const int i = slot + j * S; ub = i >> 5; uq0 = (i & 31) * 128; ukb = 0; } else { const int i = slot + (j - n_lat) * S; ub = i >> 1; uq0 = SEQ + (i & 1) * 128; ukb = SEQ; }
      const bool hn = j + 1 < n_all; int nb = 0, nkb = 0;
      if (hn) { if (j + 1 < n_lat) { nb = (slot + (j + 1) * S) >> 5; nkb = 0; } else { nb = (slot + (j + 1 - n_lat) * S) >> 1; nkb = SEQ; } }
      diff_unit(p, l, ub, hd, uq0, ukb, TB, negM, lam, lam_init, smem, rk, rv, pre, hn, nb, nkb);
      pre = hn;
    }
  } else {
    const int nun = l < 3 ? 2048 + 128 : 2048;
    for (int u = bid; u < nun; u += G) {
      if (u < 2048) { const int qb = u & 31, hd = (u >> 5) & 7, b = u >> 8; diff_unit(p, l, b, hd, qb * 128, 0, TB, negM, lam, lam_init, smem, rk, rv, false, false, 0, 0); }
      else { const int v = u - 2048, qb = v & 1, hd = (v >> 1) & 7, b = v >> 4; diff_unit(p, l, b, hd, SEQ + qb * 128, SEQ, TB, negM, lam, lam_init, smem, rk, rv, false, false, 0, 0); }
    }
  }
}

#define XB_TMO      128
#define XB_XCNT(j)  (256  + 64 * (j))
#define XB_XSUB(j)  (1280 + 64 * (j))
#define XB_XGEN(j)  (2304 + 64 * (j))
#define XB_TOP      3328
#define XB_TOPGEN   3392
#define XCD_BAR_WORDS 3456
#define XB_SPIN_CAP (1u << 18)
#ifndef LAS
#define LAS __attribute__((address_space(3)))
#endif

__device__ __forceinline__ unsigned xb_ld(unsigned* p)              { return __hip_atomic_load(p, __ATOMIC_RELAXED, __HIP_MEMORY_SCOPE_AGENT); }
__device__ __forceinline__ unsigned xb_add(unsigned* p, unsigned v) { return __hip_atomic_fetch_add(p, v, __ATOMIC_RELAXED, __HIP_MEMORY_SCOPE_AGENT); }
__device__ __forceinline__ unsigned xb_xcc_id() { return (unsigned)__builtin_amdgcn_s_getreg((3 << 11) | 20) & 0xFu; }
#define XB_SPIN(cond, bar) do { unsigned _sp = 0; while (cond) { __builtin_amdgcn_s_sleep(1); \
    if ((++_sp & 255u) == 0u) { if (xb_ld(&(bar)[XB_TMO])) break; if (_sp > XB_SPIN_CAP) { atomicAdd(&(bar)[XB_TMO], 1u); break; } } } } while (0)

struct XcdBarrier {
    unsigned* bar; unsigned x;
    volatile LAS unsigned* st;
};

__device__ __forceinline__ XcdBarrier xcd_barrier_post(unsigned* bar, volatile LAS unsigned* st) {
    XcdBarrier b; b.bar = bar; b.x = xb_xcc_id(); b.st = st;
    if (threadIdx.x == 0) (void)xb_add(&bar[XB_XCNT(b.x)], 1u);
    return b;
}
__device__ __forceinline__ void xcd_barrier_complete(unsigned* bar, unsigned x, unsigned& nloc, unsigned& nx) {
    const unsigned G = gridDim.x * gridDim.y * gridDim.z;
    unsigned sum, cnt, mine, sp = 0u;
    for (;;) {
        sum = 0u; cnt = 0u; mine = 0u;
#pragma unroll
        for (unsigned j = 0; j < 16; ++j) { const unsigned c = xb_ld(&bar[XB_XCNT(j)]); sum += c; cnt += (c > 0u) ? 1u : 0u; mine = (j == x) ? c : mine; }
        if (sum == G) break;
        __builtin_amdgcn_s_sleep(1);
        if ((++sp & 255u) == 0u) { if (xb_ld(&bar[XB_TMO])) break; if (sp > XB_SPIN_CAP) { atomicAdd(&bar[XB_TMO], 1u); break; } }
    }
    nloc = mine > 0u ? mine : 1u; nx = cnt > 0u ? cnt : 1u;
}

__device__ __forceinline__ void xcd_barrier(const XcdBarrier& b) {
    asm volatile("s_waitcnt vmcnt(0)" ::: "memory");
    __syncthreads();
    if (threadIdx.x == 0) {
        unsigned* bar = b.bar;
        __builtin_amdgcn_s_waitcnt(0);
        unsigned nloc = b.st[0], nx = b.st[1];
        if (nloc == 0u) { xcd_barrier_complete(bar, b.x, nloc, nx); b.st[0] = nloc; b.st[1] = nx; }
        const unsigned old = xb_add(&bar[XB_XSUB(b.x)], 1u);
        const unsigned gen = old / nloc;
        if (old + 1u == (gen + 1u) * nloc) {
            __builtin_amdgcn_fence(__ATOMIC_RELEASE, "agent");
            asm volatile("s_waitcnt vmcnt(0)" ::: "memory");
            const unsigned og = xb_add(&bar[XB_TOP], 1u);
            const unsigned tg = og / nx;
            if (og + 1u == (tg + 1u) * nx) xb_add(&bar[XB_TOPGEN], 1u);
            else XB_SPIN(xb_ld(&bar[XB_TOPGEN]) == tg, bar);
            __builtin_amdgcn_fence(__ATOMIC_ACQUIRE, "agent");
            xb_add(&bar[XB_XGEN(b.x)], 1u);
            asm volatile("s_waitcnt vmcnt(0)" ::: "memory");
        } else {
            XB_SPIN(xb_ld(&bar[XB_XGEN(b.x)]) == gen, bar);
            __builtin_amdgcn_fence(__ATOMIC_ACQUIRE, "agent");
            asm volatile("s_waitcnt vmcnt(0)" ::: "memory");
        }
    }
    __syncthreads();
}

typedef const Params __attribute__((address_space(4))) KParams;
DI void load_params(PW& q, KParams* k) { q.x = k->x; q.c = k->c; q.ctx = k->ctx; q.c_ctx = k->c_ctx; q.norm_g = k->norm_g; q.w_mod = k->w_mod; q.b_mod = k->b_mod; q.w_in = k->w_in; q.w_out = k->w_out; q.q_norm_g = k->q_norm_g; q.k_norm_g = k->k_norm_g; q.na_rpb = k->na_rpb; q.hy_conv_w = k->hy_conv_w; q.hy_conv_b = k->hy_conv_b; q.f_w1 = k->f_w1; q.f_b1 = k->f_b1; q.f_freq = k->f_freq; q.f_w2 = k->f_w2; q.f_b2 = k->f_b2; q.f_w3 = k->f_w3; q.f_b3 = k->f_b3; q.hy_skip = k->hy_skip; q.lq1 = k->lq1; q.lk1 = k->lk1; q.lq2 = k->lq2; q.lk2 = k->lk2; q.subln_g = k->subln_g; q.out = k->out; q.ws = k->ws; }
#define LAUNDER() do { ll = l; asm volatile("" : "+s"(ll)); KParams* k_ = kp; asm volatile("" : "+s"(k_)); load_params(q, k_); int w_ = wid0; asm volatile("" : "+s"(w_)); q.wid0 = w_; } while (0)
__global__ void __launch_bounds__(512) mega(Params p) {
  __shared__ __attribute__((aligned(16))) unsigned char smem[131072];
  __shared__ __attribute__((aligned(16))) unsigned xb_st[4];
  cg::grid_group grid = cg::this_grid();
  if (threadIdx.x < 4) xb_st[threadIdx.x] = 0u;
  __syncthreads();
  KParams* kp = (KParams*)__builtin_amdgcn_kernarg_segment_ptr();
  const int wid0 = __builtin_amdgcn_readfirstlane((int)(threadIdx.x >> 6));
  PW q; int ll = 0;
  { int l = 0; LAUNDER(); }
  if (blockIdx.x == 0) for (int i = threadIdx.x; i < 4096; i += 512) ((unsigned*)(q.ws + OFF_BAR))[i] = 0u;
  phase0(q, smem);
#if DUP & 8
  { int l = 0; LAUNDER(); phase0(q, smem); }
#endif
  grid.sync();
  const XcdBarrier xbar = xcd_barrier_post((unsigned*)(q.ws + OFF_BAR), (volatile LAS unsigned*)xb_st);
  for (int l = 0; l < 4; ++l) {
    LAUNDER();
    if (l == 0) finalize_filters(q);
    norm_phase(q, ll);
#if DUP & 16
    LAUNDER(); norm_phase(q, ll);
#endif
    xcd_barrier(xbar);
    LAUNDER();
    if (ll & 1) gemm_phase<1>(q, ll, smem); else gemm_phase<0>(q, ll, smem);
#if DUP & 1
    LAUNDER();
    if (ll & 1) gemm_phase<1>(q, ll, smem); else gemm_phase<0>(q, ll, smem);
#endif
    xcd_barrier(xbar);
    LAUNDER();
    if (ll & 1) mixer_odd(q, ll, smem); else mixer_even(q, ll, smem);
#if DUP & 2
    LAUNDER();
    if (!(ll & 1)) mixer_even(q, ll, smem);
#endif
#if DUP & 128
    LAUNDER();
    if (!(ll & 1)) mixer_even(q, ll, smem, 1);
#endif
#if DUP & 256
    LAUNDER();
    if (!(ll & 1)) mixer_even(q, ll, smem, 2);
#endif
#if DUP & 4
    LAUNDER();
    if (ll & 1) mixer_odd(q, ll, smem);
#endif
    xcd_barrier(xbar);
    LAUNDER();
    if (!(ll & 1)) { hy_transpose_phase(q, ll, smem); xcd_barrier(xbar); LAUNDER(); }
    gemm_phase<2>(q, ll, smem);
#if DUP & 32
    xcd_barrier(xbar); xcd_barrier(xbar); xcd_barrier(xbar); xcd_barrier(xbar);
#endif
#if DUP & 64
    if (l == 0) { LAUNDER(); gemm_phase<2>(q, ll, smem); }
#endif
    if (l < 3) xcd_barrier(xbar);
  }
}

extern "C" void kernel_launch(void* const* d_in, const int* in_sizes, int n_in, void* d_out, int out_size,
                              void* d_ws, size_t ws_size, hipStream_t stream) {
  static int grid_blocks = 0;
  if (!grid_blocks) {
    int dev = 0, cus = 0, per_cu = 0;
    (void)hipGetDevice(&dev);
    (void)hipDeviceGetAttribute(&cus, hipDeviceAttributeMultiprocessorCount, dev);
    (void)hipOccupancyMaxActiveBlocksPerMultiprocessor(&per_cu, mega, 512, 0);
    if (per_cu > 1) per_cu = 1;
    grid_blocks = cus * per_cu;
  }
  if (ws_size < WS_NEED) { fprintf(stderr, "workspace too small: %zu < %zu\n", ws_size, (size_t)WS_NEED); return; }
  Params p{};
  const float** pp = (const float**)&p;
  for (int i = 0; i < 27; ++i) pp[i] = (const float*)d_in[i];
  p.out = (float*)d_out; p.ws = (unsigned char*)d_ws;
  void* args[] = {&p};
  hipError_t e = hipLaunchCooperativeKernel((void*)mega, dim3(grid_blocks), dim3(512), args, 0, stream);
  if (e != hipSuccess) fprintf(stderr, "coop launch failed: %s (grid %d)\n", hipGetErrorString(e), grid_blocks);
}
```
